# Optimizing an MI355X kernel written in HIP

```python
import math
import jax
import jax.numpy as jnp
from jax import lax
import numpy as np

D_MODEL = 1024
BATCH = 16
SEQ = 2048
DEPTH = 2

F32 = jnp.float32
CTX_LEN = 256
GRID_W = 64
N_EVEN = (DEPTH + 1) // 2
N_ODD = DEPTH // 2
N_MOD = 6
NORM_EPS = 1e-6

ML_HEADS = 4
ML_DH = 128
ML_W = ML_HEADS * ML_DH
ML_CHUNK = 64

AT_HEADS = 8
AT_KV = 2
AT_G = AT_HEADS // AT_KV
AT_DH = 64
AT_W = AT_HEADS * AT_DH
AT_KVW = AT_KV * AT_DH
Q_BLOCK = 128
ROPE_THETA = 10000.0
ROPE_NF = AT_DH // 4

EV_SPLITS = (ML_W, 2 * ML_W, 3 * ML_W, 4 * ML_W, 4 * ML_W + 4 * ML_HEADS,
             4 * ML_W + 4 * ML_HEADS + AT_W, 4 * ML_W + 4 * ML_HEADS + AT_W + AT_KVW)
EV_IN = 4 * ML_W + 4 * ML_HEADS + AT_W + 2 * AT_KVW
EV_MIX = ML_W + AT_W

S5_W = 512
S5_GSIZE = 16
S5_GROUPS = S5_W // S5_GSIZE
S5_N = 64
S5_CHUNK = 128

SSD_HEADS = 8
SSD_P = 64
SSD_W = SSD_HEADS * SSD_P
SSD_G = 2
SSD_N = 128
SSD_CONV = 3
SSD_CHUNK = 128
SSD_CONV_CH = SSD_W + 2 * SSD_G * SSD_N

OD_SPLITS = (S5_W, S5_W + SSD_W, S5_W + SSD_W + SSD_CONV_CH)
OD_IN = S5_W + SSD_W + SSD_CONV_CH + 2 * SSD_HEADS
OD_MIX = S5_W + SSD_W

MOE_GROUPS = 4
MOE_PER_GROUP = 4
N_EXPERTS = MOE_GROUPS * MOE_PER_GROUP
MOE_TOPK = 2
EXPERT_HIDDEN = 512

kernel_name = "hybrid_mlstm_gqa_s5_ssd_hmoe"


def rms_norm(x, g, eps=NORM_EPS):
    xf = x.astype(F32)
    y = xf * lax.rsqrt(jnp.mean(xf * xf, axis=-1, keepdims=True) + eps)
    return (y * g.astype(F32)).astype(x.dtype)


def adaln(cond, w, b):
    m = jax.nn.silu(cond) @ w + b
    return jnp.split(m[..., None, :], N_MOD, axis=-1)


def _flip(a, rev, axis):
    return jnp.flip(a, axis=axis) if rev else a


def axial_rope(rows):
    row = jnp.repeat(jnp.arange(rows, dtype=F32), GRID_W)
    col = jnp.tile(jnp.arange(GRID_W, dtype=F32), rows)
    inv = 1.0 / (ROPE_THETA ** (jnp.arange(ROPE_NF, dtype=F32) / ROPE_NF))
    ar = row[:, None] * inv
    ac = col[:, None] * inv
    return (jnp.cos(ar), jnp.sin(ar), jnp.cos(ac), jnp.sin(ac))


def _rotate(x, cos, sin):
    x1, x2 = jnp.split(x, 2, axis=-1)
    return jnp.concatenate([x1 * cos - x2 * sin, x2 * cos + x1 * sin], axis=-1)


def apply_axial_rope(x, rope):
    cr, sr, cc, sc = [t.astype(x.dtype) for t in rope]
    xr, xc = jnp.split(x, 2, axis=-1)
    return jnp.concatenate([_rotate(xr, cr, sr), _rotate(xc, cc, sc)], axis=-1)


def mlstm_scan(q, k, v, li, lf, state0):
    Bsz, H, L, dh = q.shape
    nc = L // ML_CHUNK

    def blocks(a):
        return jnp.moveaxis(a.reshape(Bsz, H, nc, ML_CHUNK, *a.shape[3:]), 2, 0)

    mask = jnp.tril(jnp.ones((ML_CHUNK, ML_CHUNK), dtype=bool))

    def step(carry, inp):
        C0, n0, m0 = carry
        qc, kc, vc, lic, lfc = inp
        b = jnp.cumsum(lfc, axis=-1)
        logw = jnp.where(mask, b[..., :, None] - b[..., None, :] + lic[..., None, :], -jnp.inf)
        inter = b + m0[..., None]
        m = jnp.maximum(inter, jnp.max(logw, axis=-1))
        w = jnp.exp(logw - m[..., None])
        g = jnp.exp(inter - m)
        s = jnp.einsum('bhjd,bhsd->bhjs', qc, kc) * w
        num = jnp.einsum('bhjs,bhsd->bhjd', s, vc) + g[..., None] * jnp.einsum('bhvk,bhjk->bhjv', C0, qc)
        den = jnp.sum(s, axis=-1) + g * jnp.einsum('bhk,bhjk->bhj', n0, qc)
        hout = num / jnp.maximum(jnp.abs(den), jnp.exp(-m))[..., None]
        b_end = b[..., -1:]
        logw_end = b_end - b + lic
        m_new = jnp.maximum(b_end[..., 0] + m0, jnp.max(logw_end, axis=-1))
        w_end = jnp.exp(logw_end - m_new[..., None])
        decay = jnp.exp(b_end[..., 0] + m0 - m_new)
        C_new = decay[..., None, None] * C0 + jnp.einsum('bhs,bhsv,bhsk->bhvk', w_end, vc, kc)
        n_new = decay[..., None] * n0 + jnp.einsum('bhs,bhsk->bhk', w_end, kc)
        return (C_new, n_new, m_new), hout

    state, hs = lax.scan(step, state0, (blocks(q), blocks(k), blocks(v), blocks(li), blocks(lf)))
    return state, jnp.moveaxis(hs, 0, 2).reshape(Bsz, H, L, dh)


def mlstm_prep(q, k, v, g, gate_b):
    Bsz, L = q.shape[0], q.shape[1]

    def hd(a):
        return a.astype(F32).reshape(Bsz, L, ML_HEADS, ML_DH).transpose(0, 2, 1, 3)

    gates = (g.astype(F32) + gate_b.astype(F32)).reshape(Bsz, L, 2, 2, ML_HEADS).transpose(2, 3, 0, 4, 1)
    return (hd(q), hd(k) * (ML_DH ** -0.5), hd(v), gates)


def mlstm_bidir(ctx_in, lat_in):
    qc, kc, vc, gc = ctx_in
    ql, kl, vl, gl = lat_in
    Bsz = ql.shape[0]
    zero = (jnp.zeros((Bsz, ML_HEADS, ML_DH, ML_DH), F32),
            jnp.zeros((Bsz, ML_HEADS, ML_DH), F32),
            jnp.zeros((Bsz, ML_HEADS), F32))
    hc = jnp.zeros_like(qc)
    hl = jnp.zeros_like(ql)
    for d in range(2):
        li_c, lf_c = gc[d, 0], jax.nn.log_sigmoid(gc[d, 1])
        li_l, lf_l = gl[d, 0], jax.nn.log_sigmoid(gl[d, 1])
        st, hcd = mlstm_scan(_flip(qc, d, 2), _flip(kc, d, 2), _flip(vc, d, 2),
                             _flip(li_c, d, 2), _flip(lf_c, d, 2), zero)
        _, hld = mlstm_scan(_flip(ql, d, 2), _flip(kl, d, 2), _flip(vl, d, 2),
                            _flip(li_l, d, 2), _flip(lf_l, d, 2), st)
        hc = hc + _flip(hcd, d, 2)
        hl = hl + _flip(hld, d, 2)
    return hc, hl


def mlstm_output(hh, o, gain):
    Bsz, _, L, _ = hh.shape
    hh = rms_norm(hh, gain.reshape(ML_HEADS, 1, ML_DH))
    hh = hh.transpose(0, 2, 1, 3).reshape(Bsz, L, ML_W)
    return (hh * jax.nn.sigmoid(o.astype(F32))).astype(o.dtype)


def _attend(q, k, v):
    s = jnp.einsum('bkgqd,bknd->bkgqn', q, k).astype(F32) * (AT_DH ** -0.5)
    p = jax.nn.softmax(s, axis=-1).astype(v.dtype)
    return jnp.einsum('bkgqn,bknd->bkgqd', p, v)


def gqa_heads(q, k, v, q_norm, k_norm):
    Bsz, L = q.shape[0], q.shape[1]
    q = rms_norm(q.reshape(Bsz, L, AT_KV, AT_G, AT_DH), q_norm).transpose(0, 2, 3, 1, 4)
    k = rms_norm(k.reshape(Bsz, L, AT_KV, AT_DH), k_norm).transpose(0, 2, 1, 3)
    v = v.reshape(Bsz, L, AT_KV, AT_DH).transpose(0, 2, 1, 3)
    return q, k, v


def gqa_mixer(ctx_qkv, lat_qkv, q_norm, k_norm, rope, need_ctx):
    qc, kc, vc = gqa_heads(*ctx_qkv, q_norm, k_norm)
    ql, kl, vl = gqa_heads(*lat_qkv, q_norm, k_norm)
    ql = apply_axial_rope(ql, rope)
    kl = apply_axial_rope(kl, rope)
    Bsz, S = ql.shape[0], ql.shape[3]
    out_c = None
    if need_ctx:
        oc = _attend(qc, kc, vc)
        out_c = oc.transpose(0, 3, 1, 2, 4).reshape(Bsz, -1, AT_W)
    k_all = jnp.concatenate([kc, kl], axis=2)
    v_all = jnp.concatenate([vc, vl], axis=2)
    nb = S // Q_BLOCK
    qb = jnp.moveaxis(ql.reshape(Bsz, AT_KV, AT_G, nb, Q_BLOCK, AT_DH), 3, 0)
    ob = lax.map(lambda qq: _attend(qq, k_all, v_all), qb)
    out_l = ob.transpose(1, 0, 4, 2, 3, 5).reshape(Bsz, S, AT_W)
    return out_c, out_l


def even_mixer(h, hc, w_in, w_out, gate_b, ml_norm, q_norm, k_norm, rope, need_ctx):
    mq_c, mk_c, mv_c, mo_c, mg_c, aq_c, ak_c, av_c = jnp.split(hc @ w_in, EV_SPLITS, axis=-1)
    mq_l, mk_l, mv_l, mo_l, mg_l, aq_l, ak_l, av_l = jnp.split(h @ w_in, EV_SPLITS, axis=-1)
    ml_c, ml_l = mlstm_bidir(mlstm_prep(mq_c, mk_c, mv_c, mg_c, gate_b),
                             mlstm_prep(mq_l, mk_l, mv_l, mg_l, gate_b))
    at_c, at_l = gqa_mixer((aq_c, ak_c, av_c), (aq_l, ak_l, av_l), q_norm, k_norm, rope, need_ctx)
    y = jnp.concatenate([mlstm_output(ml_l, mo_l, ml_norm), at_l], axis=-1) @ w_out
    yc = None
    if need_ctx:
        yc = jnp.concatenate([mlstm_output(ml_c, mo_c, ml_norm), at_c], axis=-1) @ w_out
    return y, yc


def _complex_affine_combine(e1, e2):
    a1r, a1i, b1r, b1i = e1
    a2r, a2i, b2r, b2i = e2
    return (a2r * a1r - a2i * a1i, a2r * a1i + a2i * a1r,
            a2r * b1r - a2i * b1i + b2r, a2r * b1i + a2i * b1r + b2i)


def s5_scan(u, a_re, a_im, log_dt, b_re, b_im, c_re, c_im, h0):
    a_re, a_im, b_re, b_im, c_re, c_im = [p.astype(F32) for p in (a_re, a_im, b_re, b_im, c_re, c_im)]
    dt = jnp.exp(log_dt.astype(F32))[:, None]
    mag = jnp.exp(dt * a_re)
    ab_re = mag * jnp.cos(dt * a_im)
    ab_im = mag * jnp.sin(dt * a_im)
    den = a_re * a_re + a_im * a_im
    zr = ((ab_re - 1.0) * a_re + ab_im * a_im) / den
    zi = (ab_im * a_re - (ab_re - 1.0) * a_im) / den
    bb_re = zr[..., None] * b_re - zi[..., None] * b_im
    bb_im = zr[..., None] * b_im + zi[..., None] * b_re
    bu_re = jnp.einsum('gnc,blgc->blgn', bb_re, u)
    bu_im = jnp.einsum('gnc,blgc->blgn', bb_im, u)
    Bsz, L = u.shape[0], u.shape[1]
    nc = L // S5_CHUNK
    shape = (Bsz, S5_CHUNK, S5_GROUPS, S5_N)
    a_blk_re = jnp.broadcast_to(ab_re, shape)
    a_blk_im = jnp.broadcast_to(ab_im, shape)

    def blocks(a):
        return jnp.moveaxis(a.reshape(Bsz, nc, S5_CHUNK, S5_GROUPS, S5_N), 1, 0)

    def step(h, inp):
        h_re, h_im = h
        br, bi = inp
        p_re, p_im, s_re, s_im = lax.associative_scan(
            _complex_affine_combine, (a_blk_re, a_blk_im, br, bi), axis=1)
        hr = s_re + p_re * h_re[:, None] - p_im * h_im[:, None]
        hi = s_im + p_re * h_im[:, None] + p_im * h_re[:, None]
        y = jnp.einsum('gcn,blgn->blgc', c_re, hr) - jnp.einsum('gcn,blgn->blgc', c_im, hi)
        return (hr[:, -1], hi[:, -1]), y

    h_last, ys = lax.scan(step, h0, (blocks(bu_re), blocks(bu_im)))
    return h_last, jnp.moveaxis(ys, 0, 1).reshape(Bsz, L, S5_GROUPS, S5_GSIZE)


def s5_bidir(u_c, u_l, s5p):
    Bsz = u_l.shape[0]
    uc = u_c.astype(F32).reshape(Bsz, -1, S5_GROUPS, S5_GSIZE)
    ul = u_l.astype(F32).reshape(Bsz, -1, S5_GROUPS, S5_GSIZE)
    zero = (jnp.zeros((Bsz, S5_GROUPS, S5_N), F32), jnp.zeros((Bsz, S5_GROUPS, S5_N), F32))
    yc = jnp.zeros_like(uc)
    yl = jnp.zeros_like(ul)
    for d in range(2):
        pd = [p[d] for p in s5p]
        st, ycd = s5_scan(_flip(uc, d, 1), *pd, zero)
        _, yld = s5_scan(_flip(ul, d, 1), *pd, st)
        yc = yc + _flip(ycd, d, 1)
        yl = yl + _flip(yld, d, 1)
    return yc, yl


def s5_output(y, u, d_skip, glu_w, glu_b):
    Bsz, L = u.shape[0], u.shape[1]
    y = y.reshape(Bsz, L, S5_W) + d_skip.astype(F32) * u.astype(F32)
    g = jax.nn.gelu(y)
    return (g * jax.nn.sigmoid(g @ glu_w.astype(F32) + glu_b.astype(F32))).astype(u.dtype)


def dwconv_centered(x, w, b):
    ch = x.shape[-1]
    y = lax.conv_general_dilated(x, w[:, None, :].astype(x.dtype), window_strides=(1,),
                                 padding=[(SSD_CONV // 2, SSD_CONV // 2)],
                                 dimension_numbers=('NWC', 'WIO', 'NWC'), feature_group_count=ch)
    return y + b.astype(x.dtype)


def ssd_scan(x, dt, a, bm, cm, h0):
    Bsz, L = x.shape[0], x.shape[1]
    nc = L // SSD_CHUNK
    hg = SSD_HEADS // SSD_G
    x = x.reshape(Bsz, nc, SSD_CHUNK, SSD_G, hg, SSD_P)
    dt = dt.reshape(Bsz, nc, SSD_CHUNK, SSD_G, hg)
    bm = bm.reshape(Bsz, nc, SSD_CHUNK, SSD_G, SSD_N)
    cm = cm.reshape(Bsz, nc, SSD_CHUNK, SSD_G, SSD_N)
    acs = jnp.cumsum(dt * a.reshape(SSD_G, hg), axis=2)
    mask = jnp.tril(jnp.ones((SSD_CHUNK, SSD_CHUNK), dtype=bool))[:, :, None, None]
    seg = acs[:, :, :, None] - acs[:, :, None, :]
    decay = jnp.exp(jnp.where(mask, seg, -jnp.inf))
    cb = jnp.einsum('bclgn,bcsgn->bclsg', cm, bm)
    w = cb[..., None] * decay * dt[:, :, None]
    y_diag = jnp.einsum('bclsgh,bcsghp->bclghp', w, x)
    decay_end = jnp.exp(acs[:, :, -1:] - acs) * dt
    states = jnp.einsum('bcsgh,bcsgn,bcsghp->bcghpn', decay_end, bm, x)
    chunk_decay = jnp.exp(acs[:, :, -1])

    def step(h, inp):
        st, dec = inp
        return dec[..., None, None] * h + st, h

    h_last, h_in = lax.scan(step, h0.reshape(Bsz, SSD_G, hg, SSD_P, SSD_N),
                            (jnp.moveaxis(states, 1, 0), jnp.moveaxis(chunk_decay, 1, 0)))
    h_in = jnp.moveaxis(h_in, 0, 1)
    y_off = jnp.einsum('bclgn,bcghpn,bclgh->bclghp', cm, h_in, jnp.exp(acs))
    return (h_last.reshape(Bsz, SSD_HEADS, SSD_P, SSD_N),
            (y_diag + y_off).reshape(Bsz, L, SSD_HEADS, SSD_P))


def ssd_prep(xbc, dtr, conv_w, conv_b):
    Bsz, L = xbc.shape[0], xbc.shape[1]
    act = jax.nn.silu(dwconv_centered(xbc, conv_w, conv_b)).astype(F32)
    xs, bm, cm = jnp.split(act, (SSD_W, SSD_W + SSD_G * SSD_N), axis=-1)
    return (xs.reshape(Bsz, L, SSD_HEADS, SSD_P),
            dtr.astype(F32).reshape(Bsz, L, 2, SSD_HEADS),
            bm.reshape(Bsz, L, SSD_G, SSD_N),
            cm.reshape(Bsz, L, SSD_G, SSD_N))


def ssd_bidir(ctx_in, lat_in, dt_bias, a_log, d_skip):
    xs_c, dtr_c, b_c, c_c = ctx_in
    xs_l, dtr_l, b_l, c_l = lat_in
    Bsz = xs_l.shape[0]
    zero = jnp.zeros((Bsz, SSD_HEADS, SSD_P, SSD_N), F32)
    dsk = d_skip.astype(F32)[:, None]
    yc = dsk * xs_c
    yl = dsk * xs_l
    for d in range(2):
        a = -jnp.exp(a_log[d].astype(F32))
        dtb = dt_bias[d].astype(F32)
        dt_c = jax.nn.softplus(dtr_c[:, :, d] + dtb)
        dt_l = jax.nn.softplus(dtr_l[:, :, d] + dtb)
        st, ycd = ssd_scan(_flip(xs_c, d, 1), _flip(dt_c, d, 1), a, _flip(b_c, d, 1), _flip(c_c, d, 1), zero)
        _, yld = ssd_scan(_flip(xs_l, d, 1), _flip(dt_l, d, 1), a, _flip(b_l, d, 1), _flip(c_l, d, 1), st)
        yc = yc + _flip(ycd, d, 1)
        yl = yl + _flip(yld, d, 1)
    return yc, yl


def ssd_output(y, z, gain):
    Bsz, L = z.shape[0], z.shape[1]
    y = y.reshape(Bsz, L, SSD_W) * jax.nn.silu(z.astype(F32))
    return rms_norm(y, gain).astype(z.dtype)


def odd_mixer(h, hc, w_in, w_out, s5p, s5_d, glu_w, glu_b, conv_w, conv_b, dt_bias, a_log, ssd_d,
              ssd_norm, need_ctx):
    u_c, z_c, xbc_c, dt_c = jnp.split(hc @ w_in, OD_SPLITS, axis=-1)
    u_l, z_l, xbc_l, dt_l = jnp.split(h @ w_in, OD_SPLITS, axis=-1)
    s5c, s5l = s5_bidir(u_c, u_l, s5p)
    ssc, ssl = ssd_bidir(ssd_prep(xbc_c, dt_c, conv_w, conv_b), ssd_prep(xbc_l, dt_l, conv_w, conv_b),
                         dt_bias, a_log, ssd_d)
    y = jnp.concatenate([s5_output(s5l, u_l, s5_d, glu_w, glu_b), ssd_output(ssl, z_l, ssd_norm)], axis=-1) @ w_out
    yc = None
    if need_ctx:
        yc = jnp.concatenate([s5_output(s5c, u_c, s5_d, glu_w, glu_b), ssd_output(ssc, z_c, ssd_norm)],
                             axis=-1) @ w_out
    return y, yc


def hier_moe(h, gr_w, gr_b, er_w, er_b, w_gate, w_up, w_down):
    Bsz, L, D = h.shape
    t = h.reshape(Bsz * L, D)
    g_probs = jax.nn.softmax((t @ gr_w).astype(F32) + gr_b.astype(F32), axis=-1)
    g_p, g_idx = lax.top_k(g_probs, 1)
    e_logits = ((t @ er_w).astype(F32) + er_b.astype(F32)).reshape(-1, MOE_GROUPS, MOE_PER_GROUP)
    e_in = e_logits[jnp.arange(t.shape[0]), g_idx[:, 0]]
    top_v, top_i = lax.top_k(e_in, MOE_TOPK)
    w = jax.nn.softmax(top_v, axis=-1) * g_p
    eid = g_idx * MOE_PER_GROUP + top_i
    combine = jnp.sum(jax.nn.one_hot(eid, N_EXPERTS, dtype=F32) * w[..., None], axis=1).astype(t.dtype)
    out = jnp.zeros_like(t)
    for e in range(N_EXPERTS):
        act = jax.nn.silu(t @ w_gate[e]) * (t @ w_up[e])
        out = out + combine[:, e:e + 1] * (act @ w_down[e])
    return out.reshape(Bsz, L, D)


def setup_inputs(seed: int = 0) -> dict:
    key = jax.random.key(seed)
    ks = iter(jax.random.split(key, 48))

    def nrm(shape, scale):
        return jax.random.normal(next(ks), shape, F32) * scale

    def unif(shape, lo, hi):
        return jax.random.uniform(next(ks), shape, F32, lo, hi)

    D = D_MODEL
    x = nrm((BATCH, SEQ, D), 1.0)
    c = nrm((BATCH, D), 1.0)
    ctx = nrm((BATCH, CTX_LEN, D), 1.0)
    c_ctx = nrm((D,), 1.0)
    ada_w = nrm((DEPTH, D, N_MOD * D), 0.5 * D ** -0.5)
    ada_b = nrm((DEPTH, N_MOD * D), 0.02)
    norm_mix = 1.0 + nrm((DEPTH, D), 0.05)
    norm_ffn = 1.0 + nrm((DEPTH, D), 0.05)
    ev_w_in = nrm((N_EVEN, D, EV_IN), D ** -0.5)
    ev_w_out = nrm((N_EVEN, EV_MIX, D), EV_MIX ** -0.5)
    ig = nrm((N_EVEN, 2, ML_HEADS), 0.1)
    fg = unif((N_EVEN, 2, ML_HEADS), 3.0, 6.0)
    ml_gate_b = jnp.stack([ig, fg], axis=2).reshape(N_EVEN, 4 * ML_HEADS)
    ml_norm = 1.0 + nrm((N_EVEN, ML_W), 0.05)
    at_q_norm = 1.0 + nrm((N_EVEN, AT_DH), 0.05)
    at_k_norm = 1.0 + nrm((N_EVEN, AT_DH), 0.05)
    od_w_in = nrm((N_ODD, D, OD_IN), D ** -0.5)
    od_w_out = nrm((N_ODD, OD_MIX, D), OD_MIX ** -0.5)
    s5_a_re = -0.5 + nrm((N_ODD, 2, S5_GROUPS, S5_N), 0.01)
    s5_a_im = math.pi * jnp.arange(S5_N, dtype=F32) + nrm((N_ODD, 2, S5_GROUPS, S5_N), 0.01)
    s5_log_dt = unif((N_ODD, 2, S5_GROUPS), math.log(1e-3), math.log(1e-1))
    s5_b_re = nrm((N_ODD, 2, S5_GROUPS, S5_N, S5_GSIZE), (2 * S5_GSIZE) ** -0.5)
    s5_b_im = nrm((N_ODD, 2, S5_GROUPS, S5_N, S5_GSIZE), (2 * S5_GSIZE) ** -0.5)
    s5_c_re = nrm((N_ODD, 2, S5_GROUPS, S5_GSIZE, S5_N), S5_N ** -0.5)
    s5_c_im = nrm((N_ODD, 2, S5_GROUPS, S5_GSIZE, S5_N), S5_N ** -0.5)
    s5_d = nrm((N_ODD, S5_W), 0.5)
    s5_glu_w = nrm((N_ODD, S5_W, S5_W), S5_W ** -0.5)
    s5_glu_b = nrm((N_ODD, S5_W), 0.02)
    ssd_conv_w = nrm((N_ODD, SSD_CONV, SSD_CONV_CH), SSD_CONV ** -0.5)
    ssd_conv_b = nrm((N_ODD, SSD_CONV_CH), 0.02)
    dt0 = jnp.exp(unif((N_ODD, 2, SSD_HEADS), math.log(1e-3), math.log(1e-1)))
    ssd_dt_bias = dt0 + jnp.log(-jnp.expm1(-dt0))
    ssd_a_log = jnp.log(unif((N_ODD, 2, SSD_HEADS), 1.0, 16.0))
    ssd_d = 1.0 + nrm((N_ODD, SSD_HEADS), 0.1)
    ssd_norm = 1.0 + nrm((N_ODD, SSD_W), 0.05)
    moe_gr_w = nrm((DEPTH, D, MOE_GROUPS), D ** -0.5)
    moe_gr_b = nrm((DEPTH, MOE_GROUPS), 0.01)
    moe_er_w = nrm((DEPTH, D, N_EXPERTS), D ** -0.5)
    moe_er_b = nrm((DEPTH, N_EXPERTS), 0.01)
    moe_w_gate = nrm((DEPTH, N_EXPERTS, D, EXPERT_HIDDEN), D ** -0.5)
    moe_w_up = nrm((DEPTH, N_EXPERTS, D, EXPERT_HIDDEN), D ** -0.5)
    moe_w_down = nrm((DEPTH, N_EXPERTS, EXPERT_HIDDEN, D), EXPERT_HIDDEN ** -0.5)
    return {
        "x": x, "c": c, "ctx": ctx, "c_ctx": c_ctx,
        "ada_w": ada_w, "ada_b": ada_b, "norm_mix": norm_mix, "norm_ffn": norm_ffn,
        "ev_w_in": ev_w_in, "ev_w_out": ev_w_out, "ml_gate_b": ml_gate_b, "ml_norm": ml_norm,
        "at_q_norm": at_q_norm, "at_k_norm": at_k_norm,
        "od_w_in": od_w_in, "od_w_out": od_w_out,
        "s5_a_re": s5_a_re, "s5_a_im": s5_a_im, "s5_log_dt": s5_log_dt,
        "s5_b_re": s5_b_re, "s5_b_im": s5_b_im, "s5_c_re": s5_c_re, "s5_c_im": s5_c_im,
        "s5_d": s5_d, "s5_glu_w": s5_glu_w, "s5_glu_b": s5_glu_b,
        "ssd_conv_w": ssd_conv_w, "ssd_conv_b": ssd_conv_b, "ssd_dt_bias": ssd_dt_bias,
        "ssd_a_log": ssd_a_log, "ssd_d": ssd_d, "ssd_norm": ssd_norm,
        "moe_gr_w": moe_gr_w, "moe_gr_b": moe_gr_b, "moe_er_w": moe_er_w, "moe_er_b": moe_er_b,
        "moe_w_gate": moe_w_gate, "moe_w_up": moe_w_up, "moe_w_down": moe_w_down,
    }


def reference(x, c, ctx, c_ctx, ada_w, ada_b, norm_mix, norm_ffn,
              ev_w_in, ev_w_out, ml_gate_b, ml_norm, at_q_norm, at_k_norm,
              od_w_in, od_w_out, s5_a_re, s5_a_im, s5_log_dt, s5_b_re, s5_b_im, s5_c_re, s5_c_im,
              s5_d, s5_glu_w, s5_glu_b,
              ssd_conv_w, ssd_conv_b, ssd_dt_bias, ssd_a_log, ssd_d, ssd_norm,
              moe_gr_w, moe_gr_b, moe_er_w, moe_er_b, moe_w_gate, moe_w_up, moe_w_down):
    rows = x.shape[1] // GRID_W
    rope = axial_rope(rows)
    xc = ctx
    for i in range(DEPTH):
        need_ctx = i < DEPTH - 1
        j = i // 2
        sh1, sc1, g1, sh2, sc2, g2 = adaln(c, ada_w[i], ada_b[i])
        csh1, csc1, cg1, csh2, csc2, cg2 = adaln(c_ctx, ada_w[i], ada_b[i])
        h = rms_norm(x, norm_mix[i]) * (1.0 + sc1) + sh1
        hc = rms_norm(xc, norm_mix[i]) * (1.0 + csc1) + csh1
        if i % 2 == 0:
            y, yc = even_mixer(h, hc, ev_w_in[j], ev_w_out[j], ml_gate_b[j], ml_norm[j],
                               at_q_norm[j], at_k_norm[j], rope, need_ctx)
        else:
            s5p = (s5_a_re[j], s5_a_im[j], s5_log_dt[j], s5_b_re[j], s5_b_im[j], s5_c_re[j], s5_c_im[j])
            y, yc = odd_mixer(h, hc, od_w_in[j], od_w_out[j], s5p, s5_d[j], s5_glu_w[j], s5_glu_b[j],
                              ssd_conv_w[j], ssd_conv_b[j], ssd_dt_bias[j], ssd_a_log[j], ssd_d[j],
                              ssd_norm[j], need_ctx)
        moe_p = (moe_gr_w[i], moe_gr_b[i], moe_er_w[i], moe_er_b[i], moe_w_gate[i], moe_w_up[i], moe_w_down[i])
        x = x + g1 * y
        x = x + g2 * hier_moe(rms_norm(x, norm_ffn[i]) * (1.0 + sc2) + sh2, *moe_p)
        if need_ctx:
            xc = xc + cg1 * yc
            xc = xc + cg2 * hier_moe(rms_norm(xc, norm_ffn[i]) * (1.0 + csc2) + csh2, *moe_p)
    return x
```

```cpp
#include <hip/hip_runtime.h>
#include <hip/hip_bf16.h>
#include <cstdio>
#include <cstdint>
#include <cmath>

constexpr int D = 1024, NBATCH = 16, SEQ = 2048, CTXL = 256, LT = CTXL + SEQ  , R = NBATCH * LT  ;
constexpr int NP0 = 2816;
constexpr int NP1 = 2048;
constexpr int C_MQ = 0, C_MK = 512, C_MV = 1024, C_MO = 1536, C_AQ = 2048, C_AK = 2560, C_AV = 2688;
constexpr int C_U = 0, C_Z = 512, C_XS = 1024, C_B = 1536, C_C = 1792;
constexpr int NWAVES = 8, NTHREADS = 512, GRID = 256;
constexpr int ROWS_PER_WG = R / GRID  , ROWS_PER_WAVE = ROWS_PER_WG / NWAVES  ;
constexpr int NCLS = 24, MAXPOS = 43008  ;
constexpr float NORM_EPS = 1e-6f;

constexpr size_t MiB = 1u << 20;
constexpr size_t WS_CTL = 0, CTL_ZERO_BYTES = 1 * MiB;
constexpr size_t WS_MOD = 1 * MiB;
constexpr size_t WS_WIN0 = 2 * MiB, WS_WOUT0 = 8 * MiB, WS_WIN1 = 10 * MiB, WS_WOUT1 = 14 * MiB, WS_WGLU = 16 * MiB;
constexpr size_t WS_GU0 = 18 * MiB, WS_D0 = 50 * MiB, WS_GU1 = 66 * MiB, WS_D1 = 98 * MiB;
constexpr size_t WS_GATES = 114 * MiB;
constexpr size_t WS_ROUTE = 117 * MiB;
constexpr size_t WS_XRC = 118 * MiB;
constexpr size_t WS_HB = 134 * MiB;
constexpr size_t WS_P = 206 * MiB;
constexpr size_t WS_Y0 = 404 * MiB, WS_Y1 = 440 * MiB;
constexpr size_t WS_YS0 = 350 * MiB, WS_YS1 = 386 * MiB, WS_YD0 = 422 * MiB, WS_YD1 = 458 * MiB;
constexpr size_t WS_G = WS_GU0;
constexpr size_t WS_H2S = WS_P, WS_ACT = WS_P + 84 * MiB;
constexpr size_t WS_END = 494 * MiB;
constexpr size_t RT_CLS = 0, RT_WTS = 147456, RT_CNT = RT_WTS + 294912, RT_TOK = RT_CNT + 24576, RT_WPOS = RT_TOK + 172032;
constexpr int CW_BAR = 4096, CW_Q = 8192;

constexpr int SCRATCH_BYTES = 155648;
constexpr int MISC_OFF = SCRATCH_BYTES;
constexpr int LDS_BYTES = SCRATCH_BYTES + 256;

#define GAS __attribute__((address_space(1)))
#define LAS __attribute__((address_space(3)))
typedef unsigned short bf16_t;
typedef short bf16x8 __attribute__((ext_vector_type(8)));
typedef short s16x4 __attribute__((ext_vector_type(4)));
typedef float f32x4 __attribute__((ext_vector_type(4)));
typedef float f32x16 __attribute__((ext_vector_type(16)));
typedef unsigned u32x4 __attribute__((ext_vector_type(4)));
typedef unsigned u32x2 __attribute__((ext_vector_type(2)));
typedef float f32x2_t __attribute__((ext_vector_type(2)));
typedef __bf16 bf16x2_t __attribute__((ext_vector_type(2)));
typedef GAS unsigned gu32;

__device__ __forceinline__ unsigned pk2(float lo, float hi) { f32x2_t v = {lo, hi}; bf16x2_t b = __builtin_convertvector(v, bf16x2_t); return __builtin_bit_cast(unsigned, b); }
__device__ __forceinline__ unsigned short f2bf(float f) { return (unsigned short)(pk2(f, 0.f) & 0xffffu); }
__device__ __forceinline__ float bflo(unsigned u) { return __uint_as_float(u << 16); }
__device__ __forceinline__ float bfhi(unsigned u) { return __uint_as_float(u & 0xffff0000u); }
__device__ __forceinline__ float bf2f(unsigned short u) { return __uint_as_float(((unsigned)u) << 16); }
__device__ __forceinline__ float wave_sum(float v) {
#pragma unroll
    for (int o = 1; o < 64; o <<= 1) v += __shfl_xor(v, o);
    return v;
}
__device__ __forceinline__ float sigmoidf_(float x) { return 1.f / (1.f + __expf(-x)); }
__device__ __forceinline__ float siluf_(float x) { return x / (1.f + __expf(-x)); }
__device__ __forceinline__ int opaque_tid() { int t = threadIdx.x; asm volatile("" : "+v"(t)); return t; }
#define LDS_WAIT() asm volatile("s_waitcnt lgkmcnt(0)" ::: "memory")
#define VM_WAIT() asm volatile("s_waitcnt vmcnt(0)" ::: "memory")

__device__ __forceinline__ bool row_is_ctx(int r) { return (r % LT) < CTXL; }

#define XB_TMO      128
#define XB_XCNT(j)  (256  + 64 * (j))
#define XB_XSUB(j)  (1280 + 64 * (j))
#define XB_XGEN(j)  (2304 + 64 * (j))
#define XB_TOP      3328
#define XB_TOPGEN   3392
#define XCD_BAR_WORDS 3456
#define XB_SPIN_CAP (1u << 22)

__device__ __forceinline__ unsigned xb_ld(unsigned* p)              { return __hip_atomic_load(p, __ATOMIC_RELAXED, __HIP_MEMORY_SCOPE_AGENT); }
__device__ __forceinline__ unsigned xb_add(unsigned* p, unsigned v) { return __hip_atomic_fetch_add(p, v, __ATOMIC_RELAXED, __HIP_MEMORY_SCOPE_AGENT); }
__device__ __forceinline__ unsigned xb_xcc_id() { return (unsigned)__builtin_amdgcn_s_getreg((3 << 11) | 20) & 0xFu; }
#define XB_SPIN(cond, bar) do { unsigned _sp = 0; while (cond) { __builtin_amdgcn_s_sleep(1); \
    if ((++_sp & 255u) == 0u) { if (xb_ld(&(bar)[XB_TMO])) break; if (_sp > XB_SPIN_CAP) { atomicAdd(&(bar)[XB_TMO], 1u); break; } } } } while (0)

struct XcdBarrier { unsigned* bar; unsigned x; volatile LAS unsigned* st; };

__device__ __forceinline__ XcdBarrier xcd_barrier_post(unsigned* bar, volatile LAS unsigned* st) {
    XcdBarrier b; b.bar = bar; b.x = xb_xcc_id(); b.st = st;
    if (threadIdx.x == 0) (void)xb_add(&bar[XB_XCNT(b.x)], 1u);
    return b;
}
__device__ __forceinline__ void xcd_barrier_complete(unsigned* bar, unsigned x, unsigned& nloc, unsigned& nx) {
    const unsigned G = gridDim.x * gridDim.y * gridDim.z;
    unsigned sum, cnt, mine, sp = 0u;
    for (;;) {
        sum = 0u; cnt = 0u; mine = 0u;
#pragma unroll
        for (unsigned j = 0; j < 16; ++j) { const unsigned c = xb_ld(&bar[XB_XCNT(j)]); sum += c; cnt += (c > 0u) ? 1u : 0u; mine = (j == x) ? c : mine; }
        if (sum == G) break;
        __builtin_amdgcn_s_sleep(1);
        if ((++sp & 255u) == 0u) { if (xb_ld(&bar[XB_TMO])) break; if (sp > XB_SPIN_CAP) { atomicAdd(&bar[XB_TMO], 1u); break; } }
    }
    nloc = mine > 0u ? mine : 1u; nx = cnt > 0u ? cnt : 1u;
}
__device__ __forceinline__ void xcd_barrier(const XcdBarrier& b) {
    asm volatile("s_waitcnt vmcnt(0)" ::: "memory");
    __syncthreads();
    if (threadIdx.x == 0) {
        unsigned* bar = b.bar;
        __builtin_amdgcn_s_waitcnt(0);
        unsigned nloc = b.st[0], nx = b.st[1];
        if (nloc == 0u) { xcd_barrier_complete(bar, b.x, nloc, nx); b.st[0] = nloc; b.st[1] = nx; }
        const unsigned old = xb_add(&bar[XB_XSUB(b.x)], 1u);
        const unsigned gen = old / nloc;
        if (old + 1u == (gen + 1u) * nloc) {
            __builtin_amdgcn_fence(__ATOMIC_RELEASE, "agent");
            asm volatile("s_waitcnt vmcnt(0)" ::: "memory");
            const unsigned og = xb_add(&bar[XB_TOP], 1u);
            const unsigned tg = og / nx;
            if (og + 1u == (tg + 1u) * nx) xb_add(&bar[XB_TOPGEN], 1u);
            else XB_SPIN(xb_ld(&bar[XB_TOPGEN]) == tg, bar);
            __builtin_amdgcn_fence(__ATOMIC_ACQUIRE, "agent");
            xb_add(&bar[XB_XGEN(b.x)], 1u);
            asm volatile("s_waitcnt vmcnt(0)" ::: "memory");
        } else {
            XB_SPIN(xb_ld(&bar[XB_XGEN(b.x)]) == gen, bar);
            __builtin_amdgcn_fence(__ATOMIC_ACQUIRE, "agent");
            asm volatile("s_waitcnt vmcnt(0)" ::: "memory");
        }
    }
    __syncthreads();
}

struct Params { const float* in[39]; float* out; unsigned char* ws; };
enum { I_X = 0, I_C, I_CTX, I_CCTX, I_ADAW, I_ADAB, I_NMIX, I_NFFN, I_EVWIN, I_EVWOUT, I_MLGB, I_MLNORM, I_QNORM, I_KNORM, I_ODWIN, I_ODWOUT,
       I_S5ARE, I_S5AIM, I_S5LDT, I_S5BRE, I_S5BIM, I_S5CRE, I_S5CIM, I_S5D, I_GLUW, I_GLUB, I_CONVW, I_CONVB, I_DTB, I_ALOG, I_SSDD, I_SSDNORM,
       I_GRW, I_GRB, I_ERW, I_ERB, I_WG, I_WU, I_WD };

struct Frame {
    LAS unsigned char* lds; volatile LAS unsigned* MISC; gu32* ctl;
    int tid, lane, wave, vcu, G, bid;
    const Params* p; unsigned char* ws;
};
__device__ __forceinline__ float* xr_row(const Frame& F, int r) {
    const int b = r / LT, p = r % LT;
    return p < CTXL ? (float*)(F.ws + WS_XRC) + ((size_t)(b * CTXL + p)) * D : F.p->out + ((size_t)(b * SEQ + p - CTXL)) * D;
}
__device__ __forceinline__ const float* xin_row(const Frame& F, int r) {
    const int b = r / LT, p = r % LT;
    return p < CTXL ? F.p->in[I_CTX] + ((size_t)(b * CTXL + p)) * D : F.p->in[I_X] + ((size_t)(b * SEQ + p - CTXL)) * D;
}
__device__ __forceinline__ int q_next(Frame& F, int q) {
    __syncthreads();
    if (F.tid == 0) F.MISC[16] = __hip_atomic_fetch_add((unsigned*)(F.ctl + CW_Q + 64 * q), 1u, __ATOMIC_RELAXED, __HIP_MEMORY_SCOPE_AGENT);
    __syncthreads();
    return (int)F.MISC[16];
}

__device__ __forceinline__ void tr_item(const float* src, int ldw, int k0, int c0, bf16_t* dst, size_t dp, int r0, int kd0, LAS float* scr, int lane) {
#pragma unroll 8
    for (int i = 0; i < 32; ++i) { const int kk = 2 * i + (lane >> 5); scr[kk * 33 + (lane & 31)] = src[(size_t)(k0 + kk) * ldw + c0 + (lane & 31)]; }
    LDS_WAIT(); asm volatile("" ::: "memory");
    const int c = lane & 7;
#pragma unroll
    for (int j = 0; j < 4; ++j) { const int n = (lane >> 3) + 8 * j; const LAS float* s = scr + (8 * c) * 33 + n;
        u32x4 o; o.x = pk2(s[0 * 33], s[1 * 33]); o.y = pk2(s[2 * 33], s[3 * 33]); o.z = pk2(s[4 * 33], s[5 * 33]); o.w = pk2(s[6 * 33], s[7 * 33]);
        *(GAS u32x4*)(dst + (size_t)(r0 + n) * dp + kd0 + 8 * c) = o; }
    LDS_WAIT(); asm volatile("" ::: "memory");
}
__device__ __forceinline__ void p0_prologue(Frame& F) {
    const Params& P = *F.p;
    if (F.bid < 192) {
        const int l = F.bid / 96, cb = F.bid % 96;
        LAS float* sc = (LAS float*)F.lds;
        LAS float* red = (LAS float*)(F.lds + 17 * 1024 * 4);
        for (int i = F.tid; i < 17 * 1024; i += NTHREADS) { const int m = i >> 10, k = i & 1023; const float v = m < 16 ? P.in[I_C][m * 1024 + k] : P.in[I_CCTX][k]; sc[i] = siluf_(v); }
        __syncthreads();
        const int kq = F.tid >> 6, col = F.tid & 63;
        float acc[17];
#pragma unroll
        for (int m = 0; m < 17; ++m) acc[m] = 0.f;
        const float* w = P.in[I_ADAW] + (size_t)l * 1024 * 6144 + cb * 64 + col;
#pragma unroll 4
        for (int k = kq; k < 1024; k += 8) { const float wv = w[(size_t)k * 6144];
#pragma unroll
            for (int m = 0; m < 17; ++m) acc[m] += sc[m * 1024 + k] * wv; }
#pragma unroll
        for (int m = 0; m < 17; ++m) red[(kq * 17 + m) * 64 + col] = acc[m];
        __syncthreads();
        for (int i = F.tid; i < 17 * 64; i += NTHREADS) { const int m = i >> 6, c2 = i & 63; float s = 0.f;
#pragma unroll
            for (int q = 0; q < 8; ++q) s += red[(q * 17 + m) * 64 + c2];
            ((float*)(F.ws + WS_MOD))[((size_t)l * 17 + m) * 6144 + cb * 64 + c2] = s + P.in[I_ADAB][l * 6144 + cb * 64 + c2]; }
        __syncthreads();
    }
    LAS float* scr = (LAS float*)(F.lds + F.wave * 16384);
    const int gw = F.vcu * NWAVES + F.wave, NGW = F.G * NWAVES;
    constexpr int I0 = 16 * 88, I1 = 512, I2 = 16 * 64, I3 = 512, I4 = 8 * 16, IM = 768;
    constexpr int NITEMS = I0 + I1 + I2 + I3 + I4 + 32 * IM;
    for (int it = gw; it < NITEMS; it += NGW) {
        int r = it;
        if (r < I0) { const int kb = r / 88, nb = r % 88, n0 = nb * 32; tr_item(P.in[I_EVWIN], 2832, kb * 64, n0 + (n0 >= 2048 ? 16 : 0), (bf16_t*)(F.ws + WS_WIN0), 1024, n0, kb * 64, scr, F.lane); continue; } r -= I0;
        if (r < I1) { const int kb = r / 32, nb = r % 32; tr_item(P.in[I_EVWOUT], 1024, kb * 64, nb * 32, (bf16_t*)(F.ws + WS_WOUT0), 1024, nb * 32, kb * 64, scr, F.lane); continue; } r -= I1;
        if (r < I2) { const int kb = r / 64, nb = r % 64; tr_item(P.in[I_ODWIN], 2064, kb * 64, nb * 32, (bf16_t*)(F.ws + WS_WIN1), 1024, nb * 32, kb * 64, scr, F.lane); continue; } r -= I2;
        if (r < I3) { const int kb = r / 32, nb = r % 32; tr_item(P.in[I_ODWOUT], 1024, kb * 64, nb * 32, (bf16_t*)(F.ws + WS_WOUT1), 1024, nb * 32, kb * 64, scr, F.lane); continue; } r -= I3;
        if (r < I4) { const int kb = r / 16, nb = r % 16; tr_item(P.in[I_GLUW], 512, kb * 64, nb * 32, (bf16_t*)(F.ws + WS_WGLU), 512, nb * 32, kb * 64, scr, F.lane); continue; } r -= I4;
        const int le = r / IM, q = r % IM, l = le >> 4, e = le & 15;
        if (q < 512) {
            const int up = q >> 8, qq = q & 255, kb = qq / 16, nb = qq % 16, n0 = nb * 32, blk = n0 >> 7, within = n0 & 127;
            const float* src = P.in[up ? I_WU : I_WG] + ((size_t)(l * 16 + e)) * 1024 * 512;
            bf16_t* dst = (bf16_t*)(F.ws + (l ? WS_GU1 : WS_GU0)) + (size_t)e * 1024 * 1024;
            tr_item(src, 512, kb * 64, n0, dst, 1024, blk * 256 + up * 128 + within, kb * 64, scr, F.lane);
        } else {
            const int qq = q - 512, kb = qq / 32, nb = qq % 32;
            const float* src = P.in[I_WD] + ((size_t)(l * 16 + e)) * 512 * 1024;
            tr_item(src, 1024, kb * 64, nb * 32, (bf16_t*)(F.ws + (l ? WS_D1 : WS_D0)), 8192, nb * 32, e * 512 + kb * 64, scr, F.lane);
        }
    }
}

template <int MODE> __device__ __forceinline__ void norm_phase(Frame& F) {
    const Params& P = *F.p;
    constexpr int NS = (MODE == 0 || MODE == 2) ? 16 : 20;
    constexpr int layer = (MODE >= 2) ? 1 : 0;
    constexpr bool ROUTER = (MODE == 1 || MODE == 3);
    LAS f32x4* Wsm = (LAS f32x4*)F.lds;
    LAS int* cnt = (LAS int*)(F.lds + 4 * NS * 64 * 16);
    {
        LAS float* Wf = (LAS float*)F.lds;
        for (int i = F.tid; i < 1024 * NS; i += NTHREADS) {
            const int k = i / NS, n = i % NS; float v;
            if (MODE == 0) v = P.in[I_EVWIN][(size_t)k * 2832 + 2048 + n];
            else if (MODE == 2) v = P.in[I_ODWIN][(size_t)k * 2064 + 2048 + n];
            else v = n < 4 ? P.in[I_GRW][(size_t)layer * 4096 + k * 4 + n] : P.in[I_ERW][(size_t)layer * 16384 + k * 16 + (n - 4)];
            const int j = k >> 8, ln = (k & 255) >> 2, e = k & 3;
            Wf[((j * NS + n) * 64 + ln) * 4 + e] = v;
        }
        if (F.tid < 32) cnt[F.tid] = 0;
    }
    __syncthreads();
    const float* gain = P.in[ROUTER ? I_NFFN : I_NMIX] + layer * 1024;
    const float* mod = (const float*)(F.ws + WS_MOD) + (size_t)layer * 17 * 6144;
    constexpr int SH = ROUTER ? 3072 : 0, SC = ROUTER ? 4096 : 1024;
    bf16_t* HB = (bf16_t*)(F.ws + WS_HB);
    int cur = -1; f32x4 Av[4], Bv[4];
    const int r0 = F.bid * ROWS_PER_WG + F.wave * ROWS_PER_WAVE;
#pragma unroll 1
    for (int ri = 0; ri < ROWS_PER_WAVE; ++ri) {
        const int r = r0 + ri; const int b = r / LT; const bool isctx = (r % LT) < CTXL;
        if (MODE == 3 && isctx) continue;
        const int m = isctx ? 16 : b;
        if (m != cur) { cur = m;
#pragma unroll
            for (int j = 0; j < 4; ++j) { const f32x4 g = ((const f32x4*)gain)[64 * j + F.lane], s = ((const f32x4*)(mod + m * 6144 + SC))[64 * j + F.lane];
                Av[j] = g * (s + 1.0f); Bv[j] = ((const f32x4*)(mod + m * 6144 + SH))[64 * j + F.lane]; } }
        const float* src = (MODE == 0) ? xin_row(F, r) : xr_row(F, r);
        f32x4 v[4]; float ss = 0.f;
#pragma unroll
        for (int j = 0; j < 4; ++j) { v[j] = ((const GAS f32x4*)src)[64 * j + F.lane]; ss += (v[j].x * v[j].x + v[j].y * v[j].y) + (v[j].z * v[j].z + v[j].w * v[j].w); }
        const float rstd = rsqrtf(wave_sum(ss) * (1.f / D) + NORM_EPS);
#pragma unroll
        for (int j = 0; j < 4; ++j) v[j] = v[j] * rstd * Av[j] + Bv[j];
        GAS u32x2* o8 = (GAS u32x2*)(HB + (size_t)r * D) + F.lane;
#pragma unroll
        for (int j = 0; j < 4; ++j) { u32x2 w; w.x = pk2(v[j].x, v[j].y); w.y = pk2(v[j].z, v[j].w); o8[64 * j] = w; }
        float acc[NS];
#pragma unroll
        for (int n = 0; n < NS; ++n) { float a = 0.f;
#pragma unroll
            for (int j = 0; j < 4; ++j) { const f32x4 w = Wsm[(j * NS + n) * 64 + F.lane]; a += (v[j].x * w.x + v[j].y * w.y) + (v[j].z * w.z + v[j].w * w.w); }
            acc[n] = wave_sum(a); asm volatile("" ::: "memory"); }
        if (!ROUTER) {
            float mine = 0.f;
#pragma unroll
            for (int n = 0; n < NS; ++n) mine = (F.lane == n) ? acc[n] : mine;
            if (F.lane < NS) ((float*)(F.ws + WS_GATES))[(size_t)r * 16 + F.lane] = mine;
        } else if (F.lane == 0) {
            const float* grb = P.in[I_GRB] + layer * 4; const float* erb = P.in[I_ERB] + layer * 16;
            float gl[4]; int gi = 0; float gm = -1e30f;
#pragma unroll
            for (int n = 0; n < 4; ++n) { gl[n] = acc[n] + grb[n]; if (gl[n] > gm) { gm = gl[n]; gi = n; } }
            float gs = 0.f;
#pragma unroll
            for (int n = 0; n < 4; ++n) gs += __expf(gl[n] - gm);
            const float gp = 1.f / gs;
            float el[4];
#pragma unroll
            for (int n = 0; n < 4; ++n) { float t = 0.f;
#pragma unroll
                for (int q = 0; q < 4; ++q) t = (gi == q) ? acc[4 + 4 * q + n] + erb[4 * q + n] : t;
                el[n] = t; }
            int i0 = 0; float v0 = el[0];
#pragma unroll
            for (int n = 1; n < 4; ++n) if (el[n] > v0) { v0 = el[n]; i0 = n; }
            int i1 = -1; float v1 = -1e30f;
#pragma unroll
            for (int n = 0; n < 4; ++n) if (n != i0 && el[n] > v1) { v1 = el[n]; i1 = n; }
            const float e1 = __expf(v1 - v0); const float w0 = gp / (1.f + e1), w1 = gp * e1 / (1.f + e1);
            const int ea = i0 < i1 ? i0 : i1, eb = i0 < i1 ? i1 : i0; const float wa = i0 < i1 ? w0 : w1, wb = i0 < i1 ? w1 : w0;
            const int pidx = (ea == 0) ? (eb - 1) : (ea == 1 ? eb + 1 : 5);
            const int cls = gi * 6 + pidx;
            ((int*)(F.ws + WS_ROUTE + RT_CLS))[r] = cls;
            ((float*)(F.ws + WS_ROUTE + RT_WTS))[2 * (size_t)r] = wa; ((float*)(F.ws + WS_ROUTE + RT_WTS))[2 * (size_t)r + 1] = wb;
            atomicAdd((int*)&cnt[cls], 1);
        }
    }
    if (ROUTER) {
        __syncthreads();
        if (F.tid < NCLS) ((int*)(F.ws + WS_ROUTE + RT_CNT))[F.bid * NCLS + F.tid] = cnt[F.tid];
    }
}

struct MoeTab { LAS int* base; LAS int* tot; LAS int* mine; LAS int* ntile; };
__device__ __forceinline__ MoeTab moe_tables(Frame& F, LAS unsigned char* at, bool with_mine) {
    MoeTab T; T.base = (LAS int*)at; T.tot = T.base + 32; T.mine = T.tot + 32; T.ntile = T.mine + 32;
    const int* cnt = (const int*)(F.ws + WS_ROUTE + RT_CNT);
    LAS int* part = T.ntile + 32;
    __syncthreads();
    { const int c = F.tid & 31, pt = F.tid >> 5; int t = 0, m = 0;
      if (c < NCLS) {
#pragma unroll
          for (int i = 0; i < 16; ++i) { const int w = pt * 16 + i; const int v = cnt[w * NCLS + c]; t += v; m += (w < F.bid) ? v : 0; } }
      part[(pt * 2 + 0) * 32 + c] = t; part[(pt * 2 + 1) * 32 + c] = m; }
    __syncthreads();
    if (F.tid < NCLS) { int t = 0, m = 0; for (int pt = 0; pt < 16; ++pt) { t += part[(pt * 2 + 0) * 32 + F.tid]; m += part[(pt * 2 + 1) * 32 + F.tid]; } T.tot[F.tid] = t; T.mine[F.tid] = m; }
    __syncthreads();
    if (F.tid == 0) { int pos = 0; for (int c = 0; c < NCLS; ++c) { T.base[c] = pos; pos += ((T.tot[c] + 255) >> 8) << 8; } T.ntile[0] = pos >> 8; }
    __syncthreads();
    (void)with_mine;
    return T;
}
__device__ __forceinline__ void cls_experts(int cls, int& ea, int& eb) {
    const int g = cls / 6, pi = cls % 6; int a, b;
    if (pi < 3) { a = 0; b = pi + 1; } else if (pi < 5) { a = 1; b = pi - 1; } else { a = 2; b = 3; }
    ea = g * 4 + a; eb = g * 4 + b;
}
template <int LAYER> __device__ __forceinline__ void route_phase(Frame& F) {
    MoeTab T = moe_tables(F, F.lds, true);
    LAS int* posr = (LAS int*)(F.lds + 8192);
    const int* clsg = (const int*)(F.ws + WS_ROUTE + RT_CLS);
    int* tok = (int*)(F.ws + WS_ROUTE + RT_TOK); float* wpos = (float*)(F.ws + WS_ROUTE + RT_WPOS); const float* wts = (const float*)(F.ws + WS_ROUTE + RT_WTS);
    const int r0 = F.bid * ROWS_PER_WG;
    if (F.wave == 0) {
        int run = 0;
        for (int q = 0; q < 3; ++q) {
            const int i = q * 64 + F.lane; int cls = -1;
            if (i < ROWS_PER_WG) { const int r = r0 + i; if (!(LAYER == 1 && row_is_ctx(r))) cls = clsg[r]; }
            int mypos = -1;
            for (int c = 0; c < NCLS; ++c) {
                const unsigned long long mask = __ballot(cls == c);
                const int rank = __popcll(mask & ((1ull << F.lane) - 1ull));
                const int runc = __shfl(run, c);
                if (cls == c) mypos = T.base[c] + T.mine[c] + runc + rank;
                if (F.lane == c) run += __popcll(mask);
            }
            if (i < ROWS_PER_WG) posr[i] = mypos;
        }
    }
    __syncthreads();
    const bf16_t* HB = (const bf16_t*)(F.ws + WS_HB); bf16_t* H2S = (bf16_t*)(F.ws + WS_H2S);
    for (int ri = 0; ri < ROWS_PER_WAVE; ++ri) {
        const int i = F.wave * ROWS_PER_WAVE + ri, r = r0 + i, pos = posr[i];
        if (pos < 0) continue;
        const u32x4* s = (const u32x4*)(HB + (size_t)r * D); u32x4* d = (u32x4*)(H2S + (size_t)pos * D);
        d[F.lane] = s[F.lane]; d[64 + F.lane] = s[64 + F.lane];
        if (F.lane == 0) { tok[pos] = r; wpos[2 * (size_t)pos] = wts[2 * (size_t)r]; wpos[2 * (size_t)pos + 1] = wts[2 * (size_t)r + 1]; }
    }
    if (F.bid < NCLS) {
        const int c = F.bid, lo = T.base[c] + T.tot[c], hi = T.base[c] + (((T.tot[c] + 255) >> 8) << 8);
        for (int p = lo + F.tid; p < hi; p += NTHREADS) { tok[p] = -1; wpos[2 * (size_t)p] = 0.f; wpos[2 * (size_t)p + 1] = 0.f; }
    }
}
namespace pg8 {
constexpr int BM = 256, BK = 64, HALF = 128, HTB = HALF * BK * 2, STAGE_BYTES = 8 * HTB;
__host__ __device__ __forceinline__ int lds_byte(int r, int c) { const int st = (r >> 4) * 2 + (c >> 5), rr = r & 15, cc = c & 31, ob = rr * 64 + cc * 2; return st * 1024 + (ob ^ (((ob >> 9) & 1) << 5)); }
__host__ __device__ __forceinline__ void stage_rc(int b, int& R_, int& C_) { const int st = b / 1024, sb = b % 1024, swz = sb ^ (((sb >> 9) & 1) << 5); R_ = (st >> 1) * 16 + swz / 64; C_ = (st & 1) * 32 + (swz % 64) / 2; }
__host__ __device__ __forceinline__ int perm32(int rho) { const int n = rho >> 4, i = rho & 15; return 8 * (i >> 2) + 4 * n + (i & 3); }

struct Unit { const char* a; const char* b; int bdelta; int pm, pn, aux; };
struct Gemm { int pitchA, pitchB, K; };

template <class Epi, class Sched, bool ALIGN_EPI>
__device__ __forceinline__ void gemm_phase(LAS unsigned char* lds, const Gemm g, const Sched& S, const Epi& E) {
    const int tid = opaque_tid(), wid = __builtin_amdgcn_readfirstlane(tid >> 6), lane = tid & 63, wr = wid >> 2, wc = wid & 3, fr = lane & 15, fq = lane >> 4;
    const int K = g.K, nt = K / BK;
    unsigned voffA[2], voffB[2];
#pragma unroll
    for (int i = 0; i < 2; ++i) { int R_, C_; stage_rc(tid * 16 + i * 8192, R_, C_); const int Rb = Epi::PERM ? ((R_ & ~31) + perm32(R_ & 31)) : R_;
        voffA[i] = (unsigned)(R_ * g.pitchA + C_) * 2u; voffB[i] = (unsigned)(Rb * g.pitchB + C_) * 2u; }
    const size_t kstep = (size_t)(BK * 2);
    const size_t hstepA = (size_t)HALF * g.pitchA * 2, hstepB = (size_t)HALF * g.pitchB * 2;
    const unsigned ldsw = (unsigned)wid * 1024u;
    const int aoff = lds_byte(wr * 64 + fr, fq * 8), boff = lds_byte(wc * 32 + fr, fq * 8);
#define PG8_SA(b, h) (((b) * 2 + (h)) * HTB)
#define PG8_SB(b, h) ((4 + (b) * 2 + (h)) * HTB)
#define PG8_STAGE(bufoff, gbase, voff) do { _Pragma("unroll") for (int _i = 0; _i < 2; ++_i) \
        __builtin_amdgcn_global_load_lds((const unsigned*)((const char*)(gbase) + (voff)[_i]), (LAS unsigned*)(lds + (bufoff) + ldsw + _i * 8192), 16, 0, 0); } while (0)
#define PG8_LDA(dst, b, h) do { _Pragma("unroll") for (int m = 0; m < 4; ++m) _Pragma("unroll") for (int k = 0; k < 2; ++k) dst[m][k] = *(const LAS bf16x8*)(lds + PG8_SA(b, h) + aoff + m * 2048 + k * 1024); } while (0)
#define PG8_LDB(dst, b, h) do { _Pragma("unroll") for (int n = 0; n < 2; ++n) _Pragma("unroll") for (int k = 0; k < 2; ++k) dst[n][k] = *(const LAS bf16x8*)(lds + PG8_SB(b, h) + boff + n * 2048 + k * 1024); } while (0)
#define PG8_MMA(ai, bj, At, Bt) do { __builtin_amdgcn_s_setprio(1); _Pragma("unroll") for (int m = 0; m < 4; ++m) _Pragma("unroll") for (int n = 0; n < 2; ++n) _Pragma("unroll") for (int k = 0; k < 2; ++k) \
        acc[ai][bj][m][n] = __builtin_amdgcn_mfma_f32_16x16x32_bf16(Bt[n][k], At[m][k], acc[ai][bj][m][n], 0, 0, 0); __builtin_amdgcn_s_setprio(0); } while (0)
#define PG8_WAIT_V(n) asm volatile("s_waitcnt vmcnt(" #n ")" ::: "memory")
#define PG8_WAIT_L(n) asm volatile("s_waitcnt lgkmcnt(" #n ")" ::: "memory")
#define PG8_BAR __builtin_amdgcn_s_barrier()
#define PG8_SCHED __builtin_amdgcn_sched_barrier(0)
    Unit cur, nxt; int ui = 0;
    if (!S.next(0, cur)) return;
    f32x4 acc[2][2][4][2];
#pragma unroll
    for (int a = 0; a < 2; ++a)
#pragma unroll
        for (int b = 0; b < 2; ++b)
#pragma unroll
            for (int m = 0; m < 4; ++m)
#pragma unroll
                for (int n = 0; n < 2; ++n) acc[a][b][m][n] = (f32x4){0.f, 0.f, 0.f, 0.f};
    bf16x8 At[4][2], B0[2][2], B1[2][2];
    const char* cA = cur.a; const char* cB = cur.b;
    PG8_STAGE(PG8_SB(0, 0), cB, voffB); PG8_STAGE(PG8_SB(0, 1), cB + hstepB, voffB); PG8_STAGE(PG8_SA(0, 0), cA, voffA); PG8_STAGE(PG8_SA(0, 1), cA + hstepA, voffA);
    if (wr == 1) PG8_BAR;
    PG8_WAIT_V(2); PG8_BAR;
    PG8_STAGE(PG8_SB(1, 0), cB + kstep, voffB); PG8_STAGE(PG8_SA(1, 0), cA + kstep, voffA); PG8_STAGE(PG8_SB(1, 1), cB + hstepB + kstep, voffB);
    PG8_WAIT_V(6); PG8_BAR;
    for (;;) {
        const bool has_next = S.next(ui + 1, nxt);
        const char* nA = has_next ? nxt.a : cA; const char* nB = has_next ? nxt.b : cB;
        const int bdelta = cur.bdelta;
        for (int t = 0; t < nt; t += 2) {
            const bool last = (t == nt - 2);
            const char* a1 = cA + (size_t)(t + 1) * kstep;
            const char* a2 = last ? nA : cA + (size_t)(t + 2) * kstep;
            const char* b2 = last ? nB : cB + (size_t)(t + 2) * kstep + ((2 * (t + 2) >= nt) ? bdelta : 0);
            const char* a3 = a2 + kstep; const char* b3 = b2 + kstep;
            PG8_LDB(B0, 0, 0); PG8_LDB(B1, 0, 1); PG8_SCHED; PG8_LDA(At, 0, 0); PG8_STAGE(PG8_SA(1, 1), a1 + hstepA, voffA);
            PG8_WAIT_V(8); PG8_WAIT_L(0); PG8_BAR; PG8_MMA(0, 0, At, B0); PG8_MMA(0, 1, At, B1); PG8_BAR; PG8_SCHED;
            PG8_LDA(At, 0, 1); PG8_STAGE(PG8_SB(0, 0), b2, voffB); PG8_STAGE(PG8_SB(0, 1), b2 + hstepB, voffB); PG8_STAGE(PG8_SA(0, 0), a2, voffA);
            PG8_WAIT_V(8); PG8_WAIT_L(0); PG8_BAR; PG8_MMA(1, 0, At, B0); PG8_MMA(1, 1, At, B1); PG8_BAR; PG8_SCHED;
            PG8_LDB(B0, 1, 0); PG8_LDB(B1, 1, 1); PG8_SCHED; PG8_LDA(At, 1, 0); PG8_STAGE(PG8_SA(0, 1), a2 + hstepA, voffA);
            PG8_WAIT_V(8); PG8_WAIT_L(0); PG8_BAR; PG8_MMA(0, 0, At, B0); PG8_MMA(0, 1, At, B1); PG8_BAR; PG8_SCHED;
            PG8_LDA(At, 1, 1); PG8_STAGE(PG8_SB(1, 0), b3, voffB); PG8_STAGE(PG8_SB(1, 1), b3 + hstepB, voffB); PG8_STAGE(PG8_SA(1, 0), a3, voffA);
            PG8_WAIT_V(8); PG8_WAIT_L(0); PG8_BAR; PG8_MMA(1, 0, At, B0); PG8_MMA(1, 1, At, B1); PG8_BAR; PG8_SCHED;
        }
        if constexpr (ALIGN_EPI) { if (wr == 0) PG8_BAR; }
        E(acc, cur, wr, wc, fr, fq);
        if (!has_next) break;
#pragma unroll
        for (int a = 0; a < 2; ++a)
#pragma unroll
            for (int b = 0; b < 2; ++b)
#pragma unroll
                for (int m = 0; m < 4; ++m)
#pragma unroll
                    for (int n = 0; n < 2; ++n) acc[a][b][m][n] = (f32x4){0.f, 0.f, 0.f, 0.f};
        cur = nxt; cA = nA; cB = nB; ++ui;
        if constexpr (ALIGN_EPI) { if (wr == 1) PG8_BAR; }
    }
    PG8_WAIT_V(0);
    if constexpr (!ALIGN_EPI) { if (wr == 0) PG8_BAR; }
    PG8_BAR;
#undef PG8_SA
#undef PG8_SB
#undef PG8_STAGE
#undef PG8_LDA
#undef PG8_LDB
#undef PG8_MMA
#undef PG8_WAIT_V
#undef PG8_WAIT_L
#undef PG8_BAR
#undef PG8_SCHED
}

__device__ __forceinline__ bool order_next(int i, int G, int c, int nM, int nN, int& im, int& pn) {
    const int nwg = nM * nN; const long L = (long)i * G + c; if (L >= nwg) return false;
    int wgid = (int)L; { const int q = nwg / 8, r = nwg % 8, xcd = wgid % 8, off = wgid / 8; wgid = (xcd < r ? xcd * (q + 1) : r * (q + 1) + (xcd - r) * q) + off; }
    const int WGM = 8, nig = WGM * nN, gid = wgid / nig, fm = gid * WGM, gsz = (nM - fm) < WGM ? (nM - fm) : WGM;
    im = fm + ((wgid % nig) % gsz); pn = (wgid % nig) / gsz; return true;
}
template <bool LATENT> struct DenseSched {
    const char* A; const char* B; int nN, G, c; size_t strideA, strideB;
    __device__ __forceinline__ bool next(int i, Unit& u) const {
        int im, pn; if (!order_next(i, G, c, LATENT ? 128 : 144, nN, im, pn)) return false;
        const int tile = LATENT ? (9 * (im >> 3) + 1 + (im & 7)) : im;
        u.a = A + (size_t)tile * strideA; u.b = B + (size_t)pn * strideB; u.bdelta = 0; u.pm = tile; u.pn = pn; u.aux = 0; return true;
    }
};
struct MoeSched {
    const char* A; const char* B; int nN, G, c, nT; const LAS int* base; bool down;
    __device__ __forceinline__ bool next(int i, Unit& u) const {
        const long L = (long)i * G + c; if (L >= (long)nT * nN) return false;
        const int tile = (int)(L % nT), un = (int)(L / nT);
        int cls = 0;
#pragma unroll 1
        for (int q = 1; q < NCLS; ++q) if (base[q] <= tile * 256) cls = q;
        int ea, eb; cls_experts(cls, ea, eb);
        u.pm = tile; u.pn = un; u.a = A + (size_t)tile * (256 * 1024 * 2);
        if (!down) { const int e = (un < 4) ? ea : eb, blk = un & 3; u.b = B + (size_t)e * (1024 * 1024 * 2) + (size_t)blk * (256 * 1024 * 2); u.bdelta = 0; u.aux = un; }
        else { u.b = B + (size_t)un * (256 * 8192 * 2) + (size_t)ea * 1024; u.bdelta = (eb - ea - 1) * 1024; u.aux = 0; }
        return true;
    }
};

struct EpiStoreBf16 {
    static constexpr bool PERM = true;
    bf16_t* O; int ldc;
    __device__ __forceinline__ void operator()(const f32x4 (&acc)[2][2][4][2], const Unit& u, int wr, int wc, int fr, int fq) const {
        const int row0 = u.pm * BM + wr * 64 + fr, col0 = u.pn * BM + wc * 32 + 8 * fq;
#pragma unroll
        for (int ai = 0; ai < 2; ++ai)
#pragma unroll
            for (int m = 0; m < 4; ++m) { bf16_t* rowp = O + (size_t)(row0 + ai * HALF + m * 16) * ldc + col0;
#pragma unroll
                for (int bj = 0; bj < 2; ++bj) { const f32x4 v0 = acc[ai][bj][m][0], v1 = acc[ai][bj][m][1];
                    u32x4 w; w.x = pk2(v0[0], v0[1]); w.y = pk2(v0[2], v0[3]); w.z = pk2(v1[0], v1[1]); w.w = pk2(v1[2], v1[3]);
                    *(u32x4*)(rowp + bj * HALF) = w; } }
    }
};
struct EpiResid {
    static constexpr bool PERM = false;
    const float* xin; const float* ctxin; float* outp; float* xrc; const float* mod  ; bool from_inputs;
    __device__ __forceinline__ void operator()(const f32x4 (&acc)[2][2][4][2], const Unit& u, int wr, int wc, int fr, int fq) const {
        const int b = u.pm / 9, t9 = u.pm % 9; const bool isctx = t9 == 0;
        const size_t rowoff = isctx ? (size_t)b * CTXL : (size_t)b * SEQ + (size_t)(t9 - 1) * 256;
        float* dst = (isctx ? xrc : outp) + rowoff * D;
        const float* src = from_inputs ? ((isctx ? ctxin : xin) + rowoff * D) : dst;
        const float* gv = mod + (isctx ? 16 : b) * 6144;
        const int col0 = u.pn * BM + wc * 32 + 4 * fq;
        f32x4 g4[2][2];
#pragma unroll
        for (int bj = 0; bj < 2; ++bj)
#pragma unroll
            for (int n = 0; n < 2; ++n) g4[bj][n] = *(const f32x4*)(gv + col0 + bj * HALF + n * 16);
#pragma unroll
        for (int ai = 0; ai < 2; ++ai)
#pragma unroll
            for (int m = 0; m < 4; ++m) { const size_t off = (size_t)(ai * HALF + wr * 64 + m * 16 + fr) * D + col0;
#pragma unroll
                for (int bj = 0; bj < 2; ++bj)
#pragma unroll
                    for (int n = 0; n < 2; ++n) { const f32x4 s = *(const f32x4*)(src + off + bj * HALF + n * 16);
                        *(f32x4*)(dst + off + bj * HALF + n * 16) = s + g4[bj][n] * acc[ai][bj][m][n]; } }
    }
};
struct EpiGlu {
    static constexpr bool PERM = true;
    const bf16_t* G; bf16_t* O; const float* bias;
    __device__ __forceinline__ void operator()(const f32x4 (&acc)[2][2][4][2], const Unit& u, int wr, int wc, int fr, int fq) const {
        const int row0 = u.pm * BM + wr * 64 + fr, col0 = u.pn * BM + wc * 32 + 8 * fq;
#pragma unroll
        for (int bj = 0; bj < 2; ++bj) { const f32x4 b0 = *(const f32x4*)(bias + col0 + bj * HALF), b1 = *(const f32x4*)(bias + col0 + bj * HALF + 4);
#pragma unroll
            for (int ai = 0; ai < 2; ++ai)
#pragma unroll
                for (int m = 0; m < 4; ++m) { const int row = row0 + ai * HALF + m * 16;
                    const u32x4 gq = *(const u32x4*)(G + (size_t)row * 512 + col0 + bj * HALF);
                    const f32x4 v0 = acc[ai][bj][m][0] + b0, v1 = acc[ai][bj][m][1] + b1;
                    u32x4 w;
                    w.x = pk2(bflo(gq.x) * sigmoidf_(v0[0]), bfhi(gq.x) * sigmoidf_(v0[1])); w.y = pk2(bflo(gq.y) * sigmoidf_(v0[2]), bfhi(gq.y) * sigmoidf_(v0[3]));
                    w.z = pk2(bflo(gq.z) * sigmoidf_(v1[0]), bfhi(gq.z) * sigmoidf_(v1[1])); w.w = pk2(bflo(gq.w) * sigmoidf_(v1[2]), bfhi(gq.w) * sigmoidf_(v1[3]));
                    *(u32x4*)(O + (size_t)row * D + col0 + bj * HALF) = w; } }
    }
};
struct EpiSwiGlu {
    static constexpr bool PERM = true;
    bf16_t* ACT; const float* wpos;
    __device__ __forceinline__ void operator()(const f32x4 (&acc)[2][2][4][2], const Unit& u, int wr, int wc, int fr, int fq) const {
        const int slot = u.aux >> 2, blk = u.aux & 3;
        const int row0 = u.pm * BM + wr * 64 + fr, col0 = slot * 512 + blk * 128 + wc * 32 + 8 * fq;
#pragma unroll
        for (int ai = 0; ai < 2; ++ai)
#pragma unroll
            for (int m = 0; m < 4; ++m) { const int row = row0 + ai * HALF + m * 16; const float w = wpos[2 * (size_t)row + slot];
                const f32x4 g0 = acc[ai][0][m][0], g1 = acc[ai][0][m][1], u0 = acc[ai][1][m][0], u1 = acc[ai][1][m][1];
                u32x4 o;
                o.x = pk2(w * siluf_(g0[0]) * u0[0], w * siluf_(g0[1]) * u0[1]); o.y = pk2(w * siluf_(g0[2]) * u0[2], w * siluf_(g0[3]) * u0[3]);
                o.z = pk2(w * siluf_(g1[0]) * u1[0], w * siluf_(g1[1]) * u1[1]); o.w = pk2(w * siluf_(g1[2]) * u1[2], w * siluf_(g1[3]) * u1[3]);
                *(u32x4*)(ACT + (size_t)row * D + col0) = o; }
    }
};
struct EpiDown {
    static constexpr bool PERM = false;
    const int* tok; float* outp; float* xrc; const float* mod  ;
    __device__ __forceinline__ void operator()(const f32x4 (&acc)[2][2][4][2], const Unit& u, int wr, int wc, int fr, int fq) const {
        const int col0 = u.pn * BM + wc * 32 + 4 * fq;
#pragma unroll
        for (int ai = 0; ai < 2; ++ai)
#pragma unroll
            for (int m = 0; m < 4; ++m) { const int pos = u.pm * BM + ai * HALF + wr * 64 + m * 16 + fr; const int r = tok[pos];
                if (r >= 0) { const int b = r / LT, p = r % LT; const bool isctx = p < CTXL;
                    float* dst = (isctx ? xrc + ((size_t)(b * CTXL + p)) * D : outp + ((size_t)(b * SEQ + p - CTXL)) * D) + col0;
                    const float* gv = mod + (isctx ? 16 : b) * 6144 + col0;
#pragma unroll
                    for (int bj = 0; bj < 2; ++bj)
#pragma unroll
                        for (int n = 0; n < 2; ++n) { const f32x4 s = *(const f32x4*)(dst + bj * HALF + n * 16), g = *(const f32x4*)(gv + bj * HALF + n * 16);
                            *(f32x4*)(dst + bj * HALF + n * 16) = s + g * acc[ai][bj][m][n]; } } }
    }
};
}
namespace attn_body {
constexpr int DH = 64, PQ = NP0, PO = D;
constexpr int NW = 8, QBLK = 32, QB = QBLK * NW, KVBLK = 64;
__device__ __forceinline__ int crow(int r, int hi) { return (r & 3) + 8 * (r >> 2) + 4 * hi; }
#define SBAR() __builtin_amdgcn_sched_barrier(0)
constexpr int NSLOT = 3, SLOTB = 8192;
constexpr int LDS_K = 0, LDS_V = NSLOT * SLOTB, LDS_WS = 2 * NSLOT * SLOTB, LDS_OST = LDS_WS + NW * 64 * 4, LDS_BYTES_A = LDS_OST + NW * 4096;
constexpr float C2 = 0.125f * 1.4426950408889634f;
__device__ __forceinline__ void glds16(const void* gsrc, unsigned lds_dst) { unsigned keep;
    asm volatile("s_mov_b32 %0, m0\n\ts_mov_b32 m0, %2\n\ts_nop 0\n\tglobal_load_lds_dwordx4 %1, off\n\ts_mov_b32 m0, %0" : "=&s"(keep) : "v"(gsrc), "s"(lds_dst) : "memory"); }
__device__ __forceinline__ float max3f(float a, float b, float c) { float r; asm("v_max3_f32 %0, %1, %2, %3" : "=v"(r) : "v"(a), "v"(b), "v"(c)); return r; }
__device__ __forceinline__ float max2f(float a, float b) { float r; asm("v_max_f32_e32 %0, %1, %2" : "=v"(r) : "v"(a), "v"(b)); return r; }
__device__ __forceinline__ float fadd_s(float a, float b) { float r; asm("v_add_f32_e32 %0, %1, %2" : "=v"(r) : "v"(a), "v"(b)); return r; }
__device__ __forceinline__ float fsub_s(float a, float b) { float r; asm("v_sub_f32_e32 %0, %1, %2" : "=v"(r) : "v"(a), "v"(b)); return r; }
__device__ __forceinline__ unsigned cvtpk_s(float lo, float hi) { return pk2(lo, hi); }
#define WAIT_BAR(N) asm volatile("s_waitcnt vmcnt(" #N ") lgkmcnt(0)\n\ts_barrier" ::: "memory")

__device__ __forceinline__ void qkt(f32x16& p0, f32x16& p1, const char* Kslot, const bf16x8* qr, const f32x16& negm, int r32, int hi) {
    const char* kb = Kslot + hi * 1024 + r32 * 16;
#pragma unroll
    for (int d0 = 0; d0 < 4; ++d0) {
        const bf16x8 b0 = *reinterpret_cast<const bf16x8*>(kb + d0 * 2048);
        const bf16x8 b1 = *reinterpret_cast<const bf16x8*>(kb + d0 * 2048 + 512);
        if (d0 == 0) { p0 = __builtin_amdgcn_mfma_f32_32x32x16_bf16(b0, qr[0], negm, 0, 0, 0); p1 = __builtin_amdgcn_mfma_f32_32x32x16_bf16(b1, qr[0], negm, 0, 0, 0); }
        else { p0 = __builtin_amdgcn_mfma_f32_32x32x16_bf16(b0, qr[d0], p0, 0, 0, 0); p1 = __builtin_amdgcn_mfma_f32_32x32x16_bf16(b1, qr[d0], p1, 0, 0, 0); } }
}
typedef __attribute__((address_space(3))) const char* lds_cptr;
typedef short v4i16_t __attribute__((ext_vector_type(4)));
__device__ __forceinline__ void kload8(bf16x8* kf, lds_cptr kp) {
    kf[0] = *(const LAS bf16x8*)(kp);        kf[1] = *(const LAS bf16x8*)(kp + 512);
    kf[2] = *(const LAS bf16x8*)(kp + 2048); kf[3] = *(const LAS bf16x8*)(kp + 2560);
    kf[4] = *(const LAS bf16x8*)(kp + 4096); kf[5] = *(const LAS bf16x8*)(kp + 4608);
    kf[6] = *(const LAS bf16x8*)(kp + 6144); kf[7] = *(const LAS bf16x8*)(kp + 6656);
}
__device__ __forceinline__ void kload2(bf16x8* kf, lds_cptr kp, int j) { kf[2 * j] = *(const LAS bf16x8*)(kp + j * 2048); kf[2 * j + 1] = *(const LAS bf16x8*)(kp + j * 2048 + 512); }
__device__ __forceinline__ s16x4 vtr(lds_cptr p) { return __builtin_bit_cast(s16x4, __builtin_amdgcn_ds_read_tr16_b64_v4i16((LAS v4i16_t*)p)); }
__device__ __forceinline__ float rowmax(const f32x16& p0, const f32x16& p1) {
    float a = max3f(p0[0], p0[1], p1[0]), b = max3f(p0[2], p0[3], p1[1]); a = max3f(a, p1[2], p1[3]);
#pragma unroll
    for (int r = 4; r < 16; r += 4) { a = max3f(a, p0[r], p0[r + 1]); b = max3f(b, p0[r + 2], p0[r + 3]); a = max3f(a, p1[r], p1[r + 1]); b = max3f(b, p1[r + 2], p1[r + 3]); }
    const float m = max2f(a, b);
    auto rr = __builtin_amdgcn_permlane32_swap(__float_as_uint(m), __float_as_uint(m), false, false);
    return max2f(__uint_as_float(rr[0]), __uint_as_float(rr[1]));
}
__device__ __forceinline__ void pv(f32x16* o, int vb, bf16x8 pa0, bf16x8 pa1, bf16x8 pa2, bf16x8 pa3) {
#pragma unroll
    for (int d0 = 0; d0 < 2; ++d0) { s16x4 lo[4], hi[4];
#pragma unroll
        for (int ks = 0; ks < 4; ++ks) {
            asm volatile("ds_read_b64_tr_b16 %0,%1 offset:%c2" : "=&v"(lo[ks]) : "v"(vb), "i"(d0 * 4096 + ks * 1024) : "memory");
            asm volatile("ds_read_b64_tr_b16 %0,%1 offset:%c2" : "=&v"(hi[ks]) : "v"(vb), "i"(d0 * 4096 + ks * 1024 + 512) : "memory"); }
        asm volatile("s_waitcnt lgkmcnt(0)" ::: "memory"); SBAR();
#define PK(k) (bf16x8){lo[k][0], lo[k][1], lo[k][2], lo[k][3], hi[k][0], hi[k][1], hi[k][2], hi[k][3]}
        o[d0] = __builtin_amdgcn_mfma_f32_32x32x16_bf16(pa0, PK(0), o[d0], 0, 0, 0);
        o[d0] = __builtin_amdgcn_mfma_f32_32x32x16_bf16(pa1, PK(1), o[d0], 0, 0, 0);
        o[d0] = __builtin_amdgcn_mfma_f32_32x32x16_bf16(pa2, PK(2), o[d0], 0, 0, 0);
        o[d0] = __builtin_amdgcn_mfma_f32_32x32x16_bf16(pa3, PK(3), o[d0], 0, 0, 0);
#undef PK
    }
}
__device__ __forceinline__ void rope_cs(float pos, int i, float& c, float& s) {
    const float inv = exp2f(-(float)i * 0.83048202372184058696f);
    float rev = pos * inv * 0.15915494309189533577f; rev = rev - floorf(rev);
    c = __builtin_amdgcn_cosf(rev); s = __builtin_amdgcn_sinf(rev);
}

template <int THRL> __device__ __forceinline__ void attn_unit(int b, int h, int qb, const bf16_t* Pbuf, bf16_t* O, const float* qgain, char* shm) {
    const int tid = opaque_tid(), lane = tid & 63, r32 = lane & 31, hi = lane >> 5; const int wid = __builtin_amdgcn_readfirstlane(tid >> 6);
    const long rowbase = (long)b * LT; const int q0 = qb * QB; const int kvh = h >> 2;
    const bf16_t* Qw = Pbuf + (rowbase + q0 + wid * QBLK) * PQ + C_AQ + h * DH;
    const bf16_t* Kh = Pbuf + rowbase * PQ + C_AK + kvh * DH; const bf16_t* Vh = Pbuf + rowbase * PQ + C_AV + kvh * DH;
    const unsigned lds0 = (unsigned)(uintptr_t)shm;
    float* wsf = (float*)(shm + LDS_WS) + wid * 64;
    const bf16_t* ksrc = Kh + (long)lane * PQ + wid * 8;
    const bf16_t* vsrc = Vh + (long)(16 * (wid & 3) + (lane >> 2)) * PQ + (wid >> 2) * 32 + (lane & 3) * 8;
    const unsigned kdst = lds0 + LDS_K + wid * 1024, vdst = lds0 + LDS_V + wid * 1024;
#define DMA_K(t, slot) glds16(ksrc + (long)(t) * KVBLK * PQ, (unsigned)__builtin_amdgcn_readfirstlane(kdst + (slot)))
#define DMA_V(t, slot) glds16(vsrc + (long)(t) * KVBLK * PQ, (unsigned)__builtin_amdgcn_readfirstlane(vdst + (slot)))
    const int vb0 = (int)(lds0 + LDS_V) + ((lane >> 4) & 1) * 32 + (lane & 3) * 8 + (4 * hi + ((lane & 15) >> 2)) * 64;
    const char* Kbase = shm + LDS_K; bf16x8 kf[8];
    const lds_cptr shm3 = (lds_cptr)shm; const lds_cptr kp0 = shm3 + LDS_K + hi * 1024 + r32 * 16; const lds_cptr vp0 = shm3 + LDS_V + ((lane >> 4) & 1) * 32 + (lane & 3) * 8 + (4 * hi + ((lane & 15) >> 2)) * 64;
    const int NT = (qb == 0) ? (CTXL / KVBLK) : (LT / KVBLK);
    DMA_K(0, 0); DMA_V(0, 0); DMA_K(1, SLOTB);
    bf16x8 qr[4];
    {
        u32x4 raw[4];
#pragma unroll
        for (int d0 = 0; d0 < 4; ++d0) raw[d0] = *reinterpret_cast<const u32x4*>(&Qw[(long)r32 * PQ + d0 * 16 + hi * 8]);
        float qf[4][8]; float ss = 0.f;
#pragma unroll
        for (int d0 = 0; d0 < 4; ++d0) {
            qf[d0][0] = bflo(raw[d0].x); qf[d0][1] = bfhi(raw[d0].x); qf[d0][2] = bflo(raw[d0].y); qf[d0][3] = bfhi(raw[d0].y);
            qf[d0][4] = bflo(raw[d0].z); qf[d0][5] = bfhi(raw[d0].z); qf[d0][6] = bflo(raw[d0].w); qf[d0][7] = bfhi(raw[d0].w);
#pragma unroll
            for (int j = 0; j < 8; ++j) ss += qf[d0][j] * qf[d0][j]; }
        ss += __shfl_xor(ss, 32);
        const float rstd = rsqrtf(ss * (1.f / 64.f) + NORM_EPS);
#pragma unroll
        for (int d0 = 0; d0 < 4; ++d0)
#pragma unroll
            for (int j = 0; j < 8; ++j) qf[d0][j] *= rstd * qgain[d0 * 16 + hi * 8 + j];
        if (qb > 0) {
            const int t = q0 - CTXL + wid * QBLK + r32; const float prow = (float)(t >> 6), pcol = (float)(t & 63);
#pragma unroll
            for (int j = 0; j < 8; ++j) { float c, s;
                rope_cs(prow, hi * 8 + j, c, s); { const float x1 = qf[0][j], x2 = qf[1][j]; qf[0][j] = x1 * c - x2 * s; qf[1][j] = x2 * c + x1 * s; }
                rope_cs(pcol, hi * 8 + j, c, s); { const float x1 = qf[2][j], x2 = qf[3][j]; qf[2][j] = x1 * c - x2 * s; qf[3][j] = x2 * c + x1 * s; } }
        }
#pragma unroll
        for (int d0 = 0; d0 < 4; ++d0) { u32x4 w; w.x = pk2(qf[d0][0] * C2, qf[d0][1] * C2); w.y = pk2(qf[d0][2] * C2, qf[d0][3] * C2); w.z = pk2(qf[d0][4] * C2, qf[d0][5] * C2); w.w = pk2(qf[d0][6] * C2, qf[d0][7] * C2);
            qr[d0] = __builtin_bit_cast(bf16x8, w); }
    }
    float mhat = 0.f, l_reg = 0.f; f32x16 o[2]; o[0] = f32x16{}; o[1] = f32x16{}; f32x16 negm = f32x16{}; asm volatile("" : "+v"(negm));
    bool resc = false;
#define START(P0, P1) do { const float rm = rowmax(P0, P1); resc = false; \
    { const float dl = rm; mhat = fadd_s(mhat, dl); \
      _Pragma("unroll") for (int r = 0; r < 16; ++r) { P0[r] = fsub_s(P0[r], dl); P1[r] = fsub_s(P1[r], dl); } \
      _Pragma("unroll") for (int r = 0; r < 16; ++r) negm[r] = -mhat; asm volatile("" : "+v"(negm)); } \
    _Pragma("unroll") for (int r = 0; r < 16; ++r) P0[r] = __builtin_amdgcn_exp2f(P0[r]); } while (0)
#define RESC() do { if (resc) { asm volatile("s_waitcnt lgkmcnt(0)" ::: "memory"); \
      _Pragma("unroll") for (int d_ = 0; d_ < 2; ++d_) _Pragma("unroll") for (int r = 0; r < 16; ++r) o[d_][r] *= wsf[crow(r, hi)]; } } while (0)
    f32x16 pA0, pA1, pB0, pB1;
    int sl_prev = 0, sl_cur = 0, sl_next = SLOTB;
#define ROT() do { sl_prev = sl_cur; sl_cur = sl_next; sl_next = (sl_next == (NSLOT - 1) * SLOTB) ? 0 : sl_next + SLOTB; } while (0)
    DMA_K(2, 2 * SLOTB);
    WAIT_BAR(3);
    qkt(pA0, pA1, Kbase, qr, negm, r32, hi); asm volatile("s_nop 15\n\ts_nop 7" : "+v"(pA0), "+v"(pA1));
    START(pA0, pA1);
    _Pragma("unroll") for (int r = 0; r < 16; ++r) pA1[r] = __builtin_amdgcn_exp2f(pA1[r]);
    WAIT_BAR(0);
    DMA_K(3, 0); DMA_V(1, SLOTB);
    ROT();
    kload8(kf, kp0 + sl_cur);
    WAIT_BAR(2);
    s16x4 vlo[8], vhi[8]; u32x4 pw0, pw1, pw2, pw3;
#define PKW(P, B) cvtpk_s(P[B], P[B + 1])
#define PAF(k) __builtin_bit_cast(bf16x8, pw##k)
#define VFR(i) (bf16x8){vlo[i][0], vlo[i][1], vlo[i][2], vlo[i][3], vhi[i][0], vhi[i][1], vhi[i][2], vhi[i][3]}
#define PIN(x) asm volatile("" : "+v"(x))
#define MX3(a, b, c) __builtin_fmaxf(__builtin_fmaxf((a), (b)), (c))
#define GAPA(MF, A0, A1, A2, A3, W0, W1, PW) do { MF; sacc += A0; sacc += A1; sacc += A2; sacc += A3; PIN(sacc); W0; W1; PIN(PW); SBAR(); } while (0)
#define EX(v) __builtin_amdgcn_exp2f(v)
#define GAPB(MF, X, B) do { MF; X[B] = EX(X[B]); X[B + 1] = EX(X[B + 1]); X[B + 2] = EX(X[B + 2]); X[B + 3] = EX(X[B + 3]); PIN(X); SBAR(); } while (0)
#define VRD(i) do { vlo[i] = vtr(vp_ + (((i) >> 2) * 4096 + ((i) & 3) * 1024)); vhi[i] = vtr(vp_ + (((i) >> 2) * 4096 + ((i) & 3) * 1024 + 512)); } while (0)
#define KRD(G_, j) do { if (G_) { kload2(kf, kp0 + sl_next, j); SBAR(); } } while (0)
#define STEP(C0, C1, P0, P1, t, GK, GV, GL) do { SBAR(); \
    const lds_cptr vp_ = vp0 + sl_prev; \
    VRD(0); SBAR(); float sacc = (P0[0] + P0[1]); \
    GAPA(C0 = __builtin_amdgcn_mfma_f32_32x32x16_bf16(kf[0], qr[0], negm, 0, 0, 0), P0[2], P0[3], P0[4], P0[5],     pw0[0] = PKW(P0, 0), pw0[1] = PKW(P0, 2), pw0); \
    VRD(4); SBAR(); GAPA(C1 = __builtin_amdgcn_mfma_f32_32x32x16_bf16(kf[1], qr[0], negm, 0, 0, 0), P0[6], P0[7], P0[8], P0[9],     pw0[2] = PKW(P0, 4), pw0[3] = PKW(P0, 6), pw0); \
    VRD(1); SBAR(); GAPA(C0 = __builtin_amdgcn_mfma_f32_32x32x16_bf16(kf[2], qr[1], C0, 0, 0, 0),   P0[10], P0[11], P0[12], P0[13], pw1[0] = PKW(P0, 8), pw1[1] = PKW(P0, 10), pw1); \
    VRD(5); SBAR(); GAPA(C1 = __builtin_amdgcn_mfma_f32_32x32x16_bf16(kf[3], qr[1], C1, 0, 0, 0),   P0[14], P0[15], P1[0], P1[1],   pw1[2] = PKW(P0, 12), pw1[3] = PKW(P0, 14), pw1); \
    VRD(2); SBAR(); GAPA(C0 = __builtin_amdgcn_mfma_f32_32x32x16_bf16(kf[4], qr[2], C0, 0, 0, 0),   P1[2], P1[3], P1[4], P1[5],     pw2[0] = PKW(P1, 0), pw2[1] = PKW(P1, 2), pw2); \
    VRD(6); SBAR(); GAPA(C1 = __builtin_amdgcn_mfma_f32_32x32x16_bf16(kf[5], qr[2], C1, 0, 0, 0),   P1[6], P1[7], P1[8], P1[9],     pw2[2] = PKW(P1, 4), pw2[3] = PKW(P1, 6), pw2); \
    VRD(3); SBAR(); GAPA(C0 = __builtin_amdgcn_mfma_f32_32x32x16_bf16(kf[6], qr[3], C0, 0, 0, 0),   P1[10], P1[11], P1[12], P1[13], pw3[0] = PKW(P1, 8), pw3[1] = PKW(P1, 10), pw3); \
    VRD(7); SBAR(); GAPA(C1 = __builtin_amdgcn_mfma_f32_32x32x16_bf16(kf[7], qr[3], C1, 0, 0, 0),   P1[14], P1[15], 0.f, 0.f,       pw3[2] = PKW(P1, 12), pw3[3] = PKW(P1, 14), pw3); \
    l_reg += sacc; \
    if (GK) { DMA_K((t) + 3, sl_cur); } if (GV) { DMA_V((t) + 1, sl_next); } \
    { float a = MX3(C0[0], C0[1], C1[0]), b_ = MX3(C0[2], C0[3], C1[1]); a = MX3(a, C1[2], C1[3]); \
      _Pragma("unroll") for (int r = 4; r < 16; r += 4) { a = MX3(a, C0[r], C0[r + 1]); b_ = MX3(b_, C0[r + 2], C0[r + 3]); a = MX3(a, C1[r], C1[r + 1]); b_ = MX3(b_, C1[r + 2], C1[r + 3]); } \
      float rm = __builtin_fmaxf(a, b_); { auto rr = __builtin_amdgcn_permlane32_swap(__float_as_uint(rm), __float_as_uint(rm), false, false); rm = __builtin_fmaxf(__uint_as_float(rr[0]), __uint_as_float(rr[1])); } \
      resc = false; \
      if (__builtin_expect(__any(rm > (float)THRL), 0)) { const float dl = __builtin_fmaxf(rm, 0.f); mhat += dl; \
        _Pragma("unroll") for (int r = 0; r < 16; ++r) { C0[r] -= dl; C1[r] -= dl; } \
        _Pragma("unroll") for (int r = 0; r < 16; ++r) negm[r] = -mhat; asm volatile("" : "+v"(negm)); \
        const float f = __builtin_amdgcn_exp2f(-dl); l_reg *= f; if (hi == 0) wsf[r32] = f; resc = true; } } \
    SBAR(); \
    GAPB(o[0] = __builtin_amdgcn_mfma_f32_32x32x16_bf16(PAF(0), VFR(0), o[0], 0, 0, 0), C0, 0); \
    GAPB(o[1] = __builtin_amdgcn_mfma_f32_32x32x16_bf16(PAF(0), VFR(4), o[1], 0, 0, 0), C0, 4); \
    KRD(GL, 0); GAPB(o[0] = __builtin_amdgcn_mfma_f32_32x32x16_bf16(PAF(1), VFR(1), o[0], 0, 0, 0), C0, 8); \
    KRD(GL, 1); GAPB(o[1] = __builtin_amdgcn_mfma_f32_32x32x16_bf16(PAF(1), VFR(5), o[1], 0, 0, 0), C0, 12); \
    KRD(GL, 2); GAPB(o[0] = __builtin_amdgcn_mfma_f32_32x32x16_bf16(PAF(2), VFR(2), o[0], 0, 0, 0), C1, 0); \
    KRD(GL, 3); GAPB(o[1] = __builtin_amdgcn_mfma_f32_32x32x16_bf16(PAF(2), VFR(6), o[1], 0, 0, 0), C1, 4); \
    GAPB(o[0] = __builtin_amdgcn_mfma_f32_32x32x16_bf16(PAF(3), VFR(3), o[0], 0, 0, 0), C1, 8); \
    GAPB(o[1] = __builtin_amdgcn_mfma_f32_32x32x16_bf16(PAF(3), VFR(7), o[1], 0, 0, 0), C1, 12); \
    } while (0)
    int t = 1;
    for (; t + 5 < NT; t += 2) {
        STEP(pB0, pB1, pA0, pA1, t, true, true, true);     WAIT_BAR(2); RESC(); ROT();
        STEP(pA0, pA1, pB0, pB1, t + 1, true, true, true); WAIT_BAR(2); RESC(); ROT();
    }
#define ENDW(tt) do { if ((tt) + 3 < NT) { WAIT_BAR(2); } else if ((tt) + 2 < NT) { WAIT_BAR(1); } else { WAIT_BAR(0); } } while (0)
    for (; t + 1 < NT; t += 2) {
        STEP(pB0, pB1, pA0, pA1, t, (t + 3 < NT), (t + 1 < NT), (t + 1 < NT));         ENDW(t);     RESC(); ROT();
        STEP(pA0, pA1, pB0, pB1, t + 1, (t + 4 < NT), (t + 2 < NT), (t + 2 < NT));     ENDW(t + 1); RESC(); ROT();
    }
    STEP(pB0, pB1, pA0, pA1, NT - 1, false, false, false); RESC();
    { float sacc = pB0[0] + pB0[1]; _Pragma("unroll") for (int r = 2; r < 16; ++r) sacc += pB0[r]; _Pragma("unroll") for (int r = 0; r < 16; ++r) sacc += pB1[r]; l_reg += sacc;
      pw0 = (u32x4){PKW(pB0, 0), PKW(pB0, 2), PKW(pB0, 4), PKW(pB0, 6)}; pw1 = (u32x4){PKW(pB0, 8), PKW(pB0, 10), PKW(pB0, 12), PKW(pB0, 14)}; pw2 = (u32x4){PKW(pB1, 0), PKW(pB1, 2), PKW(pB1, 4), PKW(pB1, 6)}; pw3 = (u32x4){PKW(pB1, 8), PKW(pB1, 10), PKW(pB1, 12), PKW(pB1, 14)};
      SBAR(); pv(o, vb0 + sl_cur, PAF(0), PAF(1), PAF(2), PAF(3)); }
#undef PKW
#undef PAF
#undef VFR
#undef PIN
#undef MX3
#undef GAPA
#undef GAPB
#undef EX
#undef VRD
#undef KRD
#undef STEP
#undef ENDW
    { auto rr = __builtin_amdgcn_permlane32_swap(__float_as_uint(l_reg), __float_as_uint(l_reg), false, false); l_reg = __uint_as_float(rr[0]) + __uint_as_float(rr[1]); }
    if (hi == 0) wsf[32 + r32] = l_reg; asm volatile("s_waitcnt lgkmcnt(0)" ::: "memory");
    float rli[16];
#pragma unroll
    for (int r = 0; r < 16; ++r) rli[r] = __builtin_amdgcn_rcpf(wsf[32 + crow(r, hi)]);
    bf16_t* Ow = O + (rowbase + q0 + wid * QBLK) * PO + 512 + h * DH;
    { bf16_t* stg = (bf16_t*)(shm + LDS_OST) + wid * 2048;
#pragma unroll
      for (int r = 0; r < 16; ++r) { const int orow = crow(r, hi);
#pragma unroll
          for (int d0 = 0; d0 < 2; ++d0) stg[orow * 64 + d0 * 32 + r32] = f2bf(o[d0][r] * rli[r]); }
      asm volatile("s_waitcnt lgkmcnt(0)" ::: "memory");
#pragma unroll
      for (int i = 0; i < 4; ++i) { const int row = i * 8 + (lane >> 3), ch = lane & 7; const u32x4 v = *(const u32x4*)(stg + row * 64 + ch * 8); *(u32x4*)(Ow + (long)row * PO + ch * 8) = v; } }
    asm volatile("s_waitcnt lgkmcnt(0)\n\ts_barrier" ::: "memory");
#undef DMA_K
#undef DMA_V
#undef START
#undef RESC
#undef ROT
}
#undef SBAR
#undef WAIT_BAR
}

__device__ __forceinline__ void knorm_phase(Frame& F) {
    bf16_t* Pb = (bf16_t*)(F.ws + WS_P); const float* kg = F.p->in[I_KNORM];
    const int kvh = F.lane >> 5, half = (F.lane >> 4) & 1, i = F.lane & 15, d1 = half * 32 + i, d2 = d1 + 16;
    const float g1 = kg[d1], g2 = kg[d2];
    const int r0 = F.bid * ROWS_PER_WG + F.wave * ROWS_PER_WAVE;
    for (int ri = 0; ri < ROWS_PER_WAVE; ++ri) {
        const int r = r0 + ri, p = r % LT;
        bf16_t* kp = Pb + (size_t)r * NP0 + C_AK + kvh * 64;
        float x1 = bf2f(kp[d1]), x2 = bf2f(kp[d2]);
        float ss = x1 * x1 + x2 * x2;
#pragma unroll
        for (int o = 1; o < 32; o <<= 1) ss += __shfl_xor(ss, o);
        const float rstd = rsqrtf(ss * (1.f / 64.f) + NORM_EPS);
        x1 *= rstd * g1; x2 *= rstd * g2;
        if (p >= CTXL) { const int t = p - CTXL; const float pos = half ? (float)(t & 63) : (float)(t >> 6); float c, s; attn_body::rope_cs(pos, i, c, s);
            const float y1 = x1 * c - x2 * s, y2 = x2 * c + x1 * s; x1 = y1; x2 = y2; }
        kp[d1] = f2bf(x1); kp[d2] = f2bf(x2);
    }
}
namespace mix {
typedef LAS unsigned char* lptr;
__device__ __forceinline__ bf16x8 frag(const LAS unsigned char* base, int pitch, int row0, int k0, int lane) {
    return *(const LAS bf16x8*)(base + (row0 + (lane & 15)) * pitch + (k0 + 8 * (lane >> 4)) * 2);
}
#define MFMA16(a, b, c) __builtin_amdgcn_mfma_f32_16x16x32_bf16(a, b, c, 0, 0, 0)
__device__ __forceinline__ float log_sigmoid(float x) { return fminf(x, 0.f) - log1pf(__expf(-fabsf(x))); }
__device__ __forceinline__ float softplus(float x) { return fmaxf(x, 0.f) + log1pf(__expf(-fabsf(x))); }
__device__ __forceinline__ float scan_add(float v, int lane) {
#pragma unroll
    for (int o = 1; o < 64; o <<= 1) { const float t = __shfl_up(v, o); if (lane >= o) v += t; }
    return v;
}
__device__ __forceinline__ float scan_max(float v, int lane) {
#pragma unroll
    for (int o = 1; o < 64; o <<= 1) { const float t = __shfl_up(v, o); if (lane >= o) v = fmaxf(v, t); }
    return v;
}
__device__ __forceinline__ void unpack8(const u32x4 r, float* f) { f[0] = bflo(r.x); f[1] = bfhi(r.x); f[2] = bflo(r.y); f[3] = bfhi(r.y); f[4] = bflo(r.z); f[5] = bfhi(r.z); f[6] = bflo(r.w); f[7] = bfhi(r.w); }

__device__ __forceinline__ void mlstm_unit(Frame& F, int b, int hd, int dir) {
    const int tid = F.tid, lane = F.lane, w = F.wave, l15 = lane & 15, l4 = lane >> 4;
    const bf16_t* Pb = (const bf16_t*)(F.ws + WS_P); const float* GT = (const float*)(F.ws + WS_GATES);
    bf16_t* Y = (bf16_t*)(F.ws + (dir ? WS_Y1 : WS_Y0));
    lptr L = F.lds;
    constexpr int PQK = 272, PT = 144;
    lptr Qs = L, Ks = L + 17408, Ktw = L + 34816, Vt = L + 53248, Sw = L + 71680, Cb = L + 80896;
    LAS float* fl = (LAS float*)(L + 115712);
    LAS float *rj = fl, *cs = fl + 64, *gg = fl + 128, *eneg = fl + 192, *wend = fl + 256, *denp = fl + 320  , *nq = fl + 448, *n0 = fl + 512  , *scl = fl + 640;
    const float gbi = F.p->in[I_MLGB][dir * 8 + hd], gbf = F.p->in[I_MLGB][dir * 8 + 4 + hd];
    for (int i = tid; i < 34816 / 4; i += NTHREADS) ((LAS unsigned*)Cb)[i] = 0u;
    if (tid < 128) n0[tid] = 0.f;
    f32x4 accC[8];
#pragma unroll
    for (int i = 0; i < 8; ++i) accC[i] = (f32x4){0.f, 0.f, 0.f, 0.f};
    float m0 = 0.f;
    const size_t rowb = (size_t)b * LT;
    const float kscale = 0.08838834764831845f;
    for (int c = 0; c < 36; ++c) {
        const int p0 = dir ? (c < 4 ? 255 - 64 * c : 2559 - 64 * c) : 64 * c; const int sg = dir ? -1 : 1;
        const size_t myrow = rowb + (size_t)(p0 + sg * lane);
        const bf16_t* prow = Pb + myrow * NP0 + hd * 128 + 16 * w;
        const u32x4 q0 = *(const u32x4*)(prow + C_MQ), q1 = *(const u32x4*)(prow + C_MQ + 8);
        const u32x4 k0 = *(const u32x4*)(prow + C_MK), k1 = *(const u32x4*)(prow + C_MK + 8);
        const u32x4 v0 = *(const u32x4*)(prow + C_MV), v1 = *(const u32x4*)(prow + C_MV + 8);
        if (w == 0) {
            const float li = GT[myrow * 16 + dir * 8 + hd] + gbi;
            const float lf = log_sigmoid(GT[myrow * 16 + dir * 8 + 4 + hd] + gbf);
            const float bb = scan_add(lf, lane);
            const float csv = li - bb;
            const float pm = scan_max(csv, lane);
            const float inter = bb + m0;
            const float mj = fmaxf(inter, bb + pm);
            const float bend = __shfl(bb, 63), pmend = __shfl(pm, 63);
            const float mnew = fmaxf(bend + m0, pmend + bend);
            rj[lane] = bb - mj; cs[lane] = csv; gg[lane] = __expf(inter - mj); eneg[lane] = __expf(-mj);
            wend[lane] = __expf(csv + bend - mnew);
            if (lane == 0) scl[0] = __expf(bend + m0 - mnew);
            m0 = mnew;
        }
        __syncthreads();
        {
            const float we = wend[lane];
            *(LAS u32x4*)(Qs + lane * PQK + (2 * w) * 16) = q0; *(LAS u32x4*)(Qs + lane * PQK + (2 * w + 1) * 16) = q1;
            float kf[16], vf[16]; unpack8(k0, kf); unpack8(k1, kf + 8); unpack8(v0, vf); unpack8(v1, vf + 8);
#pragma unroll
            for (int e = 0; e < 16; ++e) kf[e] *= kscale;
            u32x4 ka, kb2; ka.x = pk2(kf[0], kf[1]); ka.y = pk2(kf[2], kf[3]); ka.z = pk2(kf[4], kf[5]); ka.w = pk2(kf[6], kf[7]);
            kb2.x = pk2(kf[8], kf[9]); kb2.y = pk2(kf[10], kf[11]); kb2.z = pk2(kf[12], kf[13]); kb2.w = pk2(kf[14], kf[15]);
            *(LAS u32x4*)(Ks + lane * PQK + (2 * w) * 16) = ka; *(LAS u32x4*)(Ks + lane * PQK + (2 * w + 1) * 16) = kb2;
#pragma unroll
            for (int e = 0; e < 16; ++e) {
                *(LAS unsigned short*)(Ktw + (16 * w + e) * PT + lane * 2) = f2bf(kf[e] * we);
                *(LAS unsigned short*)(Vt + (16 * w + e) * PT + lane * 2) = f2bf(vf[e]);
            }
        }
        __syncthreads();
        {
            const int jt = w >> 1, sh = w & 1; float rsum = 0.f;
            const int j = 16 * jt + l15; const float rjj = rj[j];
#pragma unroll
            for (int si = 0; si < 2; ++si) {
                const int st = 2 * sh + si; const int s0 = 16 * st + 4 * l4;
                u32x2 o; o.x = 0u; o.y = 0u;
                if (st <= jt) {
                    f32x4 a = (f32x4){0.f, 0.f, 0.f, 0.f};
#pragma unroll
                    for (int ks = 0; ks < 4; ++ks) a = MFMA16(frag(Ks, PQK, 16 * st, 32 * ks, lane), frag(Qs, PQK, 16 * jt, 32 * ks, lane), a);
                    float vv[4];
#pragma unroll
                    for (int r = 0; r < 4; ++r) { const int s = s0 + r; vv[r] = (s <= j) ? a[r] * __expf(rjj + cs[s]) : 0.f; rsum += vv[r]; }
                    o.x = pk2(vv[0], vv[1]); o.y = pk2(vv[2], vv[3]);
                }
                *(LAS u32x2*)(Sw + j * PT + s0 * 2) = o;
            }
            rsum += __shfl_xor(rsum, 16); rsum += __shfl_xor(rsum, 32);
            if (l4 == 0) denp[sh * 64 + j] = rsum;
            const int jq = tid >> 3, kp = tid & 7; float a = 0.f;
            const u32x4 qa = *(const LAS u32x4*)(Qs + jq * PQK + kp * 32), qb = *(const LAS u32x4*)(Qs + jq * PQK + kp * 32 + 16);
            float qf[16]; unpack8(qa, qf); unpack8(qb, qf + 8);
#pragma unroll
            for (int e = 0; e < 16; ++e) a += qf[e] * n0[16 * kp + e];
            a += __shfl_xor(a, 1); a += __shfl_xor(a, 2); a += __shfl_xor(a, 4);
            if (kp == 0) nq[jq] = a;
        }
        __syncthreads();
        {
            const int jt = w & 3, vh = w >> 2, j = 16 * jt + l15;
            bf16x8 bS[2], bQ[4];
#pragma unroll
            for (int ks = 0; ks < 2; ++ks) bS[ks] = frag(Sw, PT, 16 * jt, 32 * ks, lane);
#pragma unroll
            for (int ks = 0; ks < 4; ++ks) bQ[ks] = frag(Qs, PQK, 16 * jt, 32 * ks, lane);
            const float g = gg[j], den = denp[j] + denp[64 + j] + g * nq[j];
            const float sc = 1.f / fmaxf(fabsf(den), eneg[j]);
            bf16_t* yrow = Y + (rowb + (size_t)(p0 + sg * j)) * 512 + hd * 128;
#pragma unroll
            for (int vi = 0; vi < 4; ++vi) {
                const int vt = 4 * vh + vi;
                f32x4 a1 = (f32x4){0.f, 0.f, 0.f, 0.f}, a2 = (f32x4){0.f, 0.f, 0.f, 0.f};
#pragma unroll
                for (int ks = 0; ks < 2; ++ks) a1 = MFMA16(frag(Vt, PT, 16 * vt, 32 * ks, lane), bS[ks], a1);
#pragma unroll
                for (int ks = 0; ks < 4; ++ks) a2 = MFMA16(frag(Cb, PQK, 16 * vt, 32 * ks, lane), bQ[ks], a2);
                u32x2 o; o.x = pk2((a1[0] + g * a2[0]) * sc, (a1[1] + g * a2[1]) * sc); o.y = pk2((a1[2] + g * a2[2]) * sc, (a1[3] + g * a2[3]) * sc);
                *(u32x2*)(yrow + 16 * vt + 4 * l4) = o;
            }
        }
        float nn;
        {
            const float decay = scl[0];
            bf16x8 bV[2];
#pragma unroll
            for (int ks = 0; ks < 2; ++ks) bV[ks] = frag(Vt, PT, 16 * w, 32 * ks, lane);
#pragma unroll
            for (int kt = 0; kt < 8; ++kt) {
                f32x4 a = accC[kt] * decay;
#pragma unroll
                for (int ks = 0; ks < 2; ++ks) a = MFMA16(frag(Ktw, PT, 16 * kt, 32 * ks, lane), bV[ks], a);
                accC[kt] = a;
            }
            const int kq = tid >> 2, sp = tid & 3; float a = 0.f;
            const u32x4 ta = *(const LAS u32x4*)(Ktw + kq * PT + sp * 32), tb = *(const LAS u32x4*)(Ktw + kq * PT + sp * 32 + 16);
            float tf[16]; unpack8(ta, tf); unpack8(tb, tf + 8);
#pragma unroll
            for (int e = 0; e < 16; ++e) a += tf[e];
            a += __shfl_xor(a, 1); a += __shfl_xor(a, 2);
            nn = decay * n0[kq] + a;
        }
        __syncthreads();
#pragma unroll
        for (int kt = 0; kt < 8; ++kt) { u32x2 o; o.x = pk2(accC[kt][0], accC[kt][1]); o.y = pk2(accC[kt][2], accC[kt][3]);
            *(LAS u32x2*)(Cb + (16 * w + l15) * PQK + (16 * kt + 4 * l4) * 2) = o; }
        if ((tid & 3) == 0) n0[tid >> 2] = nn;
    }
    __syncthreads();
}

__device__ __forceinline__ void ssd_unit(Frame& F, int b, int hd, int dir) {
    const int tid = F.tid, lane = F.lane, w = F.wave, l15 = lane & 15, l4 = lane >> 4;
    const bf16_t* Pb = (const bf16_t*)(F.ws + WS_P); const float* GT = (const float*)(F.ws + WS_GATES);
    bf16_t* Y = (bf16_t*)(F.ws + (dir ? WS_YD1 : WS_YD0));
    lptr L = F.lds;
    constexpr int PP = 272;
    lptr Cm = L, BmW = L + 34816, Btw = L + 69632, Xt = L + 104448, Hb = L + 121856;
    LAS float* fl = (LAS float*)(L + 139264);
    LAS float *dtl = fl, *acsl = fl + 128, *cw = fl + 256  ;
    const int grp = hd >> 2;
    const float dtb = F.p->in[I_DTB][dir * 8 + hd], aneg = -__expf(F.p->in[I_ALOG][dir * 8 + hd]), dsk = F.p->in[I_SSDD][hd];
    for (int i = tid; i < 17408 / 4; i += NTHREADS) ((LAS unsigned*)Hb)[i] = 0u;
    for (int i = tid; i < 320; i += NTHREADS) {
        const int ch = i < 64 ? hd * 64 + i : (i < 192 ? 512 + grp * 128 + (i - 64) : 768 + grp * 128 + (i - 192));
        cw[i * 4 + 0] = F.p->in[I_CONVW][ch]; cw[i * 4 + 1] = F.p->in[I_CONVW][1024 + ch]; cw[i * 4 + 2] = F.p->in[I_CONVW][2048 + ch]; cw[i * 4 + 3] = F.p->in[I_CONVB][ch];
    }
    f32x4 hacc[4];
#pragma unroll
    for (int i = 0; i < 4; ++i) hacc[i] = (f32x4){0.f, 0.f, 0.f, 0.f};
    const size_t rowb = (size_t)b * LT;
    __syncthreads();
    for (int c = 0; c < 18; ++c) {
        const int p0 = dir ? (c < 2 ? 255 - 128 * c : 2559 - 128 * c) : 128 * c; const int sg = dir ? -1 : 1;
        float dt2[2], acs2[2], de2[2];
        {
            float da[2];
#pragma unroll
            for (int h2 = 0; h2 < 2; ++h2) { const size_t row = rowb + (size_t)(p0 + sg * (lane + 64 * h2)); dt2[h2] = softplus(GT[row * 16 + dir * 8 + hd] + dtb); da[h2] = dt2[h2] * aneg; }
            acs2[0] = scan_add(da[0], lane); const float tot0 = __shfl(acs2[0], 63);
            acs2[1] = scan_add(da[1], lane) + tot0; const float aend = __shfl(acs2[1], 63);
            de2[0] = __expf(aend - acs2[0]) * dt2[0]; de2[1] = __expf(aend - acs2[1]) * dt2[1];
            if (w == 0) { dtl[lane] = dt2[0]; dtl[64 + lane] = dt2[1]; acsl[lane] = acs2[0]; acsl[64 + lane] = acs2[1]; }
        }
#pragma unroll 1
        for (int h2 = 0; h2 < 2; ++h2) {
            const int lr = lane + 64 * h2; const int p = p0 + sg * lr;
            const bool okm = (p != 0) && (p != CTXL), okp = (p != CTXL - 1) && (p != LT - 1);
            const bf16_t* prow = Pb + (rowb + (size_t)p) * NP1 + C_XS;
#pragma unroll 1
            for (int ci = 0; ci < 5; ++ci) {
                const int chunk = w + 8 * ci;
                const int lch = chunk * 8;
                const int gch = chunk < 8 ? hd * 64 + lch : (chunk < 24 ? 512 + grp * 128 + (lch - 64) : 768 + grp * 128 + (lch - 192));
                const u32x4 zero4 = (u32x4){0u, 0u, 0u, 0u};
                const u32x4 r0 = *(const u32x4*)(prow + gch);
                const u32x4 rm = okm ? *(const u32x4*)(prow - NP1 + gch) : zero4;
                const u32x4 rp = okp ? *(const u32x4*)(prow + NP1 + gch) : zero4;
                float x0[8], xm[8], xp[8], y[8]; unpack8(r0, x0); unpack8(rm, xm); unpack8(rp, xp);
#pragma unroll
                for (int e = 0; e < 8; ++e) { const f32x4 t = *(const LAS f32x4*)(cw + (lch + e) * 4); const float v = t.x * xm[e] + t.y * x0[e] + t.z * xp[e] + t.w; y[e] = siluf_(v); }
                if (chunk < 8) {
#pragma unroll
                    for (int e = 0; e < 8; ++e) *(LAS unsigned short*)(Xt + (lch + e) * PP + lr * 2) = f2bf(y[e]);
                } else if (chunk < 24) {
                    const int n = lch - 64; u32x4 o; o.x = pk2(y[0], y[1]); o.y = pk2(y[2], y[3]); o.z = pk2(y[4], y[5]); o.w = pk2(y[6], y[7]);
                    *(LAS u32x4*)(BmW + lr * PP + n * 2) = o;
                    const float de = de2[h2];
#pragma unroll
                    for (int e = 0; e < 8; ++e) *(LAS unsigned short*)(Btw + (n + e) * PP + lr * 2) = f2bf(y[e] * de);
                } else {
                    const int n = lch - 192; u32x4 o; o.x = pk2(y[0], y[1]); o.y = pk2(y[2], y[3]); o.z = pk2(y[4], y[5]); o.w = pk2(y[6], y[7]);
                    *(LAS u32x4*)(Cm + lr * PP + n * 2) = o;
                }
            }
        }
        __syncthreads();
        f32x4 cb[8];
        {
            bf16x8 bC[4];
#pragma unroll
            for (int ks = 0; ks < 4; ++ks) bC[ks] = frag(Cm, PP, 16 * w, 32 * ks, lane);
#pragma unroll
            for (int st = 0; st < 8; ++st) { cb[st] = (f32x4){0.f, 0.f, 0.f, 0.f};
                if (st <= w) {
#pragma unroll
                    for (int ks = 0; ks < 4; ++ks) cb[st] = MFMA16(frag(BmW, PP, 16 * st, 32 * ks, lane), bC[ks], cb[st]); } }
        }
        __syncthreads();
        {
            const int l = 16 * w + l15; const float al = acsl[l];
#pragma unroll
            for (int st = 0; st < 8; ++st) { const int s0 = 16 * st + 4 * l4; float vv[4];
#pragma unroll
                for (int r = 0; r < 4; ++r) { const int s = s0 + r; vv[r] = (s <= l) ? cb[st][r] * __expf(al - acsl[s]) * dtl[s] : 0.f; }
                u32x2 o; o.x = pk2(vv[0], vv[1]); o.y = pk2(vv[2], vv[3]);
                *(LAS u32x2*)(BmW + l * PP + s0 * 2) = o; }
        }
        __syncthreads();
        {
            const int l = 16 * w + l15; const float ea = __expf(acsl[l]);
            bf16x8 bW[4], bC[4];
#pragma unroll
            for (int ks = 0; ks < 4; ++ks) { bW[ks] = frag(BmW, PP, 16 * w, 32 * ks, lane); bC[ks] = frag(Cm, PP, 16 * w, 32 * ks, lane); }
            bf16_t* yrow = Y + (rowb + (size_t)(p0 + sg * l)) * 512 + hd * 64;
#pragma unroll
            for (int pt = 0; pt < 4; ++pt) {
                f32x4 a1 = (f32x4){0.f, 0.f, 0.f, 0.f}, a2 = (f32x4){0.f, 0.f, 0.f, 0.f};
#pragma unroll
                for (int ks = 0; ks < 4; ++ks) { a1 = MFMA16(frag(Xt, PP, 16 * pt, 32 * ks, lane), bW[ks], a1); a2 = MFMA16(frag(Hb, PP, 16 * pt, 32 * ks, lane), bC[ks], a2); }
                float o4[4];
#pragma unroll
                for (int r = 0; r < 4; ++r) { const int pp = 16 * pt + 4 * l4 + r; float v = a1[r] + ea * a2[r];
                    if (dir == 0) v += dsk * bf2f(*(const LAS unsigned short*)(Xt + pp * PP + l * 2));
                    o4[r] = v; }
                u32x2 o; o.x = pk2(o4[0], o4[1]); o.y = pk2(o4[2], o4[3]);
                *(u32x2*)(yrow + 16 * pt + 4 * l4) = o;
            }
        }
        {
            const int pt = w >> 1, nh = w & 1; const float cdec = __expf(acsl[127]);
            bf16x8 bX[4];
#pragma unroll
            for (int ks = 0; ks < 4; ++ks) bX[ks] = frag(Xt, PP, 16 * pt, 32 * ks, lane);
#pragma unroll
            for (int ni = 0; ni < 4; ++ni) { f32x4 a = hacc[ni] * cdec;
#pragma unroll
                for (int ks = 0; ks < 4; ++ks) a = MFMA16(frag(Btw, PP, 16 * (4 * nh + ni), 32 * ks, lane), bX[ks], a);
                hacc[ni] = a; }
        }
        __syncthreads();
        {
            const int pt = w >> 1, nh = w & 1;
#pragma unroll
            for (int ni = 0; ni < 4; ++ni) { u32x2 o; o.x = pk2(hacc[ni][0], hacc[ni][1]); o.y = pk2(hacc[ni][2], hacc[ni][3]);
                *(LAS u32x2*)(Hb + (16 * pt + l15) * PP + (16 * (4 * nh + ni) + 4 * l4) * 2) = o; }
        }
    }
    __syncthreads();
}

__device__ __forceinline__ void s5_unit(Frame& F, int b, int dir, int gq) {
    const int lane = F.lane, w = F.wave, nn = lane & 31, hi = lane >> 5, l15 = lane & 15, l4 = lane >> 4;
    const Params& P = *F.p;
    const bf16_t* Pb = (const bf16_t*)(F.ws + WS_P);
    bf16_t* Y = (bf16_t*)(F.ws + (dir ? WS_YS1 : WS_YS0));
    const int G = gq * 8 + w, dg = dir * 32 + G;
    lptr Hs = F.lds + w * 8704; constexpr int PH = 272;
    float abr[2], abi[2];
    bf16x8 bfr[4], cfr[4];
    {
        const float dt = __expf(P.in[I_S5LDT][dg]);
        float zr[2], zi[2];
#pragma unroll
        for (int s = 0; s < 2; ++s) {
            const int n = nn + 32 * s; const float are = P.in[I_S5ARE][dg * 64 + n], aim = P.in[I_S5AIM][dg * 64 + n];
            const float mag = __expf(dt * are); float rev = dt * aim * 0.15915494309189533577f; rev = rev - floorf(rev);
            abr[s] = mag * __builtin_amdgcn_cosf(rev); abi[s] = mag * __builtin_amdgcn_sinf(rev);
            const float den = are * are + aim * aim;
            zr[s] = ((abr[s] - 1.f) * are + abi[s] * aim) / den; zi[s] = (abi[s] * are - (abr[s] - 1.f) * aim) / den;
        }
#pragma unroll
        for (int ct = 0; ct < 4; ++ct) {
            const int s = ct & 1, n = nn + 32 * s; const bool im = ct >= 2;
            const float* br = P.in[I_S5BRE] + ((size_t)dg * 64 + n) * 16 + 8 * hi; const float* bi = P.in[I_S5BIM] + ((size_t)dg * 64 + n) * 16 + 8 * hi;
            float v[8];
#pragma unroll
            for (int j = 0; j < 8; ++j) v[j] = im ? (zr[s] * bi[j] + zi[s] * br[j]) : (zr[s] * br[j] - zi[s] * bi[j]);
            u32x4 o; o.x = pk2(v[0], v[1]); o.y = pk2(v[2], v[3]); o.z = pk2(v[4], v[5]); o.w = pk2(v[6], v[7]);
            bfr[ct] = __builtin_bit_cast(bf16x8, o);
        }
#pragma unroll
        for (int ks = 0; ks < 4; ++ks) {
            const int np = 32 * ks + 8 * l4; const bool im = np >= 64; const int n = np & 63;
            const float* cp = P.in[im ? I_S5CIM : I_S5CRE] + ((size_t)dg * 16 + l15) * 64 + n;
            float v[8];
#pragma unroll
            for (int j = 0; j < 8; ++j) v[j] = im ? -cp[j] : cp[j];
            u32x4 o; o.x = pk2(v[0], v[1]); o.y = pk2(v[2], v[3]); o.z = pk2(v[4], v[5]); o.w = pk2(v[6], v[7]);
            cfr[ks] = __builtin_bit_cast(bf16x8, o);
        }
    }
    float sr[2] = {0.f, 0.f}, si[2] = {0.f, 0.f};
    const size_t rowb = (size_t)b * LT;
    const int rho = nn, tau_a = 16 * ((rho >> 2) & 1) + (rho & 3) + 4 * (rho >> 3);
    for (int blk = 0; blk < 72; ++blk) {
        const int i0 = 32 * blk; const int p0 = dir ? (i0 < 256 ? 255 - i0 : 2559 - i0) : i0; const int sg = dir ? -1 : 1;
        const u32x4 ua = *(const u32x4*)(Pb + (rowb + (size_t)(p0 + sg * tau_a)) * NP1 + C_U + G * 16 + 8 * hi);
        const bf16x8 af = __builtin_bit_cast(bf16x8, ua);
        f32x16 acc[4];
#pragma unroll
        for (int ct = 0; ct < 4; ++ct) { f32x16 z = f32x16{}; acc[ct] = __builtin_amdgcn_mfma_f32_32x32x16_bf16(af, bfr[ct], z, 0, 0, 0); }
#pragma unroll
        for (int s = 0; s < 2; ++s) {
            float xr = hi ? 0.f : sr[s], xi = hi ? 0.f : si[s];
#pragma unroll
            for (int r = 0; r < 16; ++r) { const float nr = abr[s] * xr - abi[s] * xi + acc[s][r], ni = abr[s] * xi + abi[s] * xr + acc[2 + s][r]; xr = nr; xi = ni; acc[s][r] = nr; acc[2 + s][r] = ni; }
            float cr = __shfl(xr, nn), ci = __shfl(xi, nn);
            if (!hi) { cr = 0.f; ci = 0.f; }
#pragma unroll
            for (int r = 0; r < 16; ++r) { const float tr = abr[s] * cr - abi[s] * ci, ti = abr[s] * ci + abi[s] * cr; cr = tr; ci = ti; acc[s][r] += cr; acc[2 + s][r] += ci; }
            sr[s] = __shfl(acc[s][15], nn + 32); si[s] = __shfl(acc[2 + s][15], nn + 32);
        }
#pragma unroll
        for (int r = 0; r < 16; ++r) {
            const int tau = 16 * hi + r; lptr hp = Hs + tau * PH;
            *(LAS unsigned short*)(hp + nn * 2) = f2bf(acc[0][r]); *(LAS unsigned short*)(hp + (32 + nn) * 2) = f2bf(acc[1][r]);
            *(LAS unsigned short*)(hp + (64 + nn) * 2) = f2bf(acc[2][r]); *(LAS unsigned short*)(hp + (96 + nn) * 2) = f2bf(acc[3][r]);
        }
        LDS_WAIT();
#pragma unroll
        for (int tt = 0; tt < 2; ++tt) {
            f32x4 a = (f32x4){0.f, 0.f, 0.f, 0.f};
#pragma unroll
            for (int ks = 0; ks < 4; ++ks) a = MFMA16(cfr[ks], frag(Hs, PH, 16 * tt, 32 * ks, lane), a);
            const int tau = 16 * tt + l15;
            u32x2 o; o.x = pk2(a[0], a[1]); o.y = pk2(a[2], a[3]);
            *(u32x2*)(Y + (rowb + (size_t)(p0 + sg * tau)) * 512 + G * 16 + 4 * l4) = o;
        }
        LDS_WAIT();
    }
}
#undef MFMA16
}
__device__ __forceinline__ void finalize0_phase(Frame& F) {
    const bf16_t* Y0 = (const bf16_t*)(F.ws + WS_Y0); const bf16_t* Y1 = (const bf16_t*)(F.ws + WS_Y1); const bf16_t* Pb = (const bf16_t*)(F.ws + WS_P);
    bf16_t* MIX = (bf16_t*)(F.ws + WS_HB); const float* gn = F.p->in[I_MLNORM] + 8 * F.lane;
    float g[8];
#pragma unroll
    for (int e = 0; e < 8; ++e) g[e] = gn[e];
    const int r0 = F.bid * ROWS_PER_WG + F.wave * ROWS_PER_WAVE;
    for (int ri = 0; ri < ROWS_PER_WAVE; ++ri) {
        const size_t r = r0 + ri;
        const u32x4 a = *(const u32x4*)(Y0 + r * 512 + 8 * F.lane), b = *(const u32x4*)(Y1 + r * 512 + 8 * F.lane), o = *(const u32x4*)(Pb + r * NP0 + C_MO + 8 * F.lane);
        float x[8], y[8], og[8]; mix::unpack8(a, x); mix::unpack8(b, y); mix::unpack8(o, og);
        float ss = 0.f;
#pragma unroll
        for (int e = 0; e < 8; ++e) { x[e] += y[e]; ss += x[e] * x[e]; }
        ss += __shfl_xor(ss, 1); ss += __shfl_xor(ss, 2); ss += __shfl_xor(ss, 4); ss += __shfl_xor(ss, 8);
        const float rstd = rsqrtf(ss * (1.f / 128.f) + NORM_EPS);
#pragma unroll
        for (int e = 0; e < 8; ++e) x[e] = x[e] * rstd * g[e] * sigmoidf_(og[e]);
        u32x4 w; w.x = pk2(x[0], x[1]); w.y = pk2(x[2], x[3]); w.z = pk2(x[4], x[5]); w.w = pk2(x[6], x[7]);
        *(u32x4*)(MIX + r * D + 8 * F.lane) = w;
    }
}
__device__ __forceinline__ float gelu_tanh(float x) { const float a = 0.7978845608028654f * (x + 0.044715f * x * x * x); const float t = 1.f - 2.f / (1.f + __expf(2.f * a)); return 0.5f * x * (1.f + t); }
__device__ __forceinline__ void finalize1_phase(Frame& F) {
    const bf16_t* S0 = (const bf16_t*)(F.ws + WS_YS0); const bf16_t* S1 = (const bf16_t*)(F.ws + WS_YS1);
    const bf16_t* D0 = (const bf16_t*)(F.ws + WS_YD0); const bf16_t* D1 = (const bf16_t*)(F.ws + WS_YD1); const bf16_t* Pb = (const bf16_t*)(F.ws + WS_P);
    bf16_t* MIX = (bf16_t*)(F.ws + WS_HB); bf16_t* Gb = (bf16_t*)(F.ws + WS_G);
    float sd[8], gn[8];
#pragma unroll
    for (int e = 0; e < 8; ++e) { sd[e] = F.p->in[I_S5D][8 * F.lane + e]; gn[e] = F.p->in[I_SSDNORM][8 * F.lane + e]; }
    const int r0 = F.bid * ROWS_PER_WG + F.wave * ROWS_PER_WAVE;
    for (int ri = 0; ri < ROWS_PER_WAVE; ++ri) {
        const size_t r = r0 + ri;
        if (row_is_ctx((int)r)) continue;
        {
            const u32x4 a = *(const u32x4*)(S0 + r * 512 + 8 * F.lane), b = *(const u32x4*)(S1 + r * 512 + 8 * F.lane), u = *(const u32x4*)(Pb + r * NP1 + C_U + 8 * F.lane);
            float x[8], y[8], uu[8]; mix::unpack8(a, x); mix::unpack8(b, y); mix::unpack8(u, uu);
#pragma unroll
            for (int e = 0; e < 8; ++e) x[e] = gelu_tanh(x[e] + y[e] + sd[e] * uu[e]);
            u32x4 w; w.x = pk2(x[0], x[1]); w.y = pk2(x[2], x[3]); w.z = pk2(x[4], x[5]); w.w = pk2(x[6], x[7]);
            *(u32x4*)(Gb + r * 512 + 8 * F.lane) = w;
        }
        {
            const u32x4 a = *(const u32x4*)(D0 + r * 512 + 8 * F.lane), b = *(const u32x4*)(D1 + r * 512 + 8 * F.lane), z = *(const u32x4*)(Pb + r * NP1 + C_Z + 8 * F.lane);
            float x[8], y[8], zz[8]; mix::unpack8(a, x); mix::unpack8(b, y); mix::unpack8(z, zz);
            float ss = 0.f;
#pragma unroll
            for (int e = 0; e < 8; ++e) { x[e] = (x[e] + y[e]) * siluf_(zz[e]); ss += x[e] * x[e]; }
            const float rstd = rsqrtf(wave_sum(ss) * (1.f / 512.f) + NORM_EPS);
#pragma unroll
            for (int e = 0; e < 8; ++e) x[e] = x[e] * rstd * gn[e];
            u32x4 w; w.x = pk2(x[0], x[1]); w.y = pk2(x[2], x[3]); w.z = pk2(x[4], x[5]); w.w = pk2(x[6], x[7]);
            *(u32x4*)(MIX + r * D + 512 + 8 * F.lane) = w;
        }
    }
}

#ifndef ONLY
#define ONLY -1
#endif
__global__ void __launch_bounds__(NTHREADS, 2) fwd_kernel(Params prm) {
    extern __shared__ __attribute__((aligned(16))) unsigned char lds[];
    Frame F;
    F.lds = (LAS unsigned char*)lds; F.MISC = (volatile LAS unsigned*)(F.lds + MISC_OFF);
    F.tid = threadIdx.x; F.lane = F.tid & 63; F.wave = __builtin_amdgcn_readfirstlane(F.tid >> 6);
    F.G = gridDim.x; F.bid = blockIdx.x; F.vcu = (F.G % 8 == 0) ? (F.bid % 8) * (F.G / 8) + F.bid / 8 : F.bid;
    F.p = &prm; F.ws = prm.ws; F.ctl = (gu32*)(prm.ws + WS_CTL);
    if (F.tid < 64) F.MISC[F.tid] = 0u;
    __syncthreads();
    XcdBarrier bar = xcd_barrier_post((unsigned*)(F.ctl + CW_BAR), F.MISC + 8);
#define GRID_BAR() xcd_barrier(bar)
#define PH() do { F.tid = opaque_tid(); F.lane = F.tid & 63; F.wave = __builtin_amdgcn_readfirstlane(F.tid >> 6); } while (0)
    const char* ws = (const char*)prm.ws;
    const float* mod0 = (const float*)(ws + WS_MOD); const float* mod1 = mod0 + 17 * 6144;


    if (ONLY < 0 || ONLY == 0) { PH();
    p0_prologue(F); }
    GRID_BAR();
    if (ONLY < 0 || ONLY == 1) { PH();
    norm_phase<0>(F); }
    GRID_BAR();
    if (ONLY < 0 || ONLY == 2) { PH();
    {
        pg8::Gemm g{D, D, D}; pg8::DenseSched<false> S{ws + WS_HB, ws + WS_WIN0, NP0 / 256, F.G, F.bid, (size_t)256 * D * 2, (size_t)256 * D * 2};
        pg8::EpiStoreBf16 E{(bf16_t*)(prm.ws + WS_P), NP0};
        pg8::gemm_phase<pg8::EpiStoreBf16, pg8::DenseSched<false>, true>(F.lds, g, S, E);
    }
    }
    GRID_BAR();
    if (ONLY < 0 || ONLY == 3) { PH();
    knorm_phase(F); }
    GRID_BAR();
    if (ONLY < 0 || ONLY == 4 || ONLY == 40 || ONLY == 41) { PH();
    {
        if (ONLY != 41) for (;;) {
            const int u = q_next(F, 0);
            if (u >= 128) break;
            mix::mlstm_unit(F, u >> 3, (u >> 1) & 3, u & 1);
        }
        if (ONLY != 40) for (;;) {
            const int a = q_next(F, 1);
            if (a >= 1152) break;
            int b, h, qb;
            if (a < 1024) { qb = 1 + (a & 7); b = a >> 6; h = ((a >> 5) & 1) * 4 + ((a >> 3) & 3); } else { const int a2 = a - 1024; b = a2 >> 3; h = a2 & 7; qb = 0; }
            attn_body::attn_unit<8>(b, h, qb, (const bf16_t*)(prm.ws + WS_P), (bf16_t*)(prm.ws + WS_HB), prm.in[I_QNORM], (char*)lds);
        }
    }
    }
    GRID_BAR();
    if (ONLY < 0 || ONLY == 5) { PH();
    finalize0_phase(F); }
    GRID_BAR();
    if (ONLY < 0 || ONLY == 6) { PH();
    {
        pg8::Gemm g{D, D, D}; pg8::DenseSched<false> S{ws + WS_HB, ws + WS_WOUT0, 4, F.G, F.bid, (size_t)256 * D * 2, (size_t)256 * D * 2};
        pg8::EpiResid E{prm.in[I_X], prm.in[I_CTX], prm.out, (float*)(prm.ws + WS_XRC), mod0 + 2048, true};
        pg8::gemm_phase<pg8::EpiResid, pg8::DenseSched<false>, true>(F.lds, g, S, E);
    }
    }
    GRID_BAR();
    if (ONLY < 0 || ONLY == 7) { PH();
    norm_phase<1>(F); }
    GRID_BAR();
    if (ONLY < 0 || ONLY == 8) { PH();
    route_phase<0>(F); }
    GRID_BAR();
    if (ONLY < 0 || ONLY == 9) { PH();
    {
        MoeTab T = moe_tables(F, F.lds + 131072, false);
        pg8::Gemm g{D, D, D}; pg8::MoeSched S{ws + WS_H2S, ws + WS_GU0, 8, F.G, F.bid, T.ntile[0], T.base, false};
        pg8::EpiSwiGlu E{(bf16_t*)(prm.ws + WS_ACT), (const float*)(ws + WS_ROUTE + RT_WPOS)};
        pg8::gemm_phase<pg8::EpiSwiGlu, pg8::MoeSched, true>(F.lds, g, S, E);
    }
    }
    GRID_BAR();
    if (ONLY < 0 || ONLY == 10) { PH();
    {
        MoeTab T = moe_tables(F, F.lds + 131072, false);
        pg8::Gemm g{D, 8192, D}; pg8::MoeSched S{ws + WS_ACT, ws + WS_D0, 4, F.G, F.bid, T.ntile[0], T.base, true};
        pg8::EpiDown E{(const int*)(ws + WS_ROUTE + RT_TOK), prm.out, (float*)(prm.ws + WS_XRC), mod0 + 5120};
        pg8::gemm_phase<pg8::EpiDown, pg8::MoeSched, true>(F.lds, g, S, E);
    }
    }
    GRID_BAR();
    if (ONLY < 0 || ONLY == 11) { PH();
    norm_phase<2>(F); }
    GRID_BAR();
    if (ONLY < 0 || ONLY == 12) { PH();
    {
        pg8::Gemm g{D, D, D}; pg8::DenseSched<false> S{ws + WS_HB, ws + WS_WIN1, NP1 / 256, F.G, F.bid, (size_t)256 * D * 2, (size_t)256 * D * 2};
        pg8::EpiStoreBf16 E{(bf16_t*)(prm.ws + WS_P), NP1};
        pg8::gemm_phase<pg8::EpiStoreBf16, pg8::DenseSched<false>, true>(F.lds, g, S, E);
    }
    }
    GRID_BAR();
    if (ONLY < 0 || ONLY == 13 || ONLY == 130 || ONLY == 131) { PH();
    {
        if (ONLY != 131) for (;;) {
            const int u = q_next(F, 2);
            if (u >= 128) break;
            mix::s5_unit(F, u >> 3, (u >> 2) & 1, u & 3);
        }
        if (ONLY != 130) for (;;) {
            const int a = q_next(F, 3);
            if (a >= 256) break;
            mix::ssd_unit(F, a >> 4, (a >> 1) & 7, a & 1);
        }
    }
    }
    GRID_BAR();
    if (ONLY < 0 || ONLY == 14) { PH();
    finalize1_phase(F); }
    GRID_BAR();
    if (ONLY < 0 || ONLY == 15) { PH();
    {
        pg8::Gemm g{512, 512, 512}; pg8::DenseSched<true> S{ws + WS_G, ws + WS_WGLU, 2, F.G, F.bid, (size_t)256 * 512 * 2, (size_t)256 * 512 * 2};
        pg8::EpiGlu E{(const bf16_t*)(ws + WS_G), (bf16_t*)(prm.ws + WS_HB), prm.in[I_GLUB]};
        pg8::gemm_phase<pg8::EpiGlu, pg8::DenseSched<true>, true>(F.lds, g, S, E);
    }
    }
    GRID_BAR();
    if (ONLY < 0 || ONLY == 16) { PH();
    {
        pg8::Gemm g{D, D, D}; pg8::DenseSched<true> S{ws + WS_HB, ws + WS_WOUT1, 4, F.G, F.bid, (size_t)256 * D * 2, (size_t)256 * D * 2};
        pg8::EpiResid E{prm.in[I_X], prm.in[I_CTX], prm.out, (float*)(prm.ws + WS_XRC), mod1 + 2048, false};
        pg8::gemm_phase<pg8::EpiResid, pg8::DenseSched<true>, true>(F.lds, g, S, E);
    }
    }
    GRID_BAR();
    if (ONLY < 0 || ONLY == 17) { PH();
    norm_phase<3>(F); }
    GRID_BAR();
    if (ONLY < 0 || ONLY == 18) { PH();
    route_phase<1>(F); }
    GRID_BAR();
    if (ONLY < 0 || ONLY == 19) { PH();
    {
        MoeTab T = moe_tables(F, F.lds + 131072, false);
        pg8::Gemm g{D, D, D}; pg8::MoeSched S{ws + WS_H2S, ws + WS_GU1, 8, F.G, F.bid, T.ntile[0], T.base, false};
        pg8::EpiSwiGlu E{(bf16_t*)(prm.ws + WS_ACT), (const float*)(ws + WS_ROUTE + RT_WPOS)};
        pg8::gemm_phase<pg8::EpiSwiGlu, pg8::MoeSched, true>(F.lds, g, S, E);
    }
    }
    GRID_BAR();
    if (ONLY < 0 || ONLY == 20) { PH();
    {
        MoeTab T = moe_tables(F, F.lds + 131072, false);
        pg8::Gemm g{D, 8192, D}; pg8::MoeSched S{ws + WS_ACT, ws + WS_D1, 4, F.G, F.bid, T.ntile[0], T.base, true};
        pg8::EpiDown E{(const int*)(ws + WS_ROUTE + RT_TOK), prm.out, (float*)(prm.ws + WS_XRC), mod1 + 5120};
        pg8::gemm_phase<pg8::EpiDown, pg8::MoeSched, true>(F.lds, g, S, E);
    }
}
#undef GRID_BAR
}

extern "C" void kernel_launch(void* const* d_in, const int* in_sizes, int n_in, void* d_out, int out_size, void* d_ws, size_t ws_size, hipStream_t stream) {
    static int ready = 0;
    if (ready == 0) {
        if (n_in != 39 || out_size != NBATCH * SEQ * D || ws_size < WS_END) { fprintf(stderr, "kernel_launch: unexpected problem (n_in %d, out %d, ws %zu); nothing launched\n", n_in, out_size, ws_size); ready = -1; return; }
        if (hipFuncSetAttribute((const void*)fwd_kernel, hipFuncAttributeMaxDynamicSharedMemorySize, LDS_BYTES) != hipSuccess) { fprintf(stderr, "kernel_launch: hipFuncSetAttribute failed\n"); ready = -1; return; }
        int per_cu = 0;
        if (hipOccupancyMaxActiveBlocksPerMultiprocessor(&per_cu, (const void*)fwd_kernel, NTHREADS, LDS_BYTES) != hipSuccess || per_cu < 1) fprintf(stderr, "kernel_launch: occupancy query reports %d workgroups per CU\n", per_cu);
        (void)hipGetLastError();
        ready = 1;
    }
    if (ready < 0) return;
    (void)in_sizes;
    if (hipMemsetAsync((char*)d_ws + WS_CTL, 0, CTL_ZERO_BYTES, stream) != hipSuccess) return;
    Params p{};
    for (int i = 0; i < 39; ++i) p.in[i] = (const float*)d_in[i];
    p.out = (float*)d_out; p.ws = (unsigned char*)d_ws;
    hipLaunchKernelGGL(fwd_kernel, dim3(GRID), dim3(NTHREADS), LDS_BYTES, stream, p);
}
```

```cpp
#include <hip/hip_runtime.h>
#include <hip/hip_bf16.h>
#include <cstdio>
#include <cstdint>
#include <cmath>

constexpr int D = 1024, NBATCH = 16, SEQ = 2048, CTXL = 256, LT = CTXL + SEQ  , R = NBATCH * LT  ;
constexpr int NP0 = 2816;
constexpr int NP1 = 2048;
constexpr int C_MQ = 0, C_MK = 512, C_MV = 1024, C_MO = 1536, C_AQ = 2048, C_AK = 2560, C_AV = 2688;
constexpr int C_U = 0, C_Z = 512, C_XS = 1024, C_B = 1536, C_C = 1792;
constexpr int NWAVES = 8, NTHREADS = 512, GRID = 256;
constexpr int ROWS_PER_WG = R / GRID  , ROWS_PER_WAVE = ROWS_PER_WG / NWAVES  ;
constexpr int NCLS = 24, MAXPOS = 43008  ;
constexpr float NORM_EPS = 1e-6f;

constexpr size_t MiB = 1u << 20;
constexpr size_t WS_CTL = 0, CTL_ZERO_BYTES = 1 * MiB;
constexpr size_t WS_MOD = 1 * MiB;
constexpr size_t WS_WIN0 = 2 * MiB, WS_WOUT0 = 8 * MiB, WS_WIN1 = 10 * MiB  , WS_WOUT1 = 14 * MiB + 512 * 1024, WS_WGLU = 16 * MiB + 512 * 1024;
constexpr size_t WS_GU0 = 18 * MiB, WS_D0 = 50 * MiB, WS_GU1 = 66 * MiB, WS_D1 = 98 * MiB;
constexpr size_t WS_GATES = 114 * MiB;
constexpr size_t WS_ROUTE = 117 * MiB;
constexpr size_t WS_XR = 404 * MiB;
constexpr size_t WS_HB = 134 * MiB;
constexpr size_t WS_P = 206 * MiB;
constexpr size_t WS_Y0 = 404 * MiB, WS_Y1 = 440 * MiB;
constexpr size_t OUT_YS0 = 0, OUT_YS1 = 36 * MiB, OUT_YD0 = 72 * MiB  , WS_YD1 = 350 * MiB;
constexpr size_t WS_G = WS_GU0;
constexpr size_t WS_H2S = WS_P, WS_ACT = WS_P + 84 * MiB;
constexpr size_t WS_END = 494 * MiB;
constexpr size_t RT_CLS = 0, RT_WTS = 147456, RT_CNT = RT_WTS + 294912, RT_TOK = RT_CNT + 24576, RT_WPOS = RT_TOK + 172032;
constexpr int CW_BAR = 4096, CW_Q = 8192;

constexpr int SCRATCH_BYTES = 155648;
constexpr int MISC_OFF = SCRATCH_BYTES;
constexpr int LDS_BYTES = SCRATCH_BYTES + 256;

#define GAS __attribute__((address_space(1)))
#define LAS __attribute__((address_space(3)))
typedef unsigned short bf16_t;
typedef short bf16x8 __attribute__((ext_vector_type(8)));
typedef short s16x4 __attribute__((ext_vector_type(4)));
typedef float f32x4 __attribute__((ext_vector_type(4)));
typedef float f32x16 __attribute__((ext_vector_type(16)));
typedef unsigned u32x4 __attribute__((ext_vector_type(4)));
typedef unsigned u32x2 __attribute__((ext_vector_type(2)));
typedef float f32x2_t __attribute__((ext_vector_type(2)));
typedef __bf16 bf16x2_t __attribute__((ext_vector_type(2)));
typedef GAS unsigned gu32;

__device__ __forceinline__ unsigned pk2(float lo, float hi) { f32x2_t v = {lo, hi}; bf16x2_t b = __builtin_convertvector(v, bf16x2_t); return __builtin_bit_cast(unsigned, b); }
__device__ __forceinline__ unsigned short f2bf(float f) { return (unsigned short)(pk2(f, 0.f) & 0xffffu); }
__device__ __forceinline__ float bflo(unsigned u) { return __uint_as_float(u << 16); }
__device__ __forceinline__ float bfhi(unsigned u) { return __uint_as_float(u & 0xffff0000u); }
__device__ __forceinline__ float bf2f(unsigned short u) { return __uint_as_float(((unsigned)u) << 16); }
template <int CTRL, int ROWMASK = 0xf> __device__ __forceinline__ float dppf(float v) { return __int_as_float(__builtin_amdgcn_update_dpp(0, __float_as_int(v), CTRL, ROWMASK, 0xf, false)); }
template <int M> __device__ __forceinline__ float xorl(float v) {
    if constexpr (M == 1) return dppf<0xB1>(v);
    else if constexpr (M == 2) return dppf<0x4E>(v);
    else if constexpr (M == 32) { const auto rr = __builtin_amdgcn_permlane32_swap(__float_as_uint(v), __float_as_uint(v), false, false);
        const unsigned a = rr[0], b = rr[1]; const unsigned own = __float_as_uint(v); return __uint_as_float(a == own ? b : a) ; }
    else return __int_as_float(__builtin_amdgcn_ds_swizzle(__float_as_int(v), 0x1F | (M << 10)));
}
__device__ __forceinline__ float rdlane(float v, int l) { return __int_as_float(__builtin_amdgcn_readlane(__float_as_int(v), l)); }
__device__ __forceinline__ float wave_sum(float v) {
    v += dppf<0xB1>(v); v += dppf<0x4E>(v); v += dppf<0x141>(v); v += dppf<0x140>(v);
    const float r0 = rdlane(v, 0), r1 = rdlane(v, 16), r2 = rdlane(v, 32), r3 = rdlane(v, 48);
    return (r0 + r1) + (r2 + r3);
}
__device__ __forceinline__ float lane_get(float v, int idx) { return __int_as_float(__builtin_amdgcn_ds_bpermute(idx << 2, __float_as_int(v))); }
__device__ __forceinline__ int lane_geti(int v, int idx) { return __builtin_amdgcn_ds_bpermute(idx << 2, v); }
__device__ __forceinline__ float sigmoidf_(float x) { return 1.f / (1.f + __expf(-x)); }
__device__ __forceinline__ float siluf_(float x) { return x / (1.f + __expf(-x)); }
__device__ __forceinline__ int opaque_tid(int wave_s) { int l; asm volatile("v_mbcnt_lo_u32_b32 %0, -1, 0\n\tv_mbcnt_hi_u32_b32 %0, -1, %0" : "=v"(l)); return (wave_s << 6) | l; }
#define LDS_WAIT() asm volatile("s_waitcnt lgkmcnt(0)" ::: "memory")
#define VM_WAIT() asm volatile("s_waitcnt vmcnt(0)" ::: "memory")

__device__ __forceinline__ int wave_row0(int bid, int w) { return bid * ROWS_PER_WG + w * ROWS_PER_WAVE; }
__device__ __forceinline__ bool row_is_ctx(int r) { return (r % LT) < CTXL; }

#define XB_TMO      128
#define XB_XCNT(j)  (256  + 64 * (j))
#define XB_XSUB(j)  (1280 + 64 * (j))
#define XB_XGEN(j)  (2304 + 64 * (j))
#define XB_TOP      3328
#define XB_TOPGEN   3392
#define XCD_BAR_WORDS 3456
#define XB_SPIN_CAP (1u << 22)

__device__ __forceinline__ unsigned xb_ld(unsigned* p)              { return __hip_atomic_load(p, __ATOMIC_RELAXED, __HIP_MEMORY_SCOPE_AGENT); }
__device__ __forceinline__ unsigned xb_add(unsigned* p, unsigned v) { return __hip_atomic_fetch_add(p, v, __ATOMIC_RELAXED, __HIP_MEMORY_SCOPE_AGENT); }
__device__ __forceinline__ unsigned xb_xcc_id() { return (unsigned)__builtin_amdgcn_s_getreg((3 << 11) | 20) & 0xFu; }
#define XB_SPIN(cond, bar) do { unsigned _sp = 0; while (cond) { __builtin_amdgcn_s_sleep(1); \
    if ((++_sp & 255u) == 0u) { if (xb_ld(&(bar)[XB_TMO])) break; if (_sp > XB_SPIN_CAP) { atomicAdd(&(bar)[XB_TMO], 1u); break; } } } } while (0)

struct XcdBarrier { unsigned* bar; volatile LAS unsigned* st; };

__device__ __forceinline__ XcdBarrier xcd_barrier_post(unsigned* bar, volatile LAS unsigned* st, int tid) {
    XcdBarrier b; b.bar = bar; b.st = st;
    if (tid == 0) (void)xb_add(&bar[XB_XCNT(xb_xcc_id())], 1u);
    return b;
}
__device__ __forceinline__ void xcd_barrier_complete(unsigned* bar, unsigned x, unsigned& nloc, unsigned& nx) {
    const unsigned G = gridDim.x * gridDim.y * gridDim.z;
    unsigned sum, cnt, mine, sp = 0u;
    for (;;) {
        sum = 0u; cnt = 0u; mine = 0u;
#pragma unroll
        for (unsigned j = 0; j < 16; ++j) { const unsigned c = xb_ld(&bar[XB_XCNT(j)]); sum += c; cnt += (c > 0u) ? 1u : 0u; mine = (j == x) ? c : mine; }
        if (sum == G) break;
        __builtin_amdgcn_s_sleep(1);
        if ((++sp & 255u) == 0u) { if (xb_ld(&bar[XB_TMO])) break; if (sp > XB_SPIN_CAP) { atomicAdd(&bar[XB_TMO], 1u); break; } }
    }
    nloc = mine > 0u ? mine : 1u; nx = cnt > 0u ? cnt : 1u;
}
__device__ __forceinline__ void xcd_barrier(const XcdBarrier& b, int tid) {
    asm volatile("s_waitcnt vmcnt(0)" ::: "memory");
    __syncthreads();
    if (tid == 0) {
        unsigned* bar = b.bar; const unsigned bx = xb_xcc_id();
        __builtin_amdgcn_s_waitcnt(0);
        unsigned nloc = b.st[0], nx = b.st[1];
        if (nloc == 0u) { xcd_barrier_complete(bar, bx, nloc, nx); b.st[0] = nloc; b.st[1] = nx; }
        const unsigned old = xb_add(&bar[XB_XSUB(bx)], 1u);
        const unsigned gen = old / nloc;
        if (old + 1u == (gen + 1u) * nloc) {
            __builtin_amdgcn_fence(__ATOMIC_RELEASE, "agent");
            asm volatile("s_waitcnt vmcnt(0)" ::: "memory");
            const unsigned og = xb_add(&bar[XB_TOP], 1u);
            const unsigned tg = og / nx;
            if (og + 1u == (tg + 1u) * nx) xb_add(&bar[XB_TOPGEN], 1u);
            else XB_SPIN(xb_ld(&bar[XB_TOPGEN]) == tg, bar);
            __builtin_amdgcn_fence(__ATOMIC_ACQUIRE, "agent");
            xb_add(&bar[XB_XGEN(bx)], 1u);
            asm volatile("s_waitcnt vmcnt(0)" ::: "memory");
        } else {
            XB_SPIN(xb_ld(&bar[XB_XGEN(bx)]) == gen, bar);
            __builtin_amdgcn_fence(__ATOMIC_ACQUIRE, "agent");
            asm volatile("s_waitcnt vmcnt(0)" ::: "memory");
        }
    }
    __syncthreads();
}

struct Params { const float* in[39]; float* out; unsigned char* ws; };
enum { I_X = 0, I_C, I_CTX, I_CCTX, I_ADAW, I_ADAB, I_NMIX, I_NFFN, I_EVWIN, I_EVWOUT, I_MLGB, I_MLNORM, I_QNORM, I_KNORM, I_ODWIN, I_ODWOUT,
       I_S5ARE, I_S5AIM, I_S5LDT, I_S5BRE, I_S5BIM, I_S5CRE, I_S5CIM, I_S5D, I_GLUW, I_GLUB, I_CONVW, I_CONVB, I_DTB, I_ALOG, I_SSDD, I_SSDNORM,
       I_GRW, I_GRB, I_ERW, I_ERB, I_WG, I_WU, I_WD };

struct Frame {
    LAS unsigned char* lds; volatile LAS unsigned* MISC; gu32* ctl;
    int tid, lane, wave, vcu, G, bid, wave_s;
    const Params* p; unsigned char* ws;
};
__device__ __forceinline__ bf16_t* xr_row(const Frame& F, int r) { return (bf16_t*)(F.ws + WS_XR) + (size_t)r * D; }
__device__ __forceinline__ const float* xin_row(const Frame& F, int r) {
    const int b = r / LT, p = r % LT;
    return p < CTXL ? F.p->in[I_CTX] + ((size_t)(b * CTXL + p)) * D : F.p->in[I_X] + ((size_t)(b * SEQ + p - CTXL)) * D;
}
__device__ __forceinline__ int q_next(Frame& F, int q) {
    __syncthreads();
    if (F.tid == 0) F.MISC[16] = __hip_atomic_fetch_add((unsigned*)(F.ctl + CW_Q + 64 * q), 1u, __ATOMIC_RELAXED, __HIP_MEMORY_SCOPE_AGENT);
    __syncthreads();
    return (int)F.MISC[16];
}

__device__ __forceinline__ void tr_item(const float* src, int ldw, int k0, int c0, bf16_t* dst, size_t dp, int r0, int kd0, LAS float* scr, int lane) {
    f32x4 v[8];
#pragma unroll
    for (int i = 0; i < 8; ++i) { const int kk = (lane >> 3) + 8 * i; v[i] = *(const GAS f32x4*)(src + (size_t)(k0 + kk) * ldw + c0 + 4 * (lane & 7)); }
#pragma unroll
    for (int i = 0; i < 8; ++i) { const int kk = (lane >> 3) + 8 * i; LAS float* d = scr + kk * 33 + 4 * (lane & 7); d[0] = v[i].x; d[1] = v[i].y; d[2] = v[i].z; d[3] = v[i].w; }
    LDS_WAIT(); asm volatile("" ::: "memory");
    const int c = lane & 7;
#pragma unroll
    for (int j = 0; j < 4; ++j) { const int n = (lane >> 3) + 8 * j; const LAS float* s = scr + (8 * c) * 33 + n;
        u32x4 o; o.x = pk2(s[0 * 33], s[1 * 33]); o.y = pk2(s[2 * 33], s[3 * 33]); o.z = pk2(s[4 * 33], s[5 * 33]); o.w = pk2(s[6 * 33], s[7 * 33]);
        *(GAS u32x4*)(dst + (size_t)(r0 + n) * dp + kd0 + 8 * c) = o; }
    LDS_WAIT(); asm volatile("" ::: "memory");
}
constexpr int TRL0 = 16 * 89 + 512 + 16 * 768, TRL1 = 16 * 65 + 512 + 8 * 16 + 16 * 768;
__device__ __forceinline__ void tr_moe_item(Frame& F, int l, int r, LAS float* scr) {
    const Params& P = *F.p; constexpr int IM = 768;
    const int e = r / IM, q = r % IM;
    if (q < 512) {
        const int up = q >> 8, qq = q & 255, kb = qq / 16, nb = qq % 16, n0 = nb * 32, blk = n0 >> 7, within = n0 & 127;
        const float* src = P.in[up ? I_WU : I_WG] + ((size_t)(l * 16 + e)) * 1024 * 512;
        bf16_t* dst = (bf16_t*)(F.ws + (l ? WS_GU1 : WS_GU0)) + (size_t)e * 1024 * 1024;
        tr_item(src, 512, kb * 64, n0, dst, 1024, blk * 256 + up * 128 + within, kb * 64, scr, F.lane);
    } else {
        const int qq = q - 512, kb = qq / 32, nb = qq % 32;
        const float* src = P.in[I_WD] + ((size_t)(l * 16 + e)) * 512 * 1024;
        tr_item(src, 1024, kb * 64, nb * 32, (bf16_t*)(F.ws + (l ? WS_D1 : WS_D0)) + (size_t)e * 1024 * 512, 512, nb * 32, kb * 64, scr, F.lane);
    }
}
template <int LIST> __device__ __forceinline__ void tr_list_range(Frame& F, int lo, int hi, int slot, int nslots) {
    const Params& P = *F.p;
    LAS float* scr = (LAS float*)(F.lds + F.wave * 16384);
    for (int it = lo + slot; it < hi; it += nslots) {
        int r = it;
        if (LIST == 0) {
            constexpr int I0 = 16 * 89, I1 = 512;
            if (r < I0) { const int kb = r / 89, nb = r % 89, n0 = nb * 32; tr_item(P.in[I_EVWIN], 2832, kb * 64, nb == 88 ? 2048 : n0 + (n0 >= 2048 ? 16 : 0), (bf16_t*)(F.ws + WS_WIN0), 1024, n0, kb * 64, scr, F.lane); continue; } r -= I0;
            if (r < I1) { const int kb = r / 32, nb = r % 32; tr_item(P.in[I_EVWOUT], 1024, kb * 64, nb * 32, (bf16_t*)(F.ws + WS_WOUT0), 1024, nb * 32, kb * 64, scr, F.lane); continue; } r -= I1;
            tr_moe_item(F, 0, r, scr);
        } else {
            constexpr int I2 = 16 * 65, I3 = 512, I4 = 8 * 16;
            if (r < I2) { const int kb = r / 65, nb = r % 65; tr_item(P.in[I_ODWIN], 2064, kb * 64, nb == 64 ? 2032 : nb * 32, (bf16_t*)(F.ws + WS_WIN1), 1024, nb * 32, kb * 64, scr, F.lane); continue; } r -= I2;
            if (r < I3) { const int kb = r / 32, nb = r % 32; tr_item(P.in[I_ODWOUT], 1024, kb * 64, nb * 32, (bf16_t*)(F.ws + WS_WOUT1), 1024, nb * 32, kb * 64, scr, F.lane); continue; } r -= I3;
            if (r < I4) { const int kb = r / 16, nb = r % 16; tr_item(P.in[I_GLUW], 512, kb * 64, nb * 32, (bf16_t*)(F.ws + WS_WGLU), 512, nb * 32, kb * 64, scr, F.lane); continue; } r -= I4;
            tr_moe_item(F, 1, r, scr);
        }
    }
}
__device__ __forceinline__ void p0_prologue(Frame& F) {
    const Params& P = *F.p;
    if (F.bid < 192) {
        const int l = F.bid / 96, cb = F.bid % 96;
        LAS float* sc = (LAS float*)F.lds;
        LAS float* red = (LAS float*)(F.lds + 17 * 1024 * 4);
        {
#pragma unroll 1
            for (int h = 0; h < 2; ++h) {
                float cv[17];
#pragma unroll
                for (int u = 0; u < 17; ++u) { const int i = F.tid + (17 * h + u) * NTHREADS; const int m = i >> 10, k = i & 1023; cv[u] = m < 16 ? P.in[I_C][m * 1024 + k] : P.in[I_CCTX][k]; }
#pragma unroll
                for (int u = 0; u < 17; ++u) sc[F.tid + (17 * h + u) * NTHREADS] = siluf_(cv[u]);
            }
        }
        __syncthreads();
        const int kq = F.tid >> 6, col = F.tid & 63;
        float acc[17];
#pragma unroll
        for (int m = 0; m < 17; ++m) acc[m] = 0.f;
        const float* w = P.in[I_ADAW] + (size_t)l * 1024 * 6144 + cb * 64 + col;
#pragma unroll 1
        for (int k0 = kq; k0 < 1024; k0 += 128) {
            float wv[16];
#pragma unroll
            for (int u = 0; u < 16; ++u) wv[u] = w[(size_t)(k0 + 8 * u) * 6144];
#pragma unroll
            for (int u = 0; u < 16; ++u) {
#pragma unroll
                for (int m = 0; m < 17; ++m) acc[m] += sc[m * 1024 + k0 + 8 * u] * wv[u];
                if ((u & 1) == 1) __builtin_amdgcn_sched_barrier(0); }
        }
#pragma unroll
        for (int m = 0; m < 17; ++m) red[(kq * 17 + m) * 64 + col] = acc[m];
        __syncthreads();
        for (int i = F.tid; i < 17 * 64; i += NTHREADS) { const int m = i >> 6, c2 = i & 63; float s = 0.f;
#pragma unroll
            for (int q = 0; q < 8; ++q) s += red[(q * 17 + m) * 64 + c2];
            ((float*)(F.ws + WS_MOD))[((size_t)l * 17 + m) * 6144 + cb * 64 + c2] = s + P.in[I_ADAB][l * 6144 + cb * 64 + c2]; }
        __syncthreads();
    }
    {
        u32x4* z0 = (u32x4*)(F.ws + WS_WIN0 + (size_t)2848 * 2048); u32x4* z1 = (u32x4*)(F.ws + WS_WIN1 + (size_t)2080 * 2048);
        const int n16 = 224 * 2048 / 16; const u32x4 zz = (u32x4){0u, 0u, 0u, 0u};
        for (int i = F.bid * NTHREADS + F.tid; i < n16; i += F.G * NTHREADS) { z0[i] = zz; z1[i] = zz; }
    }
    tr_list_range<0>(F, 0, TRL0, F.vcu * NWAVES + F.wave, F.G * NWAVES);
    tr_list_range<1>(F, 0, TRL1, F.vcu * NWAVES + F.wave, F.G * NWAVES);
}

template <int MODE> __device__ __forceinline__ void norm_phase(Frame& F) {
    const Params& P = *F.p;
    constexpr int NS = (MODE == 0) ? 0 : (MODE == 2 ? 16 : 20);
    constexpr int layer = (MODE >= 2) ? 1 : 0;
    constexpr bool ROUTER = (MODE == 1 || MODE == 3);
    LAS f32x4* Wsm = (LAS f32x4*)F.lds;
    LAS int* cnt = (LAS int*)(F.lds + 4 * NS * 64 * 16);
    LAS f32x4* ABm = (LAS f32x4*)(F.lds + 4 * NS * 64 * 16 + 256);
    if constexpr (NS > 0) {
        LAS float* Wf = (LAS float*)F.lds;
        constexpr int NIT = 1024 * NS / NTHREADS;
#pragma unroll 1
        for (int it = 0; it < NIT; it += 8) {
            float vv[8];
#pragma unroll
            for (int u = 0; u < 8; ++u) { const int i = F.tid + (it + u) * NTHREADS; const int k = i / NS, n = i % NS;
                if (MODE == 0) vv[u] = P.in[I_EVWIN][(size_t)k * 2832 + 2048 + n];
                else if (MODE == 2) vv[u] = P.in[I_ODWIN][(size_t)k * 2064 + 2048 + n];
                else vv[u] = n < 4 ? P.in[I_GRW][(size_t)layer * 4096 + k * 4 + n] : P.in[I_ERW][(size_t)layer * 16384 + k * 16 + (n - 4)]; }
#pragma unroll
            for (int u = 0; u < 8; ++u) { const int i = F.tid + (it + u) * NTHREADS; const int k = i / NS, n = i % NS;
                const int j = k >> 8, ln = (k & 255) >> 2, e = k & 3;
                Wf[((j * NS + n) * 64 + ln) * 4 + e] = vv[u]; }
        }
    }
    if (F.tid < 32) cnt[F.tid] = 0;
    const int rw0 = F.bid * ROWS_PER_WG;
    const int m_first = ((rw0 % LT) < CTXL) ? 16 : rw0 / LT;
    {
        const float* gain_ = P.in[(MODE == 1 || MODE == 3) ? I_NFFN : I_NMIX] + ((MODE >= 2) ? 1 : 0) * 1024;
        const float* mod_ = (const float*)(F.ws + WS_MOD) + (size_t)((MODE >= 2) ? 1 : 0) * 17 * 6144;
        constexpr int SH_ = (MODE == 1 || MODE == 3) ? 3072 : 0, SC_ = (MODE == 1 || MODE == 3) ? 4096 : 1024;
        const int rl = rw0 + ROWS_PER_WG - 1; const int m_last = ((rl % LT) < CTXL) ? 16 : rl / LT;
        { const int slot = F.tid >> 8, i4 = F.tid & 255; const int m = slot ? m_last : m_first;
          const f32x4 g = ((const f32x4*)gain_)[i4], s2 = ((const f32x4*)(mod_ + m * 6144 + SC_))[i4], b2 = ((const f32x4*)(mod_ + m * 6144 + SH_))[i4];
          ABm[(slot * 2 + 0) * 256 + i4] = g * (s2 + 1.0f); ABm[(slot * 2 + 1) * 256 + i4] = b2; }
    }
    __syncthreads();
    const float* gain = P.in[ROUTER ? I_NFFN : I_NMIX] + layer * 1024;
    const float* mod = (const float*)(F.ws + WS_MOD) + (size_t)layer * 17 * 6144;
    constexpr int SH = ROUTER ? 3072 : 0, SC = ROUTER ? 4096 : 1024;
    constexpr int NE0 = ROUTER ? 4 : 0;
    bf16_t* HB = (bf16_t*)(F.ws + WS_HB);
    int cur = -1; f32x4 Av[4], Bv[4];
    const int r0 = wave_row0(F.bid, F.wave);
    f32x4 nx[3][4]; u32x2 nb[3][4];
    auto ldrow = [&](int r, f32x4 (&a)[4], u32x2 (&bq)[4]) {
        if (MODE == 0) { const float* src = xin_row(F, r);
#pragma unroll
            for (int j = 0; j < 4; ++j) a[j] = ((const GAS f32x4*)src)[64 * j + F.lane]; }
        else { const bf16_t* src = xr_row(F, r);
#pragma unroll
            for (int j = 0; j < 4; ++j) bq[j] = ((const GAS u32x2*)src)[64 * j + F.lane]; } };
#pragma unroll
    for (int q = 0; q < 3; ++q) ldrow(r0 + q, nx[q], nb[q]);
#pragma unroll 1
    for (int ri3 = 0; ri3 < ROWS_PER_WAVE; ri3 += 3) {
#pragma unroll
      for (int q = 0; q < 3; ++q) {
        const int ri = ri3 + q;
        const int r = r0 + ri; const int b = r / LT; const bool isctx = (r % LT) < CTXL;
        f32x4 v[4];
#pragma unroll
        for (int j = 0; j < 4; ++j) { if (MODE == 0) v[j] = nx[q][j]; else v[j] = (f32x4){bflo(nb[q][j].x), bfhi(nb[q][j].x), bflo(nb[q][j].y), bfhi(nb[q][j].y)}; }
        if (ri + 3 < ROWS_PER_WAVE) ldrow(r + 3, nx[q], nb[q]);
        if (MODE == 3 && isctx) continue;
        const int m = isctx ? 16 : b;
        if (m != cur) { cur = m; const int slot = (m == m_first) ? 0 : 1;
#pragma unroll
            for (int j = 0; j < 4; ++j) { Av[j] = ABm[(slot * 2 + 0) * 256 + 64 * j + F.lane]; Bv[j] = ABm[(slot * 2 + 1) * 256 + 64 * j + F.lane]; } }
        float ss = 0.f;
#pragma unroll
        for (int j = 0; j < 4; ++j) ss += (v[j].x * v[j].x + v[j].y * v[j].y) + (v[j].z * v[j].z + v[j].w * v[j].w);
        const float rstd = rsqrtf(wave_sum(ss) * (1.f / D) + NORM_EPS);
#pragma unroll
        for (int j = 0; j < 4; ++j) v[j] = v[j] * rstd * Av[j] + Bv[j];
        GAS u32x2* o8 = (GAS u32x2*)(HB + (size_t)r * D) + F.lane;
#pragma unroll
        for (int j = 0; j < 4; ++j) { u32x2 w; w.x = pk2(v[j].x, v[j].y); w.y = pk2(v[j].z, v[j].w); o8[64 * j] = w; }
        if constexpr (NS > 0) {
        auto coldot = [&](int n) -> float { f32x2_t a2 = {0.f, 0.f};
#pragma unroll
            for (int j = 0; j < 4; ++j) { const f32x4 w = Wsm[(j * NS + n) * 64 + F.lane];
                a2 = __builtin_elementwise_fma((f32x2_t){v[j].x, v[j].y}, (f32x2_t){w.x, w.y}, a2); a2 = __builtin_elementwise_fma((f32x2_t){v[j].z, v[j].w}, (f32x2_t){w.z, w.w}, a2); }
            return a2.x + a2.y; };
        auto reduce4 = [&](float (&p)[4]) {
            const bool b3 = F.lane & 8, b2 = F.lane & 4;
            float t2[2];
#pragma unroll
            for (int i = 0; i < 2; ++i) { const float keep = b3 ? p[i + 2] : p[i], send = b3 ? p[i] : p[i + 2]; t2[i] = keep + xorl<8>(send); }
            float e; { const float keep = b2 ? t2[1] : t2[0], send = b2 ? t2[0] : t2[1]; e = keep + xorl<4>(send); }
            e += xorl<2>(e); e += xorl<1>(e);
            e += xorl<16>(e); e += xorl<32>(e);
#pragma unroll
            for (int i = 0; i < 4; ++i) p[i] = rdlane(e, 4 * i);
        };
        if constexpr (!ROUTER) {
        if (isctx) {
        float a16[16];
#pragma unroll
        for (int g4 = 0; g4 < NS / 4; ++g4) {
#pragma unroll
            for (int q = 0; q < 4; ++q) a16[4 * g4 + q] = coldot(4 * g4 + q);
            asm volatile("" ::: "memory");
        }
        float e16;
        {
            const bool b5 = F.lane & 32, b4 = F.lane & 16, b3 = F.lane & 8, b2 = F.lane & 4;
            float t8[8], t4[4], t2[2];
#pragma unroll
            for (int i = 0; i < 8; ++i) { const float keep = b5 ? a16[i + 8] : a16[i], send = b5 ? a16[i] : a16[i + 8]; t8[i] = keep + xorl<32>(send); }
#pragma unroll
            for (int i = 0; i < 4; ++i) { const float keep = b4 ? t8[i + 4] : t8[i], send = b4 ? t8[i] : t8[i + 4]; t4[i] = keep + xorl<16>(send); }
#pragma unroll
            for (int i = 0; i < 2; ++i) { const float keep = b3 ? t4[i + 2] : t4[i], send = b3 ? t4[i] : t4[i + 2]; t2[i] = keep + xorl<8>(send); }
            { const float keep = b2 ? t2[1] : t2[0], send = b2 ? t2[0] : t2[1]; e16 = keep + xorl<4>(send); }
            e16 += xorl<2>(e16); e16 += xorl<1>(e16);
        }
            if ((F.lane & 3) == 0) ((float*)(F.ws + WS_GATES))[(size_t)r * 16 + (F.lane >> 2)] = e16;
        }
        } else {
            float grp[4];
#pragma unroll
            for (int n = 0; n < 4; ++n) grp[n] = coldot(n);
#pragma unroll
            for (int n = 0; n < 4; ++n) grp[n] = wave_sum(grp[n]);
            const float* grb = P.in[I_GRB] + layer * 4; const float* erb = P.in[I_ERB] + layer * 16;
            float gl[4]; int gi = 0; float gm = -1e30f;
#pragma unroll
            for (int n = 0; n < 4; ++n) { gl[n] = grp[n] + grb[n]; if (gl[n] > gm) { gm = gl[n]; gi = n; } }
            float gs = 0.f;
#pragma unroll
            for (int n = 0; n < 4; ++n) gs += __expf(gl[n] - gm);
            const float gp = 1.f / gs;
            float el[4];
#pragma unroll
            for (int n = 0; n < 4; ++n) el[n] = 0.f;
            {
                const int gis = __builtin_amdgcn_readfirstlane(gi);
                if (gis == 0) { _Pragma("unroll") for (int n = 0; n < 4; ++n) el[n] = coldot(4 + n); }
                else if (gis == 1) { _Pragma("unroll") for (int n = 0; n < 4; ++n) el[n] = coldot(8 + n); }
                else if (gis == 2) { _Pragma("unroll") for (int n = 0; n < 4; ++n) el[n] = coldot(12 + n); }
                else { _Pragma("unroll") for (int n = 0; n < 4; ++n) el[n] = coldot(16 + n); }
            }
#pragma unroll
            for (int n = 0; n < 4; ++n) el[n] = wave_sum(el[n]);
#pragma unroll
            for (int n = 0; n < 4; ++n) el[n] += erb[4 * gi + n];
            int i0 = 0; float v0 = el[0];
#pragma unroll
            for (int n = 1; n < 4; ++n) if (el[n] > v0) { v0 = el[n]; i0 = n; }
            int i1 = -1; float v1 = -1e30f;
#pragma unroll
            for (int n = 0; n < 4; ++n) if (n != i0 && el[n] > v1) { v1 = el[n]; i1 = n; }
            const float e1 = __expf(v1 - v0); const float w0 = gp / (1.f + e1), w1 = gp * e1 / (1.f + e1);
            const int ea = i0 < i1 ? i0 : i1, eb = i0 < i1 ? i1 : i0; const float wa = i0 < i1 ? w0 : w1, wb = i0 < i1 ? w1 : w0;
            const int pidx = (ea == 0) ? (eb - 1) : (ea == 1 ? eb + 1 : 5);
            const int cls = gi * 6 + pidx;
            if (F.lane == 0) {
                ((int*)(F.ws + WS_ROUTE + RT_CLS))[r] = cls;
                ((float*)(F.ws + WS_ROUTE + RT_WTS))[2 * (size_t)r] = wa; ((float*)(F.ws + WS_ROUTE + RT_WTS))[2 * (size_t)r + 1] = wb;
                atomicAdd((int*)&cnt[cls], 1);
            }
        }
        }
    }
    }
    if (ROUTER) {
        __syncthreads();
        if (F.tid < NCLS) ((int*)(F.ws + WS_ROUTE + RT_CNT))[F.bid * NCLS + F.tid] = cnt[F.tid];
    }
}

struct MoeTab { LAS int* base; LAS int* tot; LAS int* mine; LAS int* ntile; };
__device__ __forceinline__ MoeTab moe_tables(Frame& F, LAS unsigned char* at, bool with_mine) {
    MoeTab T; T.base = (LAS int*)at; T.tot = T.base + 32; T.mine = T.tot + 32; T.ntile = T.mine + 32;
    const int* cnt = (const int*)(F.ws + WS_ROUTE + RT_CNT);
    LAS int* part = T.ntile + 32;
    __syncthreads();
    { const int c = F.tid & 31, pt = F.tid >> 5; int t = 0, m = 0;
      if (c < NCLS) {
#pragma unroll
          for (int i = 0; i < 16; ++i) { const int w = pt * 16 + i; const int v = cnt[w * NCLS + c]; t += v; m += (w < F.bid) ? v : 0; } }
      part[(pt * 2 + 0) * 32 + c] = t; part[(pt * 2 + 1) * 32 + c] = m; }
    __syncthreads();
    if (F.tid < NCLS) { int t = 0, m = 0; for (int pt = 0; pt < 16; ++pt) { t += part[(pt * 2 + 0) * 32 + F.tid]; m += part[(pt * 2 + 1) * 32 + F.tid]; } T.tot[F.tid] = t; T.mine[F.tid] = m; }
    __syncthreads();
    if (F.tid == 0) { int pos = 0; for (int c = 0; c < NCLS; ++c) { T.base[c] = pos; pos += ((T.tot[c] + 255) >> 8) << 8; } T.ntile[0] = pos >> 8; }
    __syncthreads();
    (void)with_mine;
    return T;
}
__device__ __forceinline__ void cls_experts(int cls, int& ea, int& eb) {
    const int g = cls / 6, pi = cls % 6; int a, b;
    if (pi < 3) { a = 0; b = pi + 1; } else if (pi < 5) { a = 1; b = pi - 1; } else { a = 2; b = 3; }
    ea = g * 4 + a; eb = g * 4 + b;
}
template <int LAYER> __device__ __forceinline__ void route_phase(Frame& F) {
    MoeTab T = moe_tables(F, F.lds, true);
    LAS int* posr = (LAS int*)(F.lds + 8192);
    const int* clsg = (const int*)(F.ws + WS_ROUTE + RT_CLS);
    int* tok = (int*)(F.ws + WS_ROUTE + RT_TOK); float* wpos = (float*)(F.ws + WS_ROUTE + RT_WPOS); const float* wts = (const float*)(F.ws + WS_ROUTE + RT_WTS);
    if (F.wave == 0) {
        int run = 0;
        for (int q = 0; q < 3; ++q) {
            const int i = q * 64 + F.lane; int cls = -1;
            if (i < ROWS_PER_WG) { const int r = wave_row0(F.bid, i / ROWS_PER_WAVE) + i % ROWS_PER_WAVE; if (!(LAYER == 1 && row_is_ctx(r))) cls = clsg[r]; }
            int mypos = -1;
            for (int c = 0; c < NCLS; ++c) {
                const unsigned long long mask = __ballot(cls == c);
                const int rank = __popcll(mask & ((1ull << F.lane) - 1ull));
                const int runc = __builtin_amdgcn_readlane(run, c);
                if (cls == c) mypos = T.base[c] + T.mine[c] + runc + rank;
                if (F.lane == c) run += __popcll(mask);
            }
            if (i < ROWS_PER_WG) posr[i] = mypos;
        }
    }
    __syncthreads();
    for (int i = F.tid; i < ROWS_PER_WG; i += NTHREADS) { const int pos = posr[i];
        if (pos >= 0) { const int r = wave_row0(F.bid, i / ROWS_PER_WAVE) + i % ROWS_PER_WAVE; tok[pos] = r; wpos[2 * (size_t)pos] = wts[2 * (size_t)r]; wpos[2 * (size_t)pos + 1] = wts[2 * (size_t)r + 1]; } }
    if (F.bid < NCLS) {
        const int c = F.bid, lo = T.base[c] + T.tot[c], hi = T.base[c] + (((T.tot[c] + 255) >> 8) << 8);
        for (int p = lo + F.tid; p < hi; p += NTHREADS) { tok[p] = -1; wpos[2 * (size_t)p] = 0.f; wpos[2 * (size_t)p + 1] = 0.f; }
    }
}
namespace pg8 {
constexpr int BM = 256, BK = 64, HALF = 128, HTB = HALF * BK * 2, STAGE_BYTES = 8 * HTB;
__host__ __device__ __forceinline__ int lds_byte(int r, int c) { const int st = (r >> 4) * 2 + (c >> 5), rr = r & 15, cc = c & 31, ob = rr * 64 + cc * 2; return st * 1024 + (ob ^ (((ob >> 9) & 1) << 5)); }
__host__ __device__ __forceinline__ void stage_rc(int b, int& R_, int& C_) { const int st = b / 1024, sb = b % 1024, swz = sb ^ (((sb >> 9) & 1) << 5); R_ = (st >> 1) * 16 + swz / 64; C_ = (st & 1) * 32 + (swz % 64) / 2; }
__host__ __device__ __forceinline__ int perm32(int rho) { const int n = rho >> 4, i = rho & 15; return 8 * (i >> 2) + 4 * n + (i & 3); }

struct Unit { const char* a; const char* b; int bdelta; int pm, pn, aux; const int* rows; };
struct Gemm { int pitchA, pitchB, K; };

template <class Epi, class Sched, bool ALIGN_EPI, bool GATHER = false>
__device__ __forceinline__ void gemm_phase(LAS unsigned char* lds, const Gemm g, const Sched& S, const Epi& E, int wave_s) {
    const int tid = opaque_tid(wave_s), wid = __builtin_amdgcn_readfirstlane(tid >> 6), lane = tid & 63, wr = wid >> 2, wc = wid & 3, fr = lane & 15, fq = lane >> 4;
    const int K = g.K, nt = K / BK;
    unsigned voffA[2], voffB[2]; int RA[2], CA[2];
#pragma unroll
    for (int i = 0; i < 2; ++i) { int R_, C_; stage_rc(tid * 16 + i * 8192, R_, C_); const int Rb = Epi::PERM ? ((R_ & ~31) + perm32(R_ & 31)) : R_; RA[i] = R_; CA[i] = C_;
        voffA[i] = (unsigned)(R_ * g.pitchA + C_) * 2u; voffB[i] = (unsigned)(Rb * g.pitchB + C_) * 2u; }
    unsigned gC[2][2], gN[2][2];
    auto gload = [&](const Unit& u, unsigned (&go)[2][2]) {
#pragma unroll
        for (int h = 0; h < 2; ++h)
#pragma unroll
            for (int i = 0; i < 2; ++i) { int r = u.rows[h * HALF + RA[i]]; r = r < 0 ? 0 : r; go[h][i] = (unsigned)(r * g.pitchA + CA[i]) * 2u; } };
    const size_t kstep = (size_t)(BK * 2);
    const size_t hstepA = (size_t)HALF * g.pitchA * 2, hstepB = (size_t)HALF * g.pitchB * 2;
    const unsigned ldsw = (unsigned)wid * 1024u;
    const int aoff = lds_byte(wr * 64 + fr, fq * 8), boff = lds_byte(wc * 32 + fr, fq * 8);
#define PG8_SA(b, h) (((b) * 2 + (h)) * HTB)
#define PG8_SB(b, h) ((4 + (b) * 2 + (h)) * HTB)
#define PG8_STAGE(bufoff, gbase, voff) do { _Pragma("unroll") for (int _i = 0; _i < 2; ++_i) \
        __builtin_amdgcn_global_load_lds((const unsigned*)((const char*)(gbase) + (voff)[_i]), (LAS unsigned*)(lds + (bufoff) + ldsw + _i * 8192), 16, 0, 0); } while (0)
#define PG8_STAGE_A(bufoff, gbase, h, NX) do { if constexpr (GATHER) { _Pragma("unroll") for (int _i = 0; _i < 2; ++_i) { const unsigned _o = (NX) ? gN[h][_i] : gC[h][_i]; \
        __builtin_amdgcn_global_load_lds((const unsigned*)((const char*)(gbase) + _o), (LAS unsigned*)(lds + (bufoff) + ldsw + _i * 8192), 16, 0, 0); } } \
    else { PG8_STAGE(bufoff, (const char*)(gbase) + (h) * hstepA, voffA); } } while (0)
#define PG8_LDA(dst, b, h) do { _Pragma("unroll") for (int m = 0; m < 4; ++m) _Pragma("unroll") for (int k = 0; k < 2; ++k) dst[m][k] = *(const LAS bf16x8*)(lds + PG8_SA(b, h) + aoff + m * 2048 + k * 1024); } while (0)
#define PG8_LDB(dst, b, h) do { _Pragma("unroll") for (int n = 0; n < 2; ++n) _Pragma("unroll") for (int k = 0; k < 2; ++k) dst[n][k] = *(const LAS bf16x8*)(lds + PG8_SB(b, h) + boff + n * 2048 + k * 1024); } while (0)
#define PG8_MMA(ai, bj, At, Bt) do { __builtin_amdgcn_s_setprio(1); _Pragma("unroll") for (int m = 0; m < 4; ++m) _Pragma("unroll") for (int n = 0; n < 2; ++n) _Pragma("unroll") for (int k = 0; k < 2; ++k) \
        acc[ai][bj][m][n] = __builtin_amdgcn_mfma_f32_16x16x32_bf16(Bt[n][k], At[m][k], acc[ai][bj][m][n], 0, 0, 0); __builtin_amdgcn_s_setprio(0); } while (0)
#define PG8_WAIT_V(n) asm volatile("s_waitcnt vmcnt(" #n ")" ::: "memory")
#define PG8_WAIT_L(n) asm volatile("s_waitcnt lgkmcnt(" #n ")" ::: "memory")
#define PG8_BAR __builtin_amdgcn_s_barrier()
#define PG8_SCHED __builtin_amdgcn_sched_barrier(0)
    Unit cur, nxt; int ui = 0;
    if (!S.next(0, cur)) return;
    f32x4 acc[2][2][4][2];
#pragma unroll
    for (int a = 0; a < 2; ++a)
#pragma unroll
        for (int b = 0; b < 2; ++b)
#pragma unroll
            for (int m = 0; m < 4; ++m)
#pragma unroll
                for (int n = 0; n < 2; ++n) acc[a][b][m][n] = (f32x4){0.f, 0.f, 0.f, 0.f};
    bf16x8 At[4][2], B0[2][2], B1[2][2];
    const char* cA = cur.a; const char* cB = cur.b;
    if constexpr (GATHER) gload(cur, gC);
    PG8_STAGE(PG8_SB(0, 0), cB, voffB); PG8_STAGE(PG8_SB(0, 1), cB + hstepB, voffB); PG8_STAGE_A(PG8_SA(0, 0), cA, 0, false); PG8_STAGE_A(PG8_SA(0, 1), cA, 1, false);
    if (wr == 1) PG8_BAR;
    PG8_WAIT_V(2); PG8_BAR;
    PG8_STAGE(PG8_SB(1, 0), cB + kstep, voffB); PG8_STAGE_A(PG8_SA(1, 0), cA + kstep, 0, false); PG8_STAGE(PG8_SB(1, 1), cB + hstepB + kstep, voffB);
    PG8_WAIT_V(6); PG8_BAR;
    for (;;) {
        const bool has_next = S.next(ui + 1, nxt);
        const char* nA = has_next ? nxt.a : cA; const char* nB = has_next ? nxt.b : cB;
        if constexpr (GATHER) { if (has_next) gload(nxt, gN); else { _Pragma("unroll") for (int h = 0; h < 2; ++h) _Pragma("unroll") for (int i = 0; i < 2; ++i) gN[h][i] = gC[h][i]; } }
        const int bdelta = cur.bdelta;
        for (int t = 0; t < nt; t += 2) {
            const bool last = (t == nt - 2);
            const char* a1 = cA + (size_t)(t + 1) * kstep;
            const char* a2 = last ? nA : cA + (size_t)(t + 2) * kstep;
            const char* b2 = last ? nB : cB + (size_t)(t + 2) * kstep + ((2 * (t + 2) >= nt) ? bdelta : 0);
            const char* a3 = a2 + kstep; const char* b3 = b2 + kstep;
            PG8_LDB(B0, 0, 0); PG8_LDB(B1, 0, 1); PG8_SCHED; PG8_LDA(At, 0, 0); PG8_STAGE_A(PG8_SA(1, 1), a1, 1, false);
            PG8_WAIT_V(8); PG8_WAIT_L(0); PG8_BAR; PG8_MMA(0, 0, At, B0); PG8_MMA(0, 1, At, B1); PG8_BAR; PG8_SCHED;
            PG8_LDA(At, 0, 1); PG8_STAGE(PG8_SB(0, 0), b2, voffB); PG8_STAGE(PG8_SB(0, 1), b2 + hstepB, voffB); PG8_STAGE_A(PG8_SA(0, 0), a2, 0, last);
            PG8_WAIT_V(8); PG8_WAIT_L(0); PG8_BAR; PG8_MMA(1, 0, At, B0); PG8_MMA(1, 1, At, B1); PG8_BAR; PG8_SCHED;
            PG8_LDB(B0, 1, 0); PG8_LDB(B1, 1, 1); PG8_SCHED; PG8_LDA(At, 1, 0); PG8_STAGE_A(PG8_SA(0, 1), a2, 1, last);
            PG8_WAIT_V(8); PG8_WAIT_L(0); PG8_BAR; PG8_MMA(0, 0, At, B0); PG8_MMA(0, 1, At, B1); PG8_BAR; PG8_SCHED;
            PG8_LDA(At, 1, 1); PG8_STAGE(PG8_SB(1, 0), b3, voffB); PG8_STAGE(PG8_SB(1, 1), b3 + hstepB, voffB); PG8_STAGE_A(PG8_SA(1, 0), a3, 0, last);
            PG8_WAIT_V(8); PG8_WAIT_L(0); PG8_BAR; PG8_MMA(1, 0, At, B0); PG8_MMA(1, 1, At, B1); PG8_BAR; PG8_SCHED;
        }
        if constexpr (ALIGN_EPI) { if (wr == 0) PG8_BAR; }
        E(acc, cur, wr, wc, fr, fq);
        if (!has_next) break;
#pragma unroll
        for (int a = 0; a < 2; ++a)
#pragma unroll
            for (int b = 0; b < 2; ++b)
#pragma unroll
                for (int m = 0; m < 4; ++m)
#pragma unroll
                    for (int n = 0; n < 2; ++n) acc[a][b][m][n] = (f32x4){0.f, 0.f, 0.f, 0.f};
        cur = nxt; cA = nA; cB = nB; ++ui;
        if constexpr (GATHER) { _Pragma("unroll") for (int h = 0; h < 2; ++h) _Pragma("unroll") for (int i = 0; i < 2; ++i) gC[h][i] = gN[h][i]; }
        if constexpr (ALIGN_EPI) { if (wr == 1) PG8_BAR; }
    }
    PG8_WAIT_V(0);
    if constexpr (!ALIGN_EPI) { if (wr == 0) PG8_BAR; }
    PG8_BAR;
#undef PG8_SA
#undef PG8_SB
#undef PG8_STAGE
#undef PG8_STAGE_A
#undef PG8_LDA
#undef PG8_LDB
#undef PG8_MMA
#undef PG8_WAIT_V
#undef PG8_WAIT_L
#undef PG8_BAR
#undef PG8_SCHED
}

__device__ __forceinline__ bool order_next(int i, int G, int c, int nM, int nN, int& im, int& pn) {
    const int nwg = nM * nN; const long L = (long)i * G + c; if (L >= nwg) return false;
    int wgid = (int)L; { const int q = nwg / 8, r = nwg % 8, xcd = wgid % 8, off = wgid / 8; wgid = (xcd < r ? xcd * (q + 1) : r * (q + 1) + (xcd - r) * q) + off; }
    const int WGM = 8, nig = WGM * nN, gid = wgid / nig, fm = gid * WGM, gsz = (nM - fm) < WGM ? (nM - fm) : WGM;
    im = fm + ((wgid % nig) % gsz); pn = (wgid % nig) / gsz; return true;
}
template <bool LATENT> struct DenseSched {
    const char* A; const char* B; int nN, G, c; size_t strideA, strideB;
    __device__ __forceinline__ bool next(int i, Unit& u) const {
        int im, pn; if (!order_next(i, G, c, LATENT ? 128 : 144, nN, im, pn)) return false;
        const int tile = LATENT ? (9 * (im >> 3) + 1 + (im & 7)) : im;
        u.a = A + (size_t)tile * strideA; u.b = B + (size_t)pn * strideB; u.bdelta = 0; u.pm = tile; u.pn = pn; u.aux = 0; u.rows = nullptr; return true;
    }
};
struct InProj1Sched {
    const char* A; const char* B; int G, c; size_t strideA, strideB;
    __device__ __forceinline__ bool next(int i, Unit& u) const {
        const long L = (long)i * G + c; int tile, pn;
        if (L < 144 * 8) { if (!order_next(i, G, c, 144, 8, tile, pn)) return false; }
        else { const int q = (int)(L - 144 * 8); if (q >= 128) return false; tile = 9 * (q >> 3) + 1 + (q & 7); pn = 8; }
        u.a = A + (size_t)tile * strideA; u.b = B + (size_t)pn * strideB; u.bdelta = 0; u.pm = tile; u.pn = pn; u.aux = 0; u.rows = nullptr; return true;
    }
};
struct MoeSched {
    const char* A; const char* B; int nN, G, c, nT; const LAS int* base; bool down; const int* tok;
    __device__ __forceinline__ bool next(int i, Unit& u) const {
        int tile, un; if (!order_next(i, G, c, nT, nN, tile, un)) return false;
        int cls = 0;
#pragma unroll 1
        for (int q = 1; q < NCLS; ++q) if (base[q] <= tile * 256) cls = q;
        int ea, eb; cls_experts(cls, ea, eb);
        u.pm = tile; u.pn = un; u.rows = tok + tile * 256; u.a = down ? A + (size_t)tile * (256 * 1024 * 2) : A;
        if (!down) { const int e = (un < 4) ? ea : eb, blk = un & 3; u.b = B + (size_t)e * (1024 * 1024 * 2) + (size_t)blk * (256 * 1024 * 2); u.bdelta = 0; u.aux = un; }
        else { u.b = B + (size_t)ea * (1024 * 512 * 2) + (size_t)un * (256 * 512 * 2); u.bdelta = (eb - ea) * (1024 * 512 * 2) - 8 * 128; u.aux = 0; }
        return true;
    }
};

struct EpiStoreBf16 {
    static constexpr bool PERM = true;
    bf16_t* O; int ldc; int gate_pn; float* gates; int gate_fq0;
    __device__ __forceinline__ void operator()(const f32x4 (&acc)[2][2][4][2], const Unit& u, int wr, int wc, int fr, int fq) const {
        const int row0 = u.pm * BM + wr * 64 + fr, col0 = u.pn * BM + wc * 32 + 8 * fq;
        if (u.pn == gate_pn) {
            if (wc == 0 && (fq >> 1) == (gate_fq0 >> 1)) {
#pragma unroll
                for (int ai = 0; ai < 2; ++ai)
#pragma unroll
                    for (int m = 0; m < 4; ++m) { float* gp = gates + (size_t)(row0 + ai * HALF + m * 16) * 16 + 8 * (fq & 1);
                        *(f32x4*)gp = acc[ai][0][m][0]; *(f32x4*)(gp + 4) = acc[ai][0][m][1]; } }
            return;
        }
#pragma unroll
        for (int ai = 0; ai < 2; ++ai)
#pragma unroll
            for (int m = 0; m < 4; ++m) { bf16_t* rowp = O + (size_t)(row0 + ai * HALF + m * 16) * ldc + col0;
#pragma unroll
                for (int bj = 0; bj < 2; ++bj) { const f32x4 v0 = acc[ai][bj][m][0], v1 = acc[ai][bj][m][1];
                    u32x4 w; w.x = pk2(v0[0], v0[1]); w.y = pk2(v0[2], v0[3]); w.z = pk2(v1[0], v1[1]); w.w = pk2(v1[2], v1[3]);
                    *(u32x4*)(rowp + bj * HALF) = w; } }
    }
};
template <bool FROM_INPUTS> struct EpiResid {
    static constexpr bool PERM = true;
    const float* xin; const float* ctxin; bf16_t* xr; const float* mod  ;
    __device__ __forceinline__ void operator()(const f32x4 (&acc)[2][2][4][2], const Unit& u, int wr, int wc, int fr, int fq) const {
        const int b = u.pm / 9, t9 = u.pm % 9; const bool isctx = t9 == 0;
        const size_t rowoff = isctx ? (size_t)b * CTXL : (size_t)b * SEQ + (size_t)(t9 - 1) * 256;
        const float* src = (isctx ? ctxin : xin) + rowoff * D;
        bf16_t* dst = xr + (size_t)u.pm * BM * D;
        const float* gv = mod + (isctx ? 16 : b) * 6144;
        const int col0 = u.pn * BM + wc * 32 + 8 * fq;
        f32x4 g4[2][2];
#pragma unroll
        for (int bj = 0; bj < 2; ++bj)
#pragma unroll
            for (int n = 0; n < 2; ++n) g4[bj][n] = *(const f32x4*)(gv + col0 + bj * HALF + n * 4);
#pragma unroll
        for (int ai = 0; ai < 2; ++ai)
#pragma unroll
            for (int m = 0; m < 4; ++m) { const size_t off = (size_t)(ai * HALF + wr * 64 + m * 16 + fr) * D + col0;
#pragma unroll
                for (int bj = 0; bj < 2; ++bj) { f32x4 s0, s1;
                    if (FROM_INPUTS) { s0 = *(const f32x4*)(src + off + bj * HALF); s1 = *(const f32x4*)(src + off + bj * HALF + 4); }
                    else { const u32x4 q = *(const u32x4*)(dst + off + bj * HALF); s0 = (f32x4){bflo(q.x), bfhi(q.x), bflo(q.y), bfhi(q.y)}; s1 = (f32x4){bflo(q.z), bfhi(q.z), bflo(q.w), bfhi(q.w)}; }
                    s0 = s0 + g4[bj][0] * acc[ai][bj][m][0]; s1 = s1 + g4[bj][1] * acc[ai][bj][m][1];
                    u32x4 w; w.x = pk2(s0[0], s0[1]); w.y = pk2(s0[2], s0[3]); w.z = pk2(s1[0], s1[1]); w.w = pk2(s1[2], s1[3]);
                    *(u32x4*)(dst + off + bj * HALF) = w; }
                if (m & 1) asm volatile("" ::: "memory"); }
    }
};
struct EpiGlu {
    static constexpr bool PERM = true;
    const bf16_t* G; bf16_t* O; const float* bias;
    __device__ __forceinline__ void operator()(const f32x4 (&acc)[2][2][4][2], const Unit& u, int wr, int wc, int fr, int fq) const {
        const int row0 = u.pm * BM + wr * 64 + fr, col0 = u.pn * BM + wc * 32 + 8 * fq;
#pragma unroll
        for (int bj = 0; bj < 2; ++bj) { const f32x4 b0 = *(const f32x4*)(bias + col0 + bj * HALF), b1 = *(const f32x4*)(bias + col0 + bj * HALF + 4);
#pragma unroll
            for (int ai = 0; ai < 2; ++ai)
#pragma unroll
                for (int m = 0; m < 4; ++m) { const int row = row0 + ai * HALF + m * 16;
                    const u32x4 gq = *(const u32x4*)(G + (size_t)row * 512 + col0 + bj * HALF);
                    const f32x4 v0 = acc[ai][bj][m][0] + b0, v1 = acc[ai][bj][m][1] + b1;
                    u32x4 w;
                    w.x = pk2(bflo(gq.x) * sigmoidf_(v0[0]), bfhi(gq.x) * sigmoidf_(v0[1])); w.y = pk2(bflo(gq.y) * sigmoidf_(v0[2]), bfhi(gq.y) * sigmoidf_(v0[3]));
                    w.z = pk2(bflo(gq.z) * sigmoidf_(v1[0]), bfhi(gq.z) * sigmoidf_(v1[1])); w.w = pk2(bflo(gq.w) * sigmoidf_(v1[2]), bfhi(gq.w) * sigmoidf_(v1[3]));
                    *(u32x4*)(O + (size_t)row * D + col0 + bj * HALF) = w; } }
    }
};
struct EpiSwiGlu {
    static constexpr bool PERM = true;
    bf16_t* ACT; const float* wpos;
    __device__ __forceinline__ void operator()(const f32x4 (&acc)[2][2][4][2], const Unit& u, int wr, int wc, int fr, int fq) const {
        const int slot = u.aux >> 2, blk = u.aux & 3;
        const int row0 = u.pm * BM + wr * 64 + fr, col0 = slot * 512 + blk * 128 + wc * 32 + 8 * fq;
#pragma unroll
        for (int ai = 0; ai < 2; ++ai)
#pragma unroll
            for (int m = 0; m < 4; ++m) { const int row = row0 + ai * HALF + m * 16; const float w = wpos[2 * (size_t)row + slot];
                const f32x4 g0 = acc[ai][0][m][0], g1 = acc[ai][0][m][1], u0 = acc[ai][1][m][0], u1 = acc[ai][1][m][1];
                u32x4 o;
                o.x = pk2(w * siluf_(g0[0]) * u0[0], w * siluf_(g0[1]) * u0[1]); o.y = pk2(w * siluf_(g0[2]) * u0[2], w * siluf_(g0[3]) * u0[3]);
                o.z = pk2(w * siluf_(g1[0]) * u1[0], w * siluf_(g1[1]) * u1[1]); o.w = pk2(w * siluf_(g1[2]) * u1[2], w * siluf_(g1[3]) * u1[3]);
                *(u32x4*)(ACT + (size_t)row * D + col0) = o; }
    }
};
template <bool FINAL> struct EpiDown {
    static constexpr bool PERM = true;
    const int* tok; float* outp; bf16_t* xr; const float* mod  ;
    __device__ __forceinline__ void operator()(const f32x4 (&acc)[2][2][4][2], const Unit& u, int wr, int wc, int fr, int fq) const {
        const int col0 = u.pn * BM + wc * 32 + 8 * fq;
#pragma unroll
        for (int ai = 0; ai < 2; ++ai)
#pragma unroll
            for (int m = 0; m < 4; ++m) { const int pos = u.pm * BM + ai * HALF + wr * 64 + m * 16 + fr; const int r = tok[pos];
                if (r >= 0) { const int b = r / LT, p = r % LT; const bool isctx = p < CTXL;
                    bf16_t* xp = xr + (size_t)r * D + col0;
                    float* op = outp + ((size_t)(b * SEQ + p - CTXL)) * D + col0;
                    const float* gv = mod + (isctx ? 16 : b) * 6144 + col0;
#pragma unroll
                    for (int bj = 0; bj < 2; ++bj) { const u32x4 q = *(const u32x4*)(xp + bj * HALF);
                        const f32x4 g0 = *(const f32x4*)(gv + bj * HALF), g1 = *(const f32x4*)(gv + bj * HALF + 4);
                        const f32x4 s0 = (f32x4){bflo(q.x), bfhi(q.x), bflo(q.y), bfhi(q.y)} + g0 * acc[ai][bj][m][0], s1 = (f32x4){bflo(q.z), bfhi(q.z), bflo(q.w), bfhi(q.w)} + g1 * acc[ai][bj][m][1];
                        if (FINAL) { *(f32x4*)(op + bj * HALF) = s0; *(f32x4*)(op + bj * HALF + 4) = s1; }
                        else { u32x4 w; w.x = pk2(s0[0], s0[1]); w.y = pk2(s0[2], s0[3]); w.z = pk2(s1[0], s1[1]); w.w = pk2(s1[2], s1[3]); *(u32x4*)(xp + bj * HALF) = w; } } }
                if (m & 1) asm volatile("" ::: "memory"); }
    }
};
}
namespace attn_body {
constexpr int DH = 64, PQ = NP0, PO = D;
constexpr int NW = 8, QBLK = 32, QB = QBLK * NW, KVBLK = 64;
__device__ __forceinline__ int crow(int r, int hi) { return (r & 3) + 8 * (r >> 2) + 4 * hi; }
#define SBAR() __builtin_amdgcn_sched_barrier(0)
constexpr int NSLOT = 3, SLOTB = 8192;
constexpr int LDS_K = 0, LDS_V = NSLOT * SLOTB, LDS_WS = 2 * NSLOT * SLOTB, LDS_OST = LDS_WS + NW * 64 * 4, LDS_BYTES_A = LDS_OST + NW * 4096;
constexpr float C2 = 0.125f * 1.4426950408889634f;
__device__ __forceinline__ void glds16(const void* gsrc, unsigned lds_dst) { unsigned keep;
    asm volatile("s_mov_b32 %0, m0\n\ts_mov_b32 m0, %2\n\ts_nop 0\n\tglobal_load_lds_dwordx4 %1, off\n\ts_mov_b32 m0, %0" : "=&s"(keep) : "v"(gsrc), "s"(lds_dst) : "memory"); }
__device__ __forceinline__ float max3f(float a, float b, float c) { float r; asm("v_max3_f32 %0, %1, %2, %3" : "=v"(r) : "v"(a), "v"(b), "v"(c)); return r; }
__device__ __forceinline__ float max2f(float a, float b) { float r; asm("v_max_f32_e32 %0, %1, %2" : "=v"(r) : "v"(a), "v"(b)); return r; }
__device__ __forceinline__ float fadd_s(float a, float b) { float r; asm("v_add_f32_e32 %0, %1, %2" : "=v"(r) : "v"(a), "v"(b)); return r; }
__device__ __forceinline__ float fsub_s(float a, float b) { float r; asm("v_sub_f32_e32 %0, %1, %2" : "=v"(r) : "v"(a), "v"(b)); return r; }
__device__ __forceinline__ unsigned cvtpk_s(float lo, float hi) { return pk2(lo, hi); }
#define WAIT_BAR(N) asm volatile("s_waitcnt vmcnt(" #N ") lgkmcnt(0)\n\ts_barrier" ::: "memory")

__device__ __forceinline__ void qkt(f32x16& p0, f32x16& p1, const char* Kslot, const bf16x8* qr, const f32x16& negm, int r32, int hi) {
    const char* kb = Kslot + hi * 1024 + r32 * 16;
#pragma unroll
    for (int d0 = 0; d0 < 4; ++d0) {
        const bf16x8 b0 = *reinterpret_cast<const bf16x8*>(kb + d0 * 2048);
        const bf16x8 b1 = *reinterpret_cast<const bf16x8*>(kb + d0 * 2048 + 512);
        if (d0 == 0) { p0 = __builtin_amdgcn_mfma_f32_32x32x16_bf16(b0, qr[0], negm, 0, 0, 0); p1 = __builtin_amdgcn_mfma_f32_32x32x16_bf16(b1, qr[0], negm, 0, 0, 0); }
        else { p0 = __builtin_amdgcn_mfma_f32_32x32x16_bf16(b0, qr[d0], p0, 0, 0, 0); p1 = __builtin_amdgcn_mfma_f32_32x32x16_bf16(b1, qr[d0], p1, 0, 0, 0); } }
}
typedef __attribute__((address_space(3))) const char* lds_cptr;
typedef short v4i16_t __attribute__((ext_vector_type(4)));
__device__ __forceinline__ void kload8(bf16x8* kf, lds_cptr kp) {
    kf[0] = *(const LAS bf16x8*)(kp);        kf[1] = *(const LAS bf16x8*)(kp + 512);
    kf[2] = *(const LAS bf16x8*)(kp + 2048); kf[3] = *(const LAS bf16x8*)(kp + 2560);
    kf[4] = *(const LAS bf16x8*)(kp + 4096); kf[5] = *(const LAS bf16x8*)(kp + 4608);
    kf[6] = *(const LAS bf16x8*)(kp + 6144); kf[7] = *(const LAS bf16x8*)(kp + 6656);
}
__device__ __forceinline__ void kload2(bf16x8* kf, lds_cptr kp, int j) { kf[2 * j] = *(const LAS bf16x8*)(kp + j * 2048); kf[2 * j + 1] = *(const LAS bf16x8*)(kp + j * 2048 + 512); }
__device__ __forceinline__ s16x4 vtr(lds_cptr p) { return __builtin_bit_cast(s16x4, __builtin_amdgcn_ds_read_tr16_b64_v4i16((LAS v4i16_t*)p)); }
__device__ __forceinline__ float rowmax(const f32x16& p0, const f32x16& p1) {
    float a = max3f(p0[0], p0[1], p1[0]), b = max3f(p0[2], p0[3], p1[1]); a = max3f(a, p1[2], p1[3]);
#pragma unroll
    for (int r = 4; r < 16; r += 4) { a = max3f(a, p0[r], p0[r + 1]); b = max3f(b, p0[r + 2], p0[r + 3]); a = max3f(a, p1[r], p1[r + 1]); b = max3f(b, p1[r + 2], p1[r + 3]); }
    const float m = max2f(a, b);
    auto rr = __builtin_amdgcn_permlane32_swap(__float_as_uint(m), __float_as_uint(m), false, false);
    return max2f(__uint_as_float(rr[0]), __uint_as_float(rr[1]));
}
__device__ __forceinline__ void pv(f32x16* o, int vb, bf16x8 pa0, bf16x8 pa1, bf16x8 pa2, bf16x8 pa3) {
#pragma unroll
    for (int d0 = 0; d0 < 2; ++d0) { s16x4 lo[4], hi[4];
#pragma unroll
        for (int ks = 0; ks < 4; ++ks) {
            asm volatile("ds_read_b64_tr_b16 %0,%1 offset:%c2" : "=&v"(lo[ks]) : "v"(vb), "i"(d0 * 4096 + ks * 1024) : "memory");
            asm volatile("ds_read_b64_tr_b16 %0,%1 offset:%c2" : "=&v"(hi[ks]) : "v"(vb), "i"(d0 * 4096 + ks * 1024 + 512) : "memory"); }
        asm volatile("s_waitcnt lgkmcnt(0)" ::: "memory"); SBAR();
#define PK(k) (bf16x8){lo[k][0], lo[k][1], lo[k][2], lo[k][3], hi[k][0], hi[k][1], hi[k][2], hi[k][3]}
        o[d0] = __builtin_amdgcn_mfma_f32_32x32x16_bf16(pa0, PK(0), o[d0], 0, 0, 0);
        o[d0] = __builtin_amdgcn_mfma_f32_32x32x16_bf16(pa1, PK(1), o[d0], 0, 0, 0);
        o[d0] = __builtin_amdgcn_mfma_f32_32x32x16_bf16(pa2, PK(2), o[d0], 0, 0, 0);
        o[d0] = __builtin_amdgcn_mfma_f32_32x32x16_bf16(pa3, PK(3), o[d0], 0, 0, 0);
#undef PK
    }
}
__device__ __forceinline__ void rope_cs(float pos, int i, float& c, float& s) {
    const float inv = exp2f(-(float)i * 0.83048202372184058696f);
    float rev = pos * inv * 0.15915494309189533577f; rev = rev - floorf(rev);
    c = __builtin_amdgcn_cosf(rev); s = __builtin_amdgcn_sinf(rev);
}

template <int THRL> __device__ __forceinline__ void attn_unit(int b, int h, int qb, const bf16_t* Pbuf, bf16_t* O, const float* qgain, char* shm, int wave_s) {
    const int tid = opaque_tid(wave_s), lane = tid & 63, r32 = lane & 31, hi = lane >> 5; const int wid = __builtin_amdgcn_readfirstlane(tid >> 6);
    const long rowbase = (long)b * LT; const int q0 = qb * QB; const int kvh = h >> 2;
    const bf16_t* Qw = Pbuf + (rowbase + q0 + wid * QBLK) * PQ + C_AQ + h * DH;
    const bf16_t* Kh = Pbuf + rowbase * PQ + C_AK + kvh * DH; const bf16_t* Vh = Pbuf + rowbase * PQ + C_AV + kvh * DH;
    const unsigned lds0 = (unsigned)(uintptr_t)shm;
    float* wsf = (float*)(shm + LDS_WS) + wid * 64;
    const bf16_t* ksrc = Kh + (long)lane * PQ + wid * 8;
    const bf16_t* vsrc = Vh + (long)(16 * (wid & 3) + (lane >> 2)) * PQ + (wid >> 2) * 32 + (lane & 3) * 8;
    const unsigned kdst = lds0 + LDS_K + wid * 1024, vdst = lds0 + LDS_V + wid * 1024;
#define DMA_K(t, slot) glds16(ksrc + (long)(t) * KVBLK * PQ, (unsigned)__builtin_amdgcn_readfirstlane(kdst + (slot)))
#define DMA_V(t, slot) glds16(vsrc + (long)(t) * KVBLK * PQ, (unsigned)__builtin_amdgcn_readfirstlane(vdst + (slot)))
    const int vb0 = (int)(lds0 + LDS_V) + ((lane >> 4) & 1) * 32 + (lane & 3) * 8 + (4 * hi + ((lane & 15) >> 2)) * 64;
    const char* Kbase = shm + LDS_K; bf16x8 kf[8];
    const lds_cptr shm3 = (lds_cptr)shm; const lds_cptr kp0 = shm3 + LDS_K + hi * 1024 + r32 * 16; const lds_cptr vp0 = shm3 + LDS_V + ((lane >> 4) & 1) * 32 + (lane & 3) * 8 + (4 * hi + ((lane & 15) >> 2)) * 64;
    const int NT = (qb == 0) ? (CTXL / KVBLK) : (LT / KVBLK);
    DMA_K(0, 0); DMA_V(0, 0); DMA_K(1, SLOTB);
    bf16x8 qr[4];
    {
        u32x4 raw[4];
#pragma unroll
        for (int d0 = 0; d0 < 4; ++d0) raw[d0] = *reinterpret_cast<const u32x4*>(&Qw[(long)r32 * PQ + d0 * 16 + hi * 8]);
        float qf[4][8]; float ss = 0.f;
#pragma unroll
        for (int d0 = 0; d0 < 4; ++d0) {
            qf[d0][0] = bflo(raw[d0].x); qf[d0][1] = bfhi(raw[d0].x); qf[d0][2] = bflo(raw[d0].y); qf[d0][3] = bfhi(raw[d0].y);
            qf[d0][4] = bflo(raw[d0].z); qf[d0][5] = bfhi(raw[d0].z); qf[d0][6] = bflo(raw[d0].w); qf[d0][7] = bfhi(raw[d0].w);
#pragma unroll
            for (int j = 0; j < 8; ++j) ss += qf[d0][j] * qf[d0][j]; }
        ss += xorl<32>(ss);
        const float rstd = rsqrtf(ss * (1.f / 64.f) + NORM_EPS);
#pragma unroll
        for (int d0 = 0; d0 < 4; ++d0)
#pragma unroll
            for (int j = 0; j < 8; ++j) qf[d0][j] *= rstd * qgain[d0 * 16 + hi * 8 + j];
        if (qb > 0) {
            const int t = q0 - CTXL + wid * QBLK + r32; const float prow = (float)(t >> 6), pcol = (float)(t & 63);
#pragma unroll
            for (int j = 0; j < 8; ++j) { float c, s;
                rope_cs(prow, hi * 8 + j, c, s); { const float x1 = qf[0][j], x2 = qf[1][j]; qf[0][j] = x1 * c - x2 * s; qf[1][j] = x2 * c + x1 * s; }
                rope_cs(pcol, hi * 8 + j, c, s); { const float x1 = qf[2][j], x2 = qf[3][j]; qf[2][j] = x1 * c - x2 * s; qf[3][j] = x2 * c + x1 * s; } }
        }
#pragma unroll
        for (int d0 = 0; d0 < 4; ++d0) { u32x4 w; w.x = pk2(qf[d0][0] * C2, qf[d0][1] * C2); w.y = pk2(qf[d0][2] * C2, qf[d0][3] * C2); w.z = pk2(qf[d0][4] * C2, qf[d0][5] * C2); w.w = pk2(qf[d0][6] * C2, qf[d0][7] * C2);
            qr[d0] = __builtin_bit_cast(bf16x8, w); }
    }
    float mhat = 0.f, l_reg = 0.f; f32x16 o[2]; o[0] = f32x16{}; o[1] = f32x16{}; f32x16 negm = f32x16{}; asm volatile("" : "+v"(negm));
    bool resc = false;
#define START(P0, P1) do { const float rm = rowmax(P0, P1); resc = false; \
    { const float dl = rm; mhat = fadd_s(mhat, dl); \
      _Pragma("unroll") for (int r = 0; r < 16; ++r) { P0[r] = fsub_s(P0[r], dl); P1[r] = fsub_s(P1[r], dl); } \
      _Pragma("unroll") for (int r = 0; r < 16; ++r) negm[r] = -mhat; asm volatile("" : "+v"(negm)); } \
    _Pragma("unroll") for (int r = 0; r < 16; ++r) P0[r] = __builtin_amdgcn_exp2f(P0[r]); } while (0)
#define RESC() do { if (resc) { asm volatile("s_waitcnt lgkmcnt(0)" ::: "memory"); \
      _Pragma("unroll") for (int d_ = 0; d_ < 2; ++d_) _Pragma("unroll") for (int r = 0; r < 16; ++r) o[d_][r] *= wsf[crow(r, hi)]; } } while (0)
    f32x16 pA0, pA1, pB0, pB1;
    int sl_prev = 0, sl_cur = 0, sl_next = SLOTB;
#define ROT() do { sl_prev = sl_cur; sl_cur = sl_next; sl_next = (sl_next == (NSLOT - 1) * SLOTB) ? 0 : sl_next + SLOTB; } while (0)
    DMA_K(2, 2 * SLOTB);
    WAIT_BAR(3);
    qkt(pA0, pA1, Kbase, qr, negm, r32, hi); asm volatile("s_nop 15\n\ts_nop 7" : "+v"(pA0), "+v"(pA1));
    START(pA0, pA1);
    _Pragma("unroll") for (int r = 0; r < 16; ++r) pA1[r] = __builtin_amdgcn_exp2f(pA1[r]);
    WAIT_BAR(0);
    DMA_K(3, 0); DMA_V(1, SLOTB);
    ROT();
    kload8(kf, kp0 + sl_cur);
    WAIT_BAR(2);
    s16x4 vlo[8], vhi[8]; u32x4 pw0, pw1, pw2, pw3;
#define PKW(P, B) cvtpk_s(P[B], P[B + 1])
#define PAF(k) __builtin_bit_cast(bf16x8, pw##k)
#define VFR(i) (bf16x8){vlo[i][0], vlo[i][1], vlo[i][2], vlo[i][3], vhi[i][0], vhi[i][1], vhi[i][2], vhi[i][3]}
#define PIN(x) asm volatile("" : "+v"(x))
#define MX3(a, b, c) __builtin_fmaxf(__builtin_fmaxf((a), (b)), (c))
#define GAPA(MF, A0, A1, A2, A3, W0, W1, PW) do { MF; sacc += A0; sacc += A1; sacc += A2; sacc += A3; PIN(sacc); W0; W1; PIN(PW); SBAR(); } while (0)
#define EX(v) __builtin_amdgcn_exp2f(v)
#define GAPB(MF, X, B) do { MF; X[B] = EX(X[B]); X[B + 1] = EX(X[B + 1]); X[B + 2] = EX(X[B + 2]); X[B + 3] = EX(X[B + 3]); PIN(X); SBAR(); } while (0)
#define VRD(i) do { vlo[i] = vtr(vp_ + (((i) >> 2) * 4096 + ((i) & 3) * 1024)); vhi[i] = vtr(vp_ + (((i) >> 2) * 4096 + ((i) & 3) * 1024 + 512)); } while (0)
#define KRD(G_, j) do { if (G_) { kload2(kf, kp0 + sl_next, j); SBAR(); } } while (0)
#define STEP(C0, C1, P0, P1, t, GK, GV, GL) do { SBAR(); \
    const lds_cptr vp_ = vp0 + sl_prev; \
    VRD(0); SBAR(); float sacc = (P0[0] + P0[1]); \
    GAPA(C0 = __builtin_amdgcn_mfma_f32_32x32x16_bf16(kf[0], qr[0], negm, 0, 0, 0), P0[2], P0[3], P0[4], P0[5],     pw0[0] = PKW(P0, 0), pw0[1] = PKW(P0, 2), pw0); \
    VRD(4); SBAR(); GAPA(C1 = __builtin_amdgcn_mfma_f32_32x32x16_bf16(kf[1], qr[0], negm, 0, 0, 0), P0[6], P0[7], P0[8], P0[9],     pw0[2] = PKW(P0, 4), pw0[3] = PKW(P0, 6), pw0); \
    VRD(1); SBAR(); GAPA(C0 = __builtin_amdgcn_mfma_f32_32x32x16_bf16(kf[2], qr[1], C0, 0, 0, 0),   P0[10], P0[11], P0[12], P0[13], pw1[0] = PKW(P0, 8), pw1[1] = PKW(P0, 10), pw1); \
    VRD(5); SBAR(); GAPA(C1 = __builtin_amdgcn_mfma_f32_32x32x16_bf16(kf[3], qr[1], C1, 0, 0, 0),   P0[14], P0[15], P1[0], P1[1],   pw1[2] = PKW(P0, 12), pw1[3] = PKW(P0, 14), pw1); \
    VRD(2); SBAR(); GAPA(C0 = __builtin_amdgcn_mfma_f32_32x32x16_bf16(kf[4], qr[2], C0, 0, 0, 0),   P1[2], P1[3], P1[4], P1[5],     pw2[0] = PKW(P1, 0), pw2[1] = PKW(P1, 2), pw2); \
    VRD(6); SBAR(); GAPA(C1 = __builtin_amdgcn_mfma_f32_32x32x16_bf16(kf[5], qr[2], C1, 0, 0, 0),   P1[6], P1[7], P1[8], P1[9],     pw2[2] = PKW(P1, 4), pw2[3] = PKW(P1, 6), pw2); \
    VRD(3); SBAR(); GAPA(C0 = __builtin_amdgcn_mfma_f32_32x32x16_bf16(kf[6], qr[3], C0, 0, 0, 0),   P1[10], P1[11], P1[12], P1[13], pw3[0] = PKW(P1, 8), pw3[1] = PKW(P1, 10), pw3); \
    VRD(7); SBAR(); GAPA(C1 = __builtin_amdgcn_mfma_f32_32x32x16_bf16(kf[7], qr[3], C1, 0, 0, 0),   P1[14], P1[15], 0.f, 0.f,       pw3[2] = PKW(P1, 12), pw3[3] = PKW(P1, 14), pw3); \
    l_reg += sacc; \
    if (GK) { DMA_K((t) + 3, sl_cur); } if (GV) { DMA_V((t) + 1, sl_next); } \
    { float a = MX3(C0[0], C0[1], C1[0]), b_ = MX3(C0[2], C0[3], C1[1]); a = MX3(a, C1[2], C1[3]); \
      _Pragma("unroll") for (int r = 4; r < 16; r += 4) { a = MX3(a, C0[r], C0[r + 1]); b_ = MX3(b_, C0[r + 2], C0[r + 3]); a = MX3(a, C1[r], C1[r + 1]); b_ = MX3(b_, C1[r + 2], C1[r + 3]); } \
      float rm = __builtin_fmaxf(a, b_); { auto rr = __builtin_amdgcn_permlane32_swap(__float_as_uint(rm), __float_as_uint(rm), false, false); rm = __builtin_fmaxf(__uint_as_float(rr[0]), __uint_as_float(rr[1])); } \
      resc = false; \
      if (__builtin_expect(__any(rm > (float)THRL), 0)) { const float dl = __builtin_fmaxf(rm, 0.f); mhat += dl; \
        _Pragma("unroll") for (int r = 0; r < 16; ++r) { C0[r] -= dl; C1[r] -= dl; } \
        _Pragma("unroll") for (int r = 0; r < 16; ++r) negm[r] = -mhat; asm volatile("" : "+v"(negm)); \
        const float f = __builtin_amdgcn_exp2f(-dl); l_reg *= f; if (hi == 0) wsf[r32] = f; resc = true; } } \
    SBAR(); \
    GAPB(o[0] = __builtin_amdgcn_mfma_f32_32x32x16_bf16(PAF(0), VFR(0), o[0], 0, 0, 0), C0, 0); \
    GAPB(o[1] = __builtin_amdgcn_mfma_f32_32x32x16_bf16(PAF(0), VFR(4), o[1], 0, 0, 0), C0, 4); \
    KRD(GL, 0); GAPB(o[0] = __builtin_amdgcn_mfma_f32_32x32x16_bf16(PAF(1), VFR(1), o[0], 0, 0, 0), C0, 8); \
    KRD(GL, 1); GAPB(o[1] = __builtin_amdgcn_mfma_f32_32x32x16_bf16(PAF(1), VFR(5), o[1], 0, 0, 0), C0, 12); \
    KRD(GL, 2); GAPB(o[0] = __builtin_amdgcn_mfma_f32_32x32x16_bf16(PAF(2), VFR(2), o[0], 0, 0, 0), C1, 0); \
    KRD(GL, 3); GAPB(o[1] = __builtin_amdgcn_mfma_f32_32x32x16_bf16(PAF(2), VFR(6), o[1], 0, 0, 0), C1, 4); \
    GAPB(o[0] = __builtin_amdgcn_mfma_f32_32x32x16_bf16(PAF(3), VFR(3), o[0], 0, 0, 0), C1, 8); \
    GAPB(o[1] = __builtin_amdgcn_mfma_f32_32x32x16_bf16(PAF(3), VFR(7), o[1], 0, 0, 0), C1, 12); \
    } while (0)
    int t = 1;
    for (; t + 5 < NT; t += 2) {
        STEP(pB0, pB1, pA0, pA1, t, true, true, true);     WAIT_BAR(2); RESC(); ROT();
        STEP(pA0, pA1, pB0, pB1, t + 1, true, true, true); WAIT_BAR(2); RESC(); ROT();
    }
#define ENDW(tt) do { if ((tt) + 3 < NT) { WAIT_BAR(2); } else if ((tt) + 2 < NT) { WAIT_BAR(1); } else { WAIT_BAR(0); } } while (0)
    for (; t + 1 < NT; t += 2) {
        STEP(pB0, pB1, pA0, pA1, t, (t + 3 < NT), (t + 1 < NT), (t + 1 < NT));         ENDW(t);     RESC(); ROT();
        STEP(pA0, pA1, pB0, pB1, t + 1, (t + 4 < NT), (t + 2 < NT), (t + 2 < NT));     ENDW(t + 1); RESC(); ROT();
    }
    STEP(pB0, pB1, pA0, pA1, NT - 1, false, false, false); RESC();
    { float sacc = pB0[0] + pB0[1]; _Pragma("unroll") for (int r = 2; r < 16; ++r) sacc += pB0[r]; _Pragma("unroll") for (int r = 0; r < 16; ++r) sacc += pB1[r]; l_reg += sacc;
      pw0 = (u32x4){PKW(pB0, 0), PKW(pB0, 2), PKW(pB0, 4), PKW(pB0, 6)}; pw1 = (u32x4){PKW(pB0, 8), PKW(pB0, 10), PKW(pB0, 12), PKW(pB0, 14)}; pw2 = (u32x4){PKW(pB1, 0), PKW(pB1, 2), PKW(pB1, 4), PKW(pB1, 6)}; pw3 = (u32x4){PKW(pB1, 8), PKW(pB1, 10), PKW(pB1, 12), PKW(pB1, 14)};
      SBAR(); pv(o, vb0 + sl_cur, PAF(0), PAF(1), PAF(2), PAF(3)); }
#undef PKW
#undef PAF
#undef VFR
#undef PIN
#undef MX3
#undef GAPA
#undef GAPB
#undef EX
#undef VRD
#undef KRD
#undef STEP
#undef ENDW
    { auto rr = __builtin_amdgcn_permlane32_swap(__float_as_uint(l_reg), __float_as_uint(l_reg), false, false); l_reg = __uint_as_float(rr[0]) + __uint_as_float(rr[1]); }
    if (hi == 0) wsf[32 + r32] = l_reg; asm volatile("s_waitcnt lgkmcnt(0)" ::: "memory");
    float rli[16];
#pragma unroll
    for (int r = 0; r < 16; ++r) rli[r] = __builtin_amdgcn_rcpf(wsf[32 + crow(r, hi)]);
    bf16_t* Ow = O + (rowbase + q0 + wid * QBLK) * PO + 512 + h * DH;
    { bf16_t* stg = (bf16_t*)(shm + LDS_OST) + wid * 2048;
#pragma unroll
      for (int r = 0; r < 16; ++r) { const int orow = crow(r, hi);
#pragma unroll
          for (int d0 = 0; d0 < 2; ++d0) stg[orow * 64 + d0 * 32 + r32] = f2bf(o[d0][r] * rli[r]); }
      asm volatile("s_waitcnt lgkmcnt(0)" ::: "memory");
#pragma unroll
      for (int i = 0; i < 4; ++i) { const int row = i * 8 + (lane >> 3), ch = lane & 7; const u32x4 v = *(const u32x4*)(stg + row * 64 + ch * 8); *(u32x4*)(Ow + (long)row * PO + ch * 8) = v; } }
    asm volatile("s_waitcnt lgkmcnt(0)\n\ts_barrier" ::: "memory");
#undef DMA_K
#undef DMA_V
#undef START
#undef RESC
#undef ROT
}
#undef SBAR
#undef WAIT_BAR
}

__device__ __forceinline__ void knorm_phase(Frame& F) {
    bf16_t* Pb = (bf16_t*)(F.ws + WS_P); const float* kg = F.p->in[I_KNORM];
    const int kvh = F.lane >> 5, half = (F.lane >> 4) & 1, i = F.lane & 15, d1 = half * 32 + i, d2 = d1 + 16;
    const float g1 = kg[d1], g2 = kg[d2];
    const int r0 = wave_row0(F.bid, F.wave);
#pragma unroll 1
    for (int ri3 = 0; ri3 < ROWS_PER_WAVE; ri3 += 6) {
        float x1[6], x2[6];
#pragma unroll
        for (int q = 0; q < 6; ++q) { const bf16_t* kp = Pb + (size_t)(r0 + ri3 + q) * NP0 + C_AK + kvh * 64; x1[q] = bf2f(kp[d1]); x2[q] = bf2f(kp[d2]); }
#pragma unroll
        for (int q = 0; q < 6; ++q) {
            const int r = r0 + ri3 + q, p = r % LT;
            bf16_t* kp = Pb + (size_t)r * NP0 + C_AK + kvh * 64;
            float a1 = x1[q], a2 = x2[q];
            float ss = a1 * a1 + a2 * a2;
            ss += xorl<1>(ss); ss += xorl<2>(ss); ss += xorl<4>(ss); ss += xorl<8>(ss); ss += xorl<16>(ss);
            const float rstd = rsqrtf(ss * (1.f / 64.f) + NORM_EPS);
            a1 *= rstd * g1; a2 *= rstd * g2;
            if (p >= CTXL) { const int t = p - CTXL; const float pos = half ? (float)(t & 63) : (float)(t >> 6); float c, s; attn_body::rope_cs(pos, i, c, s);
                const float y1 = a1 * c - a2 * s, y2 = a2 * c + a1 * s; a1 = y1; a2 = y2; }
            kp[d1] = f2bf(a1); kp[d2] = f2bf(a2);
        }
    }
}
namespace mix {
typedef LAS unsigned char* lptr;
__device__ __forceinline__ bf16x8 frag(const LAS unsigned char* base, int pitch, int row0, int k0, int lane) {
    return *(const LAS bf16x8*)(base + (row0 + (lane & 15)) * pitch + (k0 + 8 * (lane >> 4)) * 2);
}
#define MFMA16(a, b, c) __builtin_amdgcn_mfma_f32_16x16x32_bf16(a, b, c, 0, 0, 0)
__device__ __forceinline__ float log_sigmoid(float x) { return fminf(x, 0.f) - log1pf(__expf(-fabsf(x))); }
__device__ __forceinline__ float softplus(float x) { return fmaxf(x, 0.f) + log1pf(__expf(-fabsf(x))); }
template <int CTRL> __device__ __forceinline__ float dpp_old(float oldv, float v) { return __int_as_float(__builtin_amdgcn_update_dpp(__float_as_int(oldv), __float_as_int(v), CTRL, 0xf, 0xf, false)); }
__device__ __forceinline__ float scan_add(float v, int lane) {
    v += dpp_old<0x111>(0.f, v); v += dpp_old<0x112>(0.f, v); v += dpp_old<0x114>(0.f, v); v += dpp_old<0x118>(0.f, v);
    const float t0 = rdlane(v, 15), t1 = rdlane(v, 31), t2 = rdlane(v, 47);
    float off = (lane >= 16) ? t0 : 0.f; off += (lane >= 32) ? t1 : 0.f; off += (lane >= 48) ? t2 : 0.f;
    return v + off;
}
__device__ __forceinline__ float scan_max(float v, int lane) {
    const float ninf = -INFINITY;
    v = fmaxf(v, dpp_old<0x111>(ninf, v)); v = fmaxf(v, dpp_old<0x112>(ninf, v)); v = fmaxf(v, dpp_old<0x114>(ninf, v)); v = fmaxf(v, dpp_old<0x118>(ninf, v));
    const float t0 = rdlane(v, 15), t1 = rdlane(v, 31), t2 = rdlane(v, 47);
    float off = (lane >= 16) ? t0 : ninf; off = fmaxf(off, (lane >= 32) ? t1 : ninf); off = fmaxf(off, (lane >= 48) ? t2 : ninf);
    return fmaxf(v, off);
}
__device__ __forceinline__ void unpack8(const u32x4 r, float* f) { f[0] = bflo(r.x); f[1] = bfhi(r.x); f[2] = bflo(r.y); f[3] = bfhi(r.y); f[4] = bflo(r.z); f[5] = bfhi(r.z); f[6] = bflo(r.w); f[7] = bfhi(r.w); }

typedef short v4i16_t __attribute__((ext_vector_type(4)));
__device__ __forceinline__ bf16x8 trfrag(const LAS unsigned char* base, int pitch, int k0, int c0, int lane) {
    const int g = lane >> 4, i = lane & 15, q = i >> 2, pp = i & 3;
    const LAS unsigned char* a0 = base + (k0 + 8 * g + q) * pitch + (c0 + 4 * pp) * 2;
    const v4i16_t lo = __builtin_amdgcn_ds_read_tr16_b64_v4i16((LAS v4i16_t*)a0);
    const v4i16_t hi = __builtin_amdgcn_ds_read_tr16_b64_v4i16((LAS v4i16_t*)(a0 + 4 * pitch));
    return (bf16x8){lo[0], lo[1], lo[2], lo[3], hi[0], hi[1], hi[2], hi[3]};
}
__device__ __forceinline__ void mlstm_unit(Frame& F, int b, int hd, int dir) {
    const int tid = F.tid, lane = F.lane, w = F.wave, l15 = lane & 15, l4 = lane >> 4;
    const bf16_t* Pb = (const bf16_t*)(F.ws + WS_P); const float* GT = (const float*)(F.ws + WS_GATES);
    bf16_t* Y = (bf16_t*)(F.ws + (dir ? WS_Y1 : WS_Y0));
    lptr L = F.lds;
    constexpr int PQK = 272, PT = 144;
    lptr Qs = L, Ks = L + 17408, Kw = L + 34816, Vs = L + 52224, Sw = L + 69632, Cb = L + 78848;
    LAS float* fl = (LAS float*)(L + 113664);
    LAS float *rj = fl, *cs = fl + 64, *gg = fl + 128, *eneg = fl + 192, *wend = fl + 256, *denp = fl + 320  , *nq = fl + 448, *n0 = fl + 512  , *scl = fl + 640, *npart = fl + 704  ;
    const float gbi = F.p->in[I_MLGB][dir * 8 + hd], gbf = F.p->in[I_MLGB][dir * 8 + 4 + hd];
    for (int i = tid; i < 34816 / 4; i += NTHREADS) ((LAS unsigned*)Cb)[i] = 0u;
    if (tid < 128) n0[tid] = 0.f;
    f32x4 accC[8];
#pragma unroll
    for (int i = 0; i < 8; ++i) accC[i] = (f32x4){0.f, 0.f, 0.f, 0.f};
    float m0 = 0.f;
    const size_t rowb = (size_t)b * LT;
    const float kscale = 0.08838834764831845f;
    const int sg = dir ? -1 : 1;
    const int pr = tid >> 4, pc = tid & 15;
    u32x4 nq_[2], nk_[2], nv_[2]; float ngi = 0.f, ngf = 0.f;
    {
        const int p0 = dir ? 255 : 0;
#pragma unroll
        for (int i = 0; i < 2; ++i) { const bf16_t* rp = Pb + (rowb + (size_t)(p0 + sg * (pr + 32 * i))) * NP0 + hd * 128 + 8 * pc;
            nq_[i] = *(const u32x4*)(rp + C_MQ); nk_[i] = *(const u32x4*)(rp + C_MK); nv_[i] = *(const u32x4*)(rp + C_MV); }
        if (w == 0) { const size_t nrow = rowb + (size_t)(p0 + sg * lane); ngi = GT[nrow * 16 + dir * 8 + hd]; ngf = GT[nrow * 16 + dir * 8 + 4 + hd]; }
    }
    for (int c = 0; c < 36; ++c) {
        const int p0 = dir ? (c < 4 ? 255 - 64 * c : 2559 - 64 * c) : 64 * c;
        if (w == 0) {
            const float li = ngi + gbi;
            const float lf = log_sigmoid(ngf + gbf);
            const float bb = scan_add(lf, lane);
            const float csv = li - bb;
            const float pm = scan_max(csv, lane);
            const float inter = bb + m0;
            const float mj = fmaxf(inter, bb + pm);
            const float bend = rdlane(bb, 63), pmend = rdlane(pm, 63);
            const float mnew = fmaxf(bend + m0, pmend + bend);
            rj[lane] = bb - mj; cs[lane] = csv; gg[lane] = __expf(inter - mj); eneg[lane] = __expf(-mj);
            wend[lane] = __expf(csv + bend - mnew);
            if (lane == 0) scl[0] = __expf(bend + m0 - mnew);
            m0 = mnew;
        }
        __syncthreads();
#pragma unroll
        for (int i = 0; i < 2; ++i) {
            const int row = pr + 32 * i; const float we = wend[row];
            *(LAS u32x4*)(Qs + row * PQK + pc * 16) = nq_[i]; *(LAS u32x4*)(Vs + row * PQK + pc * 16) = nv_[i];
            float kf[8]; unpack8(nk_[i], kf);
#pragma unroll
            for (int e = 0; e < 8; ++e) kf[e] *= kscale;
            u32x4 ka; ka.x = pk2(kf[0], kf[1]); ka.y = pk2(kf[2], kf[3]); ka.z = pk2(kf[4], kf[5]); ka.w = pk2(kf[6], kf[7]);
            *(LAS u32x4*)(Ks + row * PQK + pc * 16) = ka;
            u32x4 kb; kb.x = pk2(kf[0] * we, kf[1] * we); kb.y = pk2(kf[2] * we, kf[3] * we); kb.z = pk2(kf[4] * we, kf[5] * we); kb.w = pk2(kf[6] * we, kf[7] * we);
            *(LAS u32x4*)(Kw + row * PQK + pc * 16) = kb;
        }
        {
            const int cn = (c < 35) ? c + 1 : c; const int pn0 = dir ? (cn < 4 ? 255 - 64 * cn : 2559 - 64 * cn) : 64 * cn;
#pragma unroll
            for (int i = 0; i < 2; ++i) { const bf16_t* rp = Pb + (rowb + (size_t)(pn0 + sg * (pr + 32 * i))) * NP0 + hd * 128 + 8 * pc;
                nq_[i] = *(const u32x4*)(rp + C_MQ); nk_[i] = *(const u32x4*)(rp + C_MK); nv_[i] = *(const u32x4*)(rp + C_MV); }
            if (w == 0) { const size_t nrow = rowb + (size_t)(pn0 + sg * lane); ngi = GT[nrow * 16 + dir * 8 + hd]; ngf = GT[nrow * 16 + dir * 8 + 4 + hd]; }
        }
        __syncthreads();
        {
            const int jt = w >> 1, sh = w & 1; float rsum = 0.f;
            const int j = 16 * jt + l15; const float rjj = rj[j];
#pragma unroll
            for (int si = 0; si < 2; ++si) {
                const int st = 2 * sh + si; const int s0 = 16 * st + 4 * l4;
                u32x2 o; o.x = 0u; o.y = 0u;
                if (st <= jt) {
                    f32x4 a = (f32x4){0.f, 0.f, 0.f, 0.f};
#pragma unroll
                    for (int ks = 0; ks < 4; ++ks) a = MFMA16(frag(Ks, PQK, 16 * st, 32 * ks, lane), frag(Qs, PQK, 16 * jt, 32 * ks, lane), a);
                    float vv[4]; const f32x4 c4 = *(const LAS f32x4*)(cs + s0);
#pragma unroll
                    for (int r = 0; r < 4; ++r) { const int s = s0 + r; vv[r] = (s <= j) ? a[r] * __expf(rjj + c4[r]) : 0.f; rsum += vv[r]; }
                    o.x = pk2(vv[0], vv[1]); o.y = pk2(vv[2], vv[3]);
                }
                *(LAS u32x2*)(Sw + j * PT + s0 * 2) = o;
            }
            rsum += xorl<16>(rsum); rsum += xorl<32>(rsum);
            if (l4 == 0) denp[sh * 64 + j] = rsum;
            const int jq = tid >> 3, kp = tid & 7; float a = 0.f;
            const u32x4 qa = *(const LAS u32x4*)(Qs + jq * PQK + kp * 32), qb = *(const LAS u32x4*)(Qs + jq * PQK + kp * 32 + 16);
            float qf[16]; unpack8(qa, qf); unpack8(qb, qf + 8);
#pragma unroll
            for (int e = 0; e < 16; ++e) a += qf[e] * n0[16 * kp + e];
            a += xorl<1>(a); a += xorl<2>(a); a += xorl<4>(a);
            if (kp == 0) nq[jq] = a;
        }
        __syncthreads();
        {
            const int jt = w & 3, vh = w >> 2, j = 16 * jt + l15;
            bf16x8 bS[2], bQ[4];
#pragma unroll
            for (int ks = 0; ks < 2; ++ks) bS[ks] = frag(Sw, PT, 16 * jt, 32 * ks, lane);
#pragma unroll
            for (int ks = 0; ks < 4; ++ks) bQ[ks] = frag(Qs, PQK, 16 * jt, 32 * ks, lane);
            const float g = gg[j], den = denp[j] + denp[64 + j] + g * nq[j];
            const float sc = 1.f / fmaxf(fabsf(den), eneg[j]);
            bf16_t* yrow = Y + (rowb + (size_t)(p0 + sg * j)) * 512 + hd * 128;
            bf16x8 fv[2][2], fc[2][4];
#pragma unroll
            for (int ks = 0; ks < 2; ++ks) fv[0][ks] = trfrag(Vs, PQK, 32 * ks, 16 * (4 * vh), lane);
#pragma unroll
            for (int ks = 0; ks < 4; ++ks) fc[0][ks] = frag(Cb, PQK, 16 * (4 * vh), 32 * ks, lane);
#pragma unroll
            for (int vi = 0; vi < 4; ++vi) {
                const int vt = 4 * vh + vi;
                if (vi < 3) {
#pragma unroll
                    for (int ks = 0; ks < 2; ++ks) fv[(vi + 1) & 1][ks] = trfrag(Vs, PQK, 32 * ks, 16 * (vt + 1), lane);
#pragma unroll
                    for (int ks = 0; ks < 4; ++ks) fc[(vi + 1) & 1][ks] = frag(Cb, PQK, 16 * (vt + 1), 32 * ks, lane); }
                __builtin_amdgcn_sched_barrier(0);
                f32x4 a1 = (f32x4){0.f, 0.f, 0.f, 0.f}, a2 = (f32x4){0.f, 0.f, 0.f, 0.f};
#pragma unroll
                for (int ks = 0; ks < 2; ++ks) a1 = MFMA16(fv[vi & 1][ks], bS[ks], a1);
#pragma unroll
                for (int ks = 0; ks < 4; ++ks) a2 = MFMA16(fc[vi & 1][ks], bQ[ks], a2);
                __builtin_amdgcn_sched_barrier(0);
                u32x2 o; o.x = pk2((a1[0] + g * a2[0]) * sc, (a1[1] + g * a2[1]) * sc); o.y = pk2((a1[2] + g * a2[2]) * sc, (a1[3] + g * a2[3]) * sc);
                *(u32x2*)(yrow + 16 * vt + 4 * l4) = o;
            }
        }
        const float decay = scl[0];
        {
            bf16x8 bV[2];
#pragma unroll
            for (int ks = 0; ks < 2; ++ks) bV[ks] = trfrag(Vs, PQK, 32 * ks, 16 * w, lane);
            bf16x8 fk[2][2];
#pragma unroll
            for (int ks = 0; ks < 2; ++ks) fk[0][ks] = trfrag(Kw, PQK, 32 * ks, 0, lane);
#pragma unroll
            for (int kt = 0; kt < 8; ++kt) {
                if (kt < 7) {
#pragma unroll
                    for (int ks = 0; ks < 2; ++ks) fk[(kt + 1) & 1][ks] = trfrag(Kw, PQK, 32 * ks, 16 * (kt + 1), lane); }
                __builtin_amdgcn_sched_barrier(0);
                f32x4 a = accC[kt] * decay;
#pragma unroll
                for (int ks = 0; ks < 2; ++ks) a = MFMA16(fk[kt & 1][ks], bV[ks], a);
                accC[kt] = a;
                __builtin_amdgcn_sched_barrier(0);
            }
            float s0_ = 0.f, s1_ = 0.f;
#pragma unroll
            for (int r = 0; r < 8; ++r) { const unsigned u = *(const LAS unsigned*)(Kw + (8 * w + r) * PQK + lane * 4); s0_ += bflo(u); s1_ += bfhi(u); }
            npart[w * 128 + 2 * lane] = s0_; npart[w * 128 + 2 * lane + 1] = s1_;
        }
        __syncthreads();
#pragma unroll
        for (int kt = 0; kt < 8; ++kt) { u32x2 o; o.x = pk2(accC[kt][0], accC[kt][1]); o.y = pk2(accC[kt][2], accC[kt][3]);
            *(LAS u32x2*)(Cb + (16 * w + l15) * PQK + (16 * kt + 4 * l4) * 2) = o; }
        if (tid < 128) { float a = 0.f;
#pragma unroll
            for (int q = 0; q < 8; ++q) a += npart[q * 128 + tid];
            n0[tid] = decay * n0[tid] + a; }
    }
    __syncthreads();
}

__device__ __forceinline__ void ssd_unit(Frame& F, int b, int hd, int dir) {
    const int tid = F.tid, lane = F.lane, w = F.wave, l15 = lane & 15, l4 = lane >> 4;
    const bf16_t* XB = (const bf16_t*)(F.ws + WS_HB); const float* GT = (const float*)(F.ws + WS_GATES);
    bf16_t* Y = dir ? (bf16_t*)(F.ws + WS_YD1) : (bf16_t*)((unsigned char*)F.p->out + OUT_YD0);
    lptr L = F.lds;
    constexpr int PP = 272, PX = 144;
    lptr Cm = L, BmW = L + 34816, Xr = L + 69632, Xs = L + 88064, Hb = L + 106496;
    LAS float* fl = (LAS float*)(L + 123904);
    LAS float *dtl = fl, *acsl = fl + 128;
    const int grp = hd >> 2;
    const float dtb = F.p->in[I_DTB][dir * 8 + hd], aneg = -__expf(F.p->in[I_ALOG][dir * 8 + hd]), dsk = F.p->in[I_SSDD][hd];
    for (int i = tid; i < 17408 / 4; i += NTHREADS) ((LAS unsigned*)Hb)[i] = 0u;
    f32x4 hacc[4];
#pragma unroll
    for (int i = 0; i < 4; ++i) hacc[i] = (f32x4){0.f, 0.f, 0.f, 0.f};
    const size_t rowb = (size_t)b * LT;
    const int sg = dir ? -1 : 1;
    const int rc = tid >> 4, cc = tid & 15, rx = tid >> 3, cx = tid & 7;
    u32x4 nC[4], nB[4], nX[2]; float ng[2];
    {
        const int p0 = dir ? 255 : 0;
#pragma unroll
        for (int i = 0; i < 4; ++i) { const bf16_t* rp = XB + (rowb + (size_t)(p0 + sg * (rc + 32 * i))) * D; nB[i] = *(const u32x4*)(rp + 512 + grp * 128 + 8 * cc); nC[i] = *(const u32x4*)(rp + 768 + grp * 128 + 8 * cc); }
#pragma unroll
        for (int i = 0; i < 2; ++i) { const bf16_t* rp = XB + (rowb + (size_t)(p0 + sg * (rx + 64 * i))) * D; nX[i] = *(const u32x4*)(rp + hd * 64 + 8 * cx); }
#pragma unroll
        for (int h2 = 0; h2 < 2; ++h2) ng[h2] = GT[(rowb + (size_t)(p0 + sg * (lane + 64 * h2))) * 16 + dir * 8 + hd];
    }
    __syncthreads();
    for (int c = 0; c < 18; ++c) {
        const int p0 = dir ? (c < 2 ? 255 - 128 * c : 2559 - 128 * c) : 128 * c;
        float dt2[2], acs2[2], de2[2];
        {
            float da[2];
#pragma unroll
            for (int h2 = 0; h2 < 2; ++h2) { dt2[h2] = softplus(ng[h2] + dtb); da[h2] = dt2[h2] * aneg; }
            acs2[0] = scan_add(da[0], lane); const float tot0 = rdlane(acs2[0], 63);
            acs2[1] = scan_add(da[1], lane) + tot0; const float aend = rdlane(acs2[1], 63);
            de2[0] = __expf(aend - acs2[0]) * dt2[0]; de2[1] = __expf(aend - acs2[1]) * dt2[1];
            if (w == 0) { dtl[lane] = dt2[0]; dtl[64 + lane] = dt2[1]; acsl[lane] = acs2[0]; acsl[64 + lane] = acs2[1]; }
        }
#pragma unroll
        for (int i = 0; i < 4; ++i) { *(LAS u32x4*)(BmW + (rc + 32 * i) * PP + cc * 16) = nB[i]; *(LAS u32x4*)(Cm + (rc + 32 * i) * PP + cc * 16) = nC[i]; }
#pragma unroll
        for (int i = 0; i < 2; ++i) {
            *(LAS u32x4*)(Xr + (rx + 64 * i) * PX + cx * 16) = nX[i];
            const float de = lane_get(i ? de2[1] : de2[0], rx);
            float xf[8]; unpack8(nX[i], xf);
            u32x4 o; o.x = pk2(xf[0] * de, xf[1] * de); o.y = pk2(xf[2] * de, xf[3] * de); o.z = pk2(xf[4] * de, xf[5] * de); o.w = pk2(xf[6] * de, xf[7] * de);
            *(LAS u32x4*)(Xs + (rx + 64 * i) * PX + cx * 16) = o;
        }
        {
            const int cn = (c < 17) ? c + 1 : c; const int pn0 = dir ? (cn < 2 ? 255 - 128 * cn : 2559 - 128 * cn) : 128 * cn;
#pragma unroll
            for (int i = 0; i < 4; ++i) { const bf16_t* rp = XB + (rowb + (size_t)(pn0 + sg * (rc + 32 * i))) * D; nB[i] = *(const u32x4*)(rp + 512 + grp * 128 + 8 * cc); nC[i] = *(const u32x4*)(rp + 768 + grp * 128 + 8 * cc); }
#pragma unroll
            for (int i = 0; i < 2; ++i) { const bf16_t* rp = XB + (rowb + (size_t)(pn0 + sg * (rx + 64 * i))) * D; nX[i] = *(const u32x4*)(rp + hd * 64 + 8 * cx); }
#pragma unroll
            for (int h2 = 0; h2 < 2; ++h2) ng[h2] = GT[(rowb + (size_t)(pn0 + sg * (lane + 64 * h2))) * 16 + dir * 8 + hd];
        }
        __syncthreads();
        f32x4 cb[8];
        {
            bf16x8 bC[4];
#pragma unroll
            for (int ks = 0; ks < 4; ++ks) bC[ks] = frag(Cm, PP, 16 * w, 32 * ks, lane);
            bf16x8 fa[2][4];
#pragma unroll
            for (int ks = 0; ks < 4; ++ks) fa[0][ks] = frag(BmW, PP, 0, 32 * ks, lane);
#pragma unroll
            for (int st = 0; st < 8; ++st) { cb[st] = (f32x4){0.f, 0.f, 0.f, 0.f};
                if (st <= w) {
                    if (st < 7 && st + 1 <= w) {
#pragma unroll
                        for (int ks = 0; ks < 4; ++ks) fa[(st + 1) & 1][ks] = frag(BmW, PP, 16 * (st + 1), 32 * ks, lane); }
                    __builtin_amdgcn_sched_barrier(0);
#pragma unroll
                    for (int ks = 0; ks < 4; ++ks) cb[st] = MFMA16(fa[st & 1][ks], bC[ks], cb[st]);
                    __builtin_amdgcn_sched_barrier(0); } }
        }
        {
            const int pt = w >> 1, nh = w & 1; const float cdec = __expf(acsl[127]);
            bf16x8 bX[4];
#pragma unroll
            for (int ks = 0; ks < 4; ++ks) bX[ks] = trfrag(Xs, PX, 32 * ks, 16 * pt, lane);
            bf16x8 fb[2][4];
#pragma unroll
            for (int ks = 0; ks < 4; ++ks) fb[0][ks] = trfrag(BmW, PP, 32 * ks, 16 * (4 * nh), lane);
#pragma unroll
            for (int ni = 0; ni < 4; ++ni) { f32x4 a = hacc[ni] * cdec;
                if (ni < 3) {
#pragma unroll
                    for (int ks = 0; ks < 4; ++ks) fb[(ni + 1) & 1][ks] = trfrag(BmW, PP, 32 * ks, 16 * (4 * nh + ni + 1), lane); }
                __builtin_amdgcn_sched_barrier(0);
#pragma unroll
                for (int ks = 0; ks < 4; ++ks) a = MFMA16(fb[ni & 1][ks], bX[ks], a);
                __builtin_amdgcn_sched_barrier(0);
                hacc[ni] = a; }
        }
        __syncthreads();
        {
            const int l = 16 * w + l15; const float al = acsl[l];
            f32x4 a4[8], d4[8];
#pragma unroll
            for (int st = 0; st < 8; ++st) { a4[st] = *(const LAS f32x4*)(acsl + 16 * st + 4 * l4); d4[st] = *(const LAS f32x4*)(dtl + 16 * st + 4 * l4); }
#pragma unroll
            for (int st = 0; st < 8; ++st) { const int s0 = 16 * st + 4 * l4; float vv[4];
#pragma unroll
                for (int r = 0; r < 4; ++r) { const int s = s0 + r; vv[r] = (s <= l) ? cb[st][r] * __expf(al - a4[st][r]) * d4[st][r] : 0.f; }
                u32x2 o; o.x = pk2(vv[0], vv[1]); o.y = pk2(vv[2], vv[3]);
                *(LAS u32x2*)(BmW + l * PP + s0 * 2) = o; }
        }
        __syncthreads();
        {
            const int l = 16 * w + l15; const float ea = __expf(acsl[l]);
            bf16x8 bW[4], bC[4];
#pragma unroll
            for (int ks = 0; ks < 4; ++ks) { bW[ks] = frag(BmW, PP, 16 * w, 32 * ks, lane); bC[ks] = frag(Cm, PP, 16 * w, 32 * ks, lane); }
            bf16_t* yrow = Y + (rowb + (size_t)(p0 + sg * l)) * 512 + hd * 64;
            bf16x8 fx[2][4], fh[2][4];
#pragma unroll
            for (int ks = 0; ks < 4; ++ks) { fx[0][ks] = trfrag(Xr, PX, 32 * ks, 0, lane); fh[0][ks] = frag(Hb, PP, 0, 32 * ks, lane); }
#pragma unroll
            for (int pt = 0; pt < 4; ++pt) {
                f32x4 a1 = (f32x4){0.f, 0.f, 0.f, 0.f}, a2 = (f32x4){0.f, 0.f, 0.f, 0.f};
                if (pt < 3) {
#pragma unroll
                    for (int ks = 0; ks < 4; ++ks) { fx[(pt + 1) & 1][ks] = trfrag(Xr, PX, 32 * ks, 16 * (pt + 1), lane); fh[(pt + 1) & 1][ks] = frag(Hb, PP, 16 * (pt + 1), 32 * ks, lane); } }
                __builtin_amdgcn_sched_barrier(0);
#pragma unroll
                for (int ks = 0; ks < 4; ++ks) { a1 = MFMA16(fx[pt & 1][ks], bW[ks], a1); a2 = MFMA16(fh[pt & 1][ks], bC[ks], a2); }
                __builtin_amdgcn_sched_barrier(0);
                float o4[4];
#pragma unroll
                for (int r = 0; r < 4; ++r) o4[r] = a1[r] + ea * a2[r];
                if (dir == 0) { const u32x2 xq = *(const LAS u32x2*)(Xr + l * PX + (16 * pt + 4 * l4) * 2);
                    o4[0] += dsk * bflo(xq.x); o4[1] += dsk * bfhi(xq.x); o4[2] += dsk * bflo(xq.y); o4[3] += dsk * bfhi(xq.y); }
                u32x2 o; o.x = pk2(o4[0], o4[1]); o.y = pk2(o4[2], o4[3]);
                *(u32x2*)(yrow + 16 * pt + 4 * l4) = o;
            }
        }
        __syncthreads();
        {
            const int pt = w >> 1, nh = w & 1;
#pragma unroll
            for (int ni = 0; ni < 4; ++ni) { u32x2 o; o.x = pk2(hacc[ni][0], hacc[ni][1]); o.y = pk2(hacc[ni][2], hacc[ni][3]);
                *(LAS u32x2*)(Hb + (16 * pt + l15) * PP + (16 * (4 * nh + ni) + 4 * l4) * 2) = o; }
        }
    }
    __syncthreads();
}

__device__ __forceinline__ void s5_unit(Frame& F, int b, int dir, int gq) {
    const int lane = F.lane, w = F.wave, nn = lane & 31, hi = lane >> 5, l15 = lane & 15, l4 = lane >> 4;
    const Params& P = *F.p;
    const bf16_t* Pb = (const bf16_t*)(F.ws + WS_P);
    bf16_t* Y = (bf16_t*)((unsigned char*)F.p->out + (dir ? OUT_YS1 : OUT_YS0));
    const int G = gq * 8 + w, dg = dir * 32 + G;
    lptr Hs = F.lds + w * 8704; constexpr int PH = 272;
    float abr[2], abi[2];
    bf16x8 bfr[4], cfr[4];
    {
        const float dt = __expf(P.in[I_S5LDT][dg]);
        float zr[2], zi[2];
#pragma unroll
        for (int s = 0; s < 2; ++s) {
            const int n = nn + 32 * s; const float are = P.in[I_S5ARE][dg * 64 + n], aim = P.in[I_S5AIM][dg * 64 + n];
            const float mag = __expf(dt * are); float rev = dt * aim * 0.15915494309189533577f; rev = rev - floorf(rev);
            abr[s] = mag * __builtin_amdgcn_cosf(rev); abi[s] = mag * __builtin_amdgcn_sinf(rev);
            const float den = are * are + aim * aim;
            zr[s] = ((abr[s] - 1.f) * are + abi[s] * aim) / den; zi[s] = (abi[s] * are - (abr[s] - 1.f) * aim) / den;
        }
#pragma unroll
        for (int ct = 0; ct < 4; ++ct) {
            const int s = ct & 1, n = nn + 32 * s; const bool im = ct >= 2;
            const float* br = P.in[I_S5BRE] + ((size_t)dg * 64 + n) * 16 + 8 * hi; const float* bi = P.in[I_S5BIM] + ((size_t)dg * 64 + n) * 16 + 8 * hi;
            float v[8];
#pragma unroll
            for (int j = 0; j < 8; ++j) v[j] = im ? (zr[s] * bi[j] + zi[s] * br[j]) : (zr[s] * br[j] - zi[s] * bi[j]);
            u32x4 o; o.x = pk2(v[0], v[1]); o.y = pk2(v[2], v[3]); o.z = pk2(v[4], v[5]); o.w = pk2(v[6], v[7]);
            bfr[ct] = __builtin_bit_cast(bf16x8, o);
        }
#pragma unroll
        for (int ks = 0; ks < 4; ++ks) {
            const int n0 = (32 * ks + 8 * l4) >> 1;
            const float* cre = P.in[I_S5CRE] + ((size_t)dg * 16 + l15) * 64 + n0; const float* cim = P.in[I_S5CIM] + ((size_t)dg * 16 + l15) * 64 + n0;
            float v[8];
#pragma unroll
            for (int j = 0; j < 4; ++j) { v[2 * j] = cre[j]; v[2 * j + 1] = -cim[j]; }
            u32x4 o; o.x = pk2(v[0], v[1]); o.y = pk2(v[2], v[3]); o.z = pk2(v[4], v[5]); o.w = pk2(v[6], v[7]);
            cfr[ks] = __builtin_bit_cast(bf16x8, o);
        }
    }
    float pwr[2][8], pwi[2][8];
#pragma unroll
    for (int s = 0; s < 2; ++s) { float pr = abr[s], pi = abi[s];
#pragma unroll
        for (int r = 0; r < 8; ++r) { pwr[s][r] = pr; pwi[s][r] = pi; const float tr = pr * abr[s] - pi * abi[s], ti = pr * abi[s] + pi * abr[s]; pr = tr; pi = ti; } }
    float sr[2] = {0.f, 0.f}, si[2] = {0.f, 0.f};
    const size_t rowb = (size_t)b * LT;
    const int rho = nn, tau_a = 16 * ((rho >> 2) & 1) + (rho & 3) + 4 * (rho >> 3);
    u32x4 unext = *(const u32x4*)(Pb + (rowb + (size_t)((dir ? 255 : 0) + (dir ? -1 : 1) * tau_a)) * NP1 + C_U + G * 16 + 8 * hi);
    for (int blk = 0; blk < 72; ++blk) {
        const int i0 = 32 * blk; const int p0 = dir ? (i0 < 256 ? 255 - i0 : 2559 - i0) : i0; const int sg = dir ? -1 : 1;
        const u32x4 ua = unext;
        { const int i1 = (blk < 71) ? 32 * (blk + 1) : i0; const int p1 = dir ? (i1 < 256 ? 255 - i1 : 2559 - i1) : i1;
          unext = *(const u32x4*)(Pb + (rowb + (size_t)(p1 + sg * tau_a)) * NP1 + C_U + G * 16 + 8 * hi); }
        const bf16x8 af = __builtin_bit_cast(bf16x8, ua);
        f32x16 acc[4];
#pragma unroll
        for (int ct = 0; ct < 4; ++ct) { f32x16 z = f32x16{}; acc[ct] = __builtin_amdgcn_mfma_f32_32x32x16_bf16(af, bfr[ct], z, 0, 0, 0);
            asm volatile("s_nop 15\n\ts_nop 15" : "+v"(acc[ct]));
        }
#pragma unroll
        for (int s = 0; s < 2; ++s) {
            float xr = hi ? 0.f : sr[s], xi = hi ? 0.f : si[s];
#pragma unroll
            for (int r = 0; r < 16; ++r) { const float nr = abr[s] * xr - abi[s] * xi + acc[s][r], ni = abr[s] * xi + abi[s] * xr + acc[2 + s][r]; xr = nr; xi = ni; acc[s][r] = nr; acc[2 + s][r] = ni; }
            float cr = lane_get(xr, nn), ci = lane_get(xi, nn);
            if (!hi) { cr = 0.f; ci = 0.f; }
#pragma unroll
            for (int r = 0; r < 8; ++r) { acc[s][r] += pwr[s][r] * cr - pwi[s][r] * ci; acc[2 + s][r] += pwr[s][r] * ci + pwi[s][r] * cr; }
            { const float tr = pwr[s][7] * cr - pwi[s][7] * ci, ti = pwr[s][7] * ci + pwi[s][7] * cr; cr = tr; ci = ti; }
#pragma unroll
            for (int r = 0; r < 8; ++r) { acc[s][8 + r] += pwr[s][r] * cr - pwi[s][r] * ci; acc[2 + s][8 + r] += pwr[s][r] * ci + pwi[s][r] * cr; }
            sr[s] = lane_get(acc[s][15], nn + 32); si[s] = lane_get(acc[2 + s][15], nn + 32);
        }
#pragma unroll
        for (int r = 0; r < 16; ++r) {
            const int tau = 16 * hi + r; lptr hp = Hs + tau * PH;
            *(LAS unsigned*)(hp + nn * 4) = pk2(acc[0][r], acc[2][r]); *(LAS unsigned*)(hp + (32 + nn) * 4) = pk2(acc[1][r], acc[3][r]);
        }
        LDS_WAIT();
#pragma unroll
        for (int tt = 0; tt < 2; ++tt) {
            f32x4 a = (f32x4){0.f, 0.f, 0.f, 0.f};
#pragma unroll
            for (int ks = 0; ks < 4; ++ks) a = MFMA16(cfr[ks], frag(Hs, PH, 16 * tt, 32 * ks, lane), a);
            const int tau = 16 * tt + l15;
            u32x2 o; o.x = pk2(a[0], a[1]); o.y = pk2(a[2], a[3]);
            *(u32x2*)(Y + (rowb + (size_t)(p0 + sg * tau)) * 512 + G * 16 + 4 * l4) = o;
        }
        LDS_WAIT();
    }
}
#undef MFMA16
}
__device__ __forceinline__ void finalize0_phase(Frame& F) {
    const bf16_t* Y0 = (const bf16_t*)(F.ws + WS_Y0); const bf16_t* Y1 = (const bf16_t*)(F.ws + WS_Y1); const bf16_t* Pb = (const bf16_t*)(F.ws + WS_P);
    bf16_t* MIX = (bf16_t*)(F.ws + WS_HB); const float* gn = F.p->in[I_MLNORM] + 8 * F.lane;
    float g[8];
#pragma unroll
    for (int e = 0; e < 8; ++e) g[e] = gn[e];
    const int r0 = wave_row0(F.bid, F.wave);
#pragma unroll 1
    for (int ri3 = 0; ri3 < ROWS_PER_WAVE; ri3 += 3) {
        u32x4 a[3], b[3], o[3];
#pragma unroll
        for (int q = 0; q < 3; ++q) { const size_t r = r0 + ri3 + q;
            a[q] = *(const u32x4*)(Y0 + r * 512 + 8 * F.lane); b[q] = *(const u32x4*)(Y1 + r * 512 + 8 * F.lane); o[q] = *(const u32x4*)(Pb + r * NP0 + C_MO + 8 * F.lane); }
#pragma unroll
        for (int q = 0; q < 3; ++q) { const size_t r = r0 + ri3 + q;
            float x[8], y[8], og[8]; mix::unpack8(a[q], x); mix::unpack8(b[q], y); mix::unpack8(o[q], og);
            float ss = 0.f;
#pragma unroll
            for (int e = 0; e < 8; ++e) { x[e] += y[e]; ss += x[e] * x[e]; }
            ss += xorl<1>(ss); ss += xorl<2>(ss); ss += xorl<4>(ss); ss += xorl<8>(ss);
            const float rstd = rsqrtf(ss * (1.f / 128.f) + NORM_EPS);
#pragma unroll
            for (int e = 0; e < 8; ++e) x[e] = x[e] * rstd * g[e] * sigmoidf_(og[e]);
            u32x4 w; w.x = pk2(x[0], x[1]); w.y = pk2(x[2], x[3]); w.z = pk2(x[4], x[5]); w.w = pk2(x[6], x[7]);
            *(u32x4*)(MIX + r * D + 8 * F.lane) = w; }
    }
}
__device__ __forceinline__ float gelu_tanh(float x) { const float a = 0.7978845608028654f * (x + 0.044715f * x * x * x); const float t = 1.f - 2.f / (1.f + __expf(2.f * a)); return 0.5f * x * (1.f + t); }
__device__ __forceinline__ void finalize1_phase(Frame& F) {
    const bf16_t* S0 = (const bf16_t*)((const unsigned char*)F.p->out + OUT_YS0); const bf16_t* S1 = (const bf16_t*)((const unsigned char*)F.p->out + OUT_YS1);
    const bf16_t* D0 = (const bf16_t*)((const unsigned char*)F.p->out + OUT_YD0); const bf16_t* D1 = (const bf16_t*)(F.ws + WS_YD1); const bf16_t* Pb = (const bf16_t*)(F.ws + WS_P);
    bf16_t* MIX = (bf16_t*)(F.ws + WS_HB); bf16_t* Gb = (bf16_t*)(F.ws + WS_G);
    float sd[8], gn[8];
#pragma unroll
    for (int e = 0; e < 8; ++e) { sd[e] = F.p->in[I_S5D][8 * F.lane + e]; gn[e] = F.p->in[I_SSDNORM][8 * F.lane + e]; }
    const int r0 = wave_row0(F.bid, F.wave);
#pragma unroll 1
    for (int ri3 = 0; ri3 < ROWS_PER_WAVE; ri3 += 3) {
        u32x4 a[3], b[3], u[3], c[3], d[3], z[3];
#pragma unroll
        for (int q = 0; q < 3; ++q) { const size_t r = r0 + ri3 + q;
            a[q] = *(const u32x4*)(S0 + r * 512 + 8 * F.lane); b[q] = *(const u32x4*)(S1 + r * 512 + 8 * F.lane); u[q] = *(const u32x4*)(Pb + r * NP1 + C_U + 8 * F.lane);
            c[q] = *(const u32x4*)(D0 + r * 512 + 8 * F.lane); d[q] = *(const u32x4*)(D1 + r * 512 + 8 * F.lane); z[q] = *(const u32x4*)(Pb + r * NP1 + C_Z + 8 * F.lane); }
#pragma unroll
        for (int q = 0; q < 3; ++q) { const size_t r = r0 + ri3 + q;
            if (row_is_ctx((int)r)) continue;
            {
                float x[8], y[8], uu[8]; mix::unpack8(a[q], x); mix::unpack8(b[q], y); mix::unpack8(u[q], uu);
#pragma unroll
                for (int e = 0; e < 8; ++e) x[e] = gelu_tanh(x[e] + y[e] + sd[e] * uu[e]);
                u32x4 w; w.x = pk2(x[0], x[1]); w.y = pk2(x[2], x[3]); w.z = pk2(x[4], x[5]); w.w = pk2(x[6], x[7]);
                *(u32x4*)(Gb + r * 512 + 8 * F.lane) = w;
            }
            {
                float x[8], y[8], zz[8]; mix::unpack8(c[q], x); mix::unpack8(d[q], y); mix::unpack8(z[q], zz);
                float ss = 0.f;
#pragma unroll
                for (int e = 0; e < 8; ++e) { x[e] = (x[e] + y[e]) * siluf_(zz[e]); ss += x[e] * x[e]; }
                const float rstd = rsqrtf(wave_sum(ss) * (1.f / 512.f) + NORM_EPS);
#pragma unroll
                for (int e = 0; e < 8; ++e) x[e] = x[e] * rstd * gn[e];
                u32x4 w; w.x = pk2(x[0], x[1]); w.y = pk2(x[2], x[3]); w.z = pk2(x[4], x[5]); w.w = pk2(x[6], x[7]);
                *(u32x4*)(MIX + r * D + 512 + 8 * F.lane) = w;
            }
        }
    }
}

__device__ __forceinline__ void conv_phase(Frame& F) {
    const bf16_t* Pb = (const bf16_t*)(F.ws + WS_P); bf16_t* XB = (bf16_t*)(F.ws + WS_HB);
    const int c0 = 16 * F.lane;
    float w0[16], w1[16], w2[16], bb[16];
#pragma unroll
    for (int e = 0; e < 16; ++e) { w0[e] = F.p->in[I_CONVW][c0 + e]; w1[e] = F.p->in[I_CONVW][1024 + c0 + e]; w2[e] = F.p->in[I_CONVW][2048 + c0 + e]; bb[e] = F.p->in[I_CONVB][c0 + e]; }
    const int r0 = wave_row0(F.bid, F.wave);
    const u32x4 z4 = (u32x4){0u, 0u, 0u, 0u};
    auto ld = [&](int r, u32x4& a, u32x4& b2) { const bf16_t* p = Pb + (size_t)r * NP1 + C_XS + c0; a = *(const u32x4*)p; b2 = *(const u32x4*)(p + 8); };
    u32x4 pa, pb, ca, cb2, na, nb;
    ld(r0 > 0 ? r0 - 1 : 0, pa, pb);
    ld(r0, ca, cb2);
#pragma unroll 1
    for (int ri = 0; ri < ROWS_PER_WAVE; ++ri) {
        const int r = r0 + ri, p = r % LT;
        ld(r + 1 < R ? r + 1 : R - 1, na, nb);
        const bool okm = (p != 0) && (p != CTXL), okp = (p != CTXL - 1) && (p != LT - 1);
        float xm[16], x0[16], xp[16];
        mix::unpack8(okm ? pa : z4, xm); mix::unpack8(okm ? pb : z4, xm + 8); mix::unpack8(ca, x0); mix::unpack8(cb2, x0 + 8); mix::unpack8(okp ? na : z4, xp); mix::unpack8(okp ? nb : z4, xp + 8);
        float y[16];
#pragma unroll
        for (int e = 0; e < 16; ++e) y[e] = siluf_(w0[e] * xm[e] + w1[e] * x0[e] + w2[e] * xp[e] + bb[e]);
        u32x4 o0, o1; o0.x = pk2(y[0], y[1]); o0.y = pk2(y[2], y[3]); o0.z = pk2(y[4], y[5]); o0.w = pk2(y[6], y[7]);
        o1.x = pk2(y[8], y[9]); o1.y = pk2(y[10], y[11]); o1.z = pk2(y[12], y[13]); o1.w = pk2(y[14], y[15]);
        bf16_t* q = XB + (size_t)r * D + c0; *(u32x4*)q = o0; *(u32x4*)(q + 8) = o1;
        pa = ca; pb = cb2; ca = na; cb2 = nb;
    }
}

#ifndef ONLY
#define ONLY -1
#endif
#ifndef REP
#define REP -1
#endif
#ifndef DUMP
#define DUMP -1
#endif
#ifndef DUMPSRC
#define DUMPSRC 0
#endif
#define PORD(k) ((k) <= 12 ? (k) : ((k) == 21 ? 13 : (k) + 1))
#define LIVE(k) (DUMP < 0 || PORD(k) <= PORD(DUMP))
#ifndef REPSEL
#define REPSEL 0
#endif
__global__ void __launch_bounds__(NTHREADS, 2) fwd_kernel(Params prm) {
    extern __shared__ __attribute__((aligned(16))) unsigned char lds[];
    Frame F;
    F.lds = (LAS unsigned char*)lds; F.MISC = (volatile LAS unsigned*)(F.lds + MISC_OFF);
    F.tid = threadIdx.x; F.lane = F.tid & 63; F.wave = __builtin_amdgcn_readfirstlane(F.tid >> 6); F.wave_s = F.wave;
    F.G = gridDim.x; F.bid = blockIdx.x; F.vcu = (F.G % 8 == 0) ? (F.bid % 8) * (F.G / 8) + F.bid / 8 : F.bid;
    F.p = &prm; F.ws = prm.ws; F.ctl = (gu32*)(prm.ws + WS_CTL);
    if (F.tid < 64) F.MISC[F.tid] = 0u;
    __syncthreads();
    XcdBarrier bar = xcd_barrier_post((unsigned*)(F.ctl + CW_BAR), F.MISC + 8, F.tid);
#define GRID_BAR() xcd_barrier(bar, opaque_tid(F.wave_s))
#ifdef TMASK
    unsigned long long tp_t0 = 0, tp_acc = 0;
#define TP_BEGIN(k) do { if (((TMASK) >> (k)) & 1) tp_t0 = __builtin_amdgcn_s_memrealtime(); } while (0)
#define TP_END(k) do { if (((TMASK) >> (k)) & 1) tp_acc += __builtin_amdgcn_s_memrealtime() - tp_t0; } while (0)
#else
#define TP_BEGIN(k) do {} while (0)
#define TP_END(k) do {} while (0)
#endif
#ifndef UBLK
#define UBLK 0
#endif
    bool ut_done4 = false;
#if defined(TMASK) && defined(USEL)
#define UT_BEGIN(k) do { if (USEL == (k) && F.bid == UBLK) tp_t0 = __builtin_amdgcn_s_memrealtime(); } while (0)
#define UT_END(k) do { if (USEL == (k) && F.bid == UBLK) tp_acc += __builtin_amdgcn_s_memrealtime() - tp_t0; } while (0)
#else
#define UT_BEGIN(k) do {} while (0)
#define UT_END(k) do {} while (0)
#endif
#define PH() do { F.tid = opaque_tid(F.wave_s); F.lane = F.tid & 63; F.wave = F.wave_s; } while (0)
    const char* ws = (const char*)prm.ws;
    const float* mod0 = (const float*)(ws + WS_MOD); const float* mod1 = mod0 + 17 * 6144;


    TP_BEGIN(0); if (LIVE(0) && (ONLY < 0 || ONLY == 0)) { for (int rep = 0; rep < ((REP == 0) ? 2 : 1); ++rep) { if (rep) GRID_BAR(); PH();
    p0_prologue(F); } }
    GRID_BAR(); TP_END(0);
    TP_BEGIN(1); if (LIVE(1) && (ONLY < 0 || ONLY == 1)) { for (int rep = 0; rep < ((REP == 1) ? 2 : 1); ++rep) { if (rep) GRID_BAR(); PH();
    norm_phase<0>(F); } }
    GRID_BAR(); TP_END(1);
    TP_BEGIN(2); if (LIVE(2) && (ONLY < 0 || ONLY == 2)) { for (int rep = 0; rep < ((REP == 2) ? 2 : 1); ++rep) { if (rep) GRID_BAR(); PH();
    {
        pg8::Gemm g{D, D, D}; pg8::DenseSched<false> S{ws + WS_HB, ws + WS_WIN0, NP0 / 256 + 1, F.G, F.bid, (size_t)256 * D * 2, (size_t)256 * D * 2};
        pg8::EpiStoreBf16 E{(bf16_t*)(prm.ws + WS_P), NP0, NP0 / 256, (float*)(prm.ws + WS_GATES), 0};
        pg8::gemm_phase<pg8::EpiStoreBf16, pg8::DenseSched<false>, true>(F.lds, g, S, E, F.wave_s);
    }
    } }
    GRID_BAR(); TP_END(2);
    TP_BEGIN(3); if (LIVE(3) && (ONLY < 0 || ONLY == 3)) { for (int rep = 0; rep < ((REP == 3) ? 2 : 1); ++rep) { if (rep) GRID_BAR(); PH();
    knorm_phase(F); } }
    GRID_BAR(); TP_END(3);
    TP_BEGIN(4); if (LIVE(4) && (ONLY < 0 || ONLY == 4 || ONLY == 40 || ONLY == 41)) { for (int rep = 0; rep < ((REP == 4) ? 2 : 1); ++rep) { if (rep) GRID_BAR(); PH();
    {
        if (ONLY != 41 && !(rep == 1 && REPSEL == 2) && F.bid < 128) {
            UT_BEGIN(3); const int u = F.bid;
            mix::mlstm_unit(F, u >> 3, (u >> 1) & 3, u & 1); UT_END(3);
        }
        if (ONLY != 40 && !(rep == 1 && REPSEL == 1)) for (;;) {
            const int a = q_next(F, 1 + 4 * rep);
            if (a >= 1152) break;
            int b, h, qb;
            if (a < 1024) { qb = 1 + (a & 7); b = a >> 6; h = ((a >> 5) & 1) * 4 + ((a >> 3) & 3); } else { const int a2 = a - 1024; b = a2 >> 3; h = a2 & 7; qb = 0; }
            const bool tm_ = (a < 1024) && (F.bid == UBLK) && !ut_done4; if (tm_) { UT_BEGIN(4); }
            attn_body::attn_unit<8>(b, h, qb, (const bf16_t*)(prm.ws + WS_P), (bf16_t*)(prm.ws + WS_HB), prm.in[I_QNORM], (char*)lds, F.wave_s);
            if (tm_) { UT_END(4); ut_done4 = true; }
        }
    }
    } }
    GRID_BAR(); TP_END(4);
    TP_BEGIN(5); if (LIVE(5) && (ONLY < 0 || ONLY == 5)) { for (int rep = 0; rep < ((REP == 5) ? 2 : 1); ++rep) { if (rep) GRID_BAR(); PH();
    finalize0_phase(F); } }
    GRID_BAR(); TP_END(5);
    TP_BEGIN(6); if (LIVE(6) && (ONLY < 0 || ONLY == 6)) { for (int rep = 0; rep < ((REP == 6) ? 2 : 1); ++rep) { if (rep) GRID_BAR(); PH();
    {
        pg8::Gemm g{D, D, D}; pg8::DenseSched<false> S{ws + WS_HB, ws + WS_WOUT0, 4, F.G, F.bid, (size_t)256 * D * 2, (size_t)256 * D * 2};
        pg8::EpiResid<true> E{prm.in[I_X], prm.in[I_CTX], (bf16_t*)(prm.ws + WS_XR), mod0 + 2048};
        pg8::gemm_phase<pg8::EpiResid<true>, pg8::DenseSched<false>, true>(F.lds, g, S, E, F.wave_s);
        if (false) { PH(); tr_list_range<1>(F, 0, TRL1 / 2, (F.bid - 64) * NWAVES + F.wave, 192 * NWAVES); }
    }
    } }
    GRID_BAR(); TP_END(6);
    TP_BEGIN(7); if (LIVE(7) && (ONLY < 0 || ONLY == 7)) { for (int rep = 0; rep < ((REP == 7) ? 2 : 1); ++rep) { if (rep) GRID_BAR(); PH();
    norm_phase<1>(F); } }
    GRID_BAR(); TP_END(7);
    TP_BEGIN(8); if (LIVE(8) && (ONLY < 0 || ONLY == 8)) { for (int rep = 0; rep < ((REP == 8) ? 2 : 1); ++rep) { if (rep) GRID_BAR(); PH();
    route_phase<0>(F); } }
    GRID_BAR(); TP_END(8);
    TP_BEGIN(9); if (LIVE(9) && (ONLY < 0 || ONLY == 9)) { for (int rep = 0; rep < ((REP == 9) ? 2 : 1); ++rep) { if (rep) GRID_BAR(); PH();
    {
        MoeTab T = moe_tables(F, F.lds + 131072, false);
        pg8::Gemm g{D, D, D}; pg8::MoeSched S{ws + WS_HB, ws + WS_GU0, 8, F.G, F.bid, T.ntile[0], T.base, false, (const int*)(ws + WS_ROUTE + RT_TOK)};
        pg8::EpiSwiGlu E{(bf16_t*)(prm.ws + WS_ACT), (const float*)(ws + WS_ROUTE + RT_WPOS)};
        pg8::gemm_phase<pg8::EpiSwiGlu, pg8::MoeSched, true, true>(F.lds, g, S, E, F.wave_s);
    }
    } }
    GRID_BAR(); TP_END(9);
    TP_BEGIN(10); if (LIVE(10) && (ONLY < 0 || ONLY == 10)) { for (int rep = 0; rep < ((REP == 10) ? 2 : 1); ++rep) { if (rep) GRID_BAR(); PH();
    {
        MoeTab T = moe_tables(F, F.lds + 131072, false);
        pg8::Gemm g{D, 512, D}; pg8::MoeSched S{ws + WS_ACT, ws + WS_D0, 4, F.G, F.bid, T.ntile[0], T.base, true, (const int*)(ws + WS_ROUTE + RT_TOK)};
        pg8::EpiDown<false> E{(const int*)(ws + WS_ROUTE + RT_TOK), prm.out, (bf16_t*)(prm.ws + WS_XR), mod0 + 5120};
        pg8::gemm_phase<pg8::EpiDown<false>, pg8::MoeSched, true>(F.lds, g, S, E, F.wave_s);
        {
            const int nu = 4 * T.ntile[0]; int third = nu - 2 * F.G; third = third < 0 ? 0 : (third > F.G - 32 ? F.G - 32 : third);
            if (false) { PH(); tr_list_range<1>(F, TRL1 / 2, TRL1, (F.bid - third) * NWAVES + F.wave, (F.G - third) * NWAVES); }
        }
    }
    } }
    GRID_BAR(); TP_END(10);
    TP_BEGIN(11); if (LIVE(11) && (ONLY < 0 || ONLY == 11)) { for (int rep = 0; rep < ((REP == 11) ? 2 : 1); ++rep) { if (rep) GRID_BAR(); PH();
    norm_phase<2>(F); } }
    GRID_BAR(); TP_END(11);
    TP_BEGIN(12); if (LIVE(12) && (ONLY < 0 || ONLY == 12)) { for (int rep = 0; rep < ((REP == 12) ? 2 : 1); ++rep) { if (rep) GRID_BAR(); PH();
    {
        pg8::Gemm g{D, D, D}; pg8::InProj1Sched S{ws + WS_HB, ws + WS_WIN1, F.G, F.bid, (size_t)256 * D * 2, (size_t)256 * D * 2};
        pg8::EpiStoreBf16 E{(bf16_t*)(prm.ws + WS_P), NP1, NP1 / 256, (float*)(prm.ws + WS_GATES), 2};
        pg8::gemm_phase<pg8::EpiStoreBf16, pg8::InProj1Sched, true>(F.lds, g, S, E, F.wave_s);
    }
    } }
    GRID_BAR(); TP_END(12);
    TP_BEGIN(21); if (LIVE(21) && (ONLY < 0 || ONLY == 21)) { for (int rep = 0; rep < ((REP == 21) ? 2 : 1); ++rep) { if (rep) GRID_BAR(); PH();
    conv_phase(F); } }
    GRID_BAR(); TP_END(21);
    TP_BEGIN(13); if (LIVE(13) && (ONLY < 0 || ONLY == 13 || ONLY == 130 || ONLY == 131)) { for (int rep = 0; rep < ((REP == 13) ? 2 : 1); ++rep) { if (rep) GRID_BAR(); PH();
    {
        if (ONLY != 131 && !(rep == 1 && REPSEL == 2) && F.bid < 128) {
            UT_BEGIN(1); const int u = F.bid;
            mix::s5_unit(F, u >> 3, (u >> 2) & 1, u & 3); UT_END(1);
        }
        if (ONLY != 130 && !(rep == 1 && REPSEL == 1)) for (int it = 0;; ++it) {
            const int a = q_next(F, 3 + 4 * rep);
            if (a >= 256) break;
            if (it == 0) UT_BEGIN(2);
            mix::ssd_unit(F, a >> 4, (a >> 1) & 7, a & 1);
            if (it == 0) UT_END(2);
        }
    }
    } }
    GRID_BAR(); TP_END(13);
    TP_BEGIN(14); if (LIVE(14) && (ONLY < 0 || ONLY == 14)) { for (int rep = 0; rep < ((REP == 14) ? 2 : 1); ++rep) { if (rep) GRID_BAR(); PH();
    finalize1_phase(F); } }
    GRID_BAR(); TP_END(14);
    TP_BEGIN(15); if (LIVE(15) && (ONLY < 0 || ONLY == 15)) { for (int rep = 0; rep < ((REP == 15) ? 2 : 1); ++rep) { if (rep) GRID_BAR(); PH();
    {
        pg8::Gemm g{512, 512, 512}; pg8::DenseSched<true> S{ws + WS_G, ws + WS_WGLU, 2, F.G, F.bid, (size_t)256 * 512 * 2, (size_t)256 * 512 * 2};
        pg8::EpiGlu E{(const bf16_t*)(ws + WS_G), (bf16_t*)(prm.ws + WS_HB), prm.in[I_GLUB]};
        pg8::gemm_phase<pg8::EpiGlu, pg8::DenseSched<true>, true>(F.lds, g, S, E, F.wave_s);
    }
    } }
    GRID_BAR(); TP_END(15);
    TP_BEGIN(16); if (LIVE(16) && (ONLY < 0 || ONLY == 16)) { for (int rep = 0; rep < ((REP == 16) ? 2 : 1); ++rep) { if (rep) GRID_BAR(); PH();
    {
        pg8::Gemm g{D, D, D}; pg8::DenseSched<true> S{ws + WS_HB, ws + WS_WOUT1, 4, F.G, F.bid, (size_t)256 * D * 2, (size_t)256 * D * 2};
        pg8::EpiResid<false> E{prm.in[I_X], prm.in[I_CTX], (bf16_t*)(prm.ws + WS_XR), mod1 + 2048};
        pg8::gemm_phase<pg8::EpiResid<false>, pg8::DenseSched<true>, true>(F.lds, g, S, E, F.wave_s);
    }
    } }
    GRID_BAR(); TP_END(16);
    TP_BEGIN(17); if (LIVE(17) && (ONLY < 0 || ONLY == 17)) { for (int rep = 0; rep < ((REP == 17) ? 2 : 1); ++rep) { if (rep) GRID_BAR(); PH();
    norm_phase<3>(F); } }
    GRID_BAR(); TP_END(17);
    TP_BEGIN(18); if (LIVE(18) && (ONLY < 0 || ONLY == 18)) { for (int rep = 0; rep < ((REP == 18) ? 2 : 1); ++rep) { if (rep) GRID_BAR(); PH();
    route_phase<1>(F); } }
    GRID_BAR(); TP_END(18);
    TP_BEGIN(19); if (LIVE(19) && (ONLY < 0 || ONLY == 19)) { for (int rep = 0; rep < ((REP == 19) ? 2 : 1); ++rep) { if (rep) GRID_BAR(); PH();
    {
        MoeTab T = moe_tables(F, F.lds + 131072, false);
        pg8::Gemm g{D, D, D}; pg8::MoeSched S{ws + WS_HB, ws + WS_GU1, 8, F.G, F.bid, T.ntile[0], T.base, false, (const int*)(ws + WS_ROUTE + RT_TOK)};
        pg8::EpiSwiGlu E{(bf16_t*)(prm.ws + WS_ACT), (const float*)(ws + WS_ROUTE + RT_WPOS)};
        pg8::gemm_phase<pg8::EpiSwiGlu, pg8::MoeSched, true, true>(F.lds, g, S, E, F.wave_s);
    }
    } }
    GRID_BAR(); TP_END(19);
    TP_BEGIN(20); if (LIVE(20) && (ONLY < 0 || ONLY == 20)) { for (int rep = 0; rep < ((REP == 20) ? 2 : 1); ++rep) { if (rep) GRID_BAR(); PH();
    {
        MoeTab T = moe_tables(F, F.lds + 131072, false);
        pg8::Gemm g{D, 512, D}; pg8::MoeSched S{ws + WS_ACT, ws + WS_D1, 4, F.G, F.bid, T.ntile[0], T.base, true, (const int*)(ws + WS_ROUTE + RT_TOK)};
        pg8::EpiDown<true> E{(const int*)(ws + WS_ROUTE + RT_TOK), prm.out, (bf16_t*)(prm.ws + WS_XR), mod1 + 5120};
        pg8::gemm_phase<pg8::EpiDown<true>, pg8::MoeSched, true>(F.lds, g, S, E, F.wave_s);
    }
} }
    GRID_BAR(); TP_END(20);
#ifdef EXTRA_BARS
    for (int i = 0; i < EXTRA_BARS; ++i) GRID_BAR();
#endif
#ifdef FINALHASH
    {
        PH();
        for (size_t i = (size_t)F.bid * NTHREADS + F.tid; i < (size_t)NBATCH * SEQ * D / 4; i += (size_t)GRID * NTHREADS) {
            const u32x4 w = ((const u32x4*)prm.out)[i];
            auto hsh = [](unsigned v) -> float { return (float)(((v * 2654435761u) >> 12) & 0xFFFFu) * (1.f / 65536.f); };
            ((f32x4*)prm.out)[i] = (f32x4){hsh(w.x), hsh(w.y), hsh(w.z), hsh(w.w)};
        }
    }
#endif
    if (DUMP >= 0) {
        PH();
#ifdef DUMPCOPY
        {
            const u32x4* src = (const u32x4*)((const unsigned char*)prm.out + (DUMPCOPY ? OUT_YS1 : OUT_YS0)); u32x4* dst = (u32x4*)(prm.ws + WS_G);
            for (size_t i = (size_t)F.bid * NTHREADS + F.tid; i < (size_t)R * 512 * 2 / 16; i += (size_t)GRID * NTHREADS) dst[i] = src[i];
            GRID_BAR(); PH();
        }
#endif
        const bf16_t* sb = (const bf16_t*)(prm.ws + (DUMPSRC == 0 ? WS_XR : (DUMPSRC == 1 ? WS_HB : (DUMPSRC == 2 ? WS_P : WS_G))));
        constexpr int spitch = (DUMPSRC == 2) ? NP1 : ((DUMPSRC == 3) ? 512 : D);
        for (size_t i = (size_t)F.bid * NTHREADS + F.tid; i < (size_t)NBATCH * SEQ * D / 4; i += (size_t)GRID * NTHREADS) {
            const size_t e = i * 4; const int col = (int)(e % D); const size_t tr = e / D; const int b = (int)(tr / SEQ), t = (int)(tr % SEQ);
            const size_t r = (size_t)b * LT + CTXL + t;
            const int c2 = (DUMPSRC == 3) ? (col & 511) : col;
            if (DUMPSRC == 5) { const u32x2 w = *(const u32x2*)((const bf16_t*)(prm.ws + WS_ACT) + e); ((f32x4*)prm.out)[i] = (f32x4){bflo(w.x), bfhi(w.x), bflo(w.y), bfhi(w.y)}; continue; }
            if (DUMPSRC == 7) { const int* cg = (const int*)(prm.ws + WS_ROUTE + RT_CNT); f32x4 o = {0.f, 0.f, 0.f, 0.f};
                if (i < 1536) o = (f32x4){(float)cg[4 * i], (float)cg[4 * i + 1], (float)cg[4 * i + 2], (float)cg[4 * i + 3]};
                ((f32x4*)prm.out)[i] = o; continue; }
            if (DUMPSRC == 8) { f32x4 o = {0.f, 0.f, 0.f, 0.f}; const int* clsg = (const int*)(prm.ws + WS_ROUTE + RT_CLS); const float* wts = (const float*)(prm.ws + WS_ROUTE + RT_WTS);
                auto hs8 = [](unsigned v) -> float { return (float)(((v * 2654435761u) >> 12) & 0xFFFFu) * (1.f / 65536.f); };
                if (col == 0) o = (f32x4){hs8((unsigned)clsg[r]), hs8(__float_as_uint(wts[2 * r])), hs8(__float_as_uint(wts[2 * r + 1])), 0.f};
                ((f32x4*)prm.out)[i] = o; continue; }
            if (DUMPSRC == 6) { f32x4 o = {0.f, 0.f, 0.f, 0.f}; const int idx = b * SEQ + t;
                const int* clsg = (const int*)(prm.ws + WS_ROUTE + RT_CLS); const float* wts = (const float*)(prm.ws + WS_ROUTE + RT_WTS);
                const int* tok = (const int*)(prm.ws + WS_ROUTE + RT_TOK); const float* wpos = (const float*)(prm.ws + WS_ROUTE + RT_WPOS);
                if (col == 0) o = (f32x4){(float)clsg[r], wts[2 * r], wts[2 * r + 1], (float)tok[idx]};
                else if (col == 4) o = (f32x4){0.f, wpos[2 * (size_t)idx], wpos[2 * (size_t)idx + 1], 0.f};
                ((f32x4*)prm.out)[i] = o; continue; }
            const u32x2 w = *(const u32x2*)(sb + r * spitch + c2);
#ifdef DUMPHASH
            { auto hsh = [](unsigned v) -> float { return (float)(((v * 2654435761u) >> 12) & 0xFFFFu) * (1.f / 65536.f); };
              ((f32x4*)prm.out)[i] = (f32x4){hsh(w.x & 0xffffu), hsh(w.x >> 16), hsh(w.y & 0xffffu), hsh(w.y >> 16)}; continue; }
#endif
            ((f32x4*)prm.out)[i] = (f32x4){bflo(w.x), bfhi(w.x), bflo(w.y), bfhi(w.y)};
        }
    }
#ifdef BWTEST
    {
        GRID_BAR();
        const unsigned long long tb0 = __builtin_amdgcn_s_memrealtime();
        PH();
        const f32x4* src = (const f32x4*)prm.in[I_X]; f32x4* dst = (f32x4*)(prm.ws + WS_P);
        const size_t n4 = (size_t)NBATCH * SEQ * D / 4; const size_t stride = (size_t)GRID * NTHREADS;
        for (size_t i = (size_t)F.bid * NTHREADS + F.tid; i < n4; i += stride * BWTEST) {
            f32x4 v[BWTEST];
#pragma unroll
            for (int u = 0; u < BWTEST; ++u) v[u] = (i + u * stride < n4) ? src[i + u * stride] : (f32x4){0.f, 0.f, 0.f, 0.f};
#pragma unroll
            for (int u = 0; u < BWTEST; ++u) if (i + u * stride < n4) dst[i + u * stride] = v[u];
        }
        GRID_BAR();
        tp_acc += __builtin_amdgcn_s_memrealtime() - tb0;
    }
#endif
#ifdef TMASK
    if (F.bid == UBLK) { const unsigned long long t_end = __builtin_amdgcn_s_memrealtime() + (unsigned long long)(TAMP) * tp_acc; while (__builtin_amdgcn_s_memrealtime() < t_end) __builtin_amdgcn_s_sleep(32); }
#endif
#undef GRID_BAR
}

extern "C" void kernel_launch(void* const* d_in, const int* in_sizes, int n_in, void* d_out, int out_size, void* d_ws, size_t ws_size, hipStream_t stream) {
    static int ready = 0;
    if (ready == 0) {
        if (n_in != 39 || out_size != NBATCH * SEQ * D || ws_size < WS_END) { fprintf(stderr, "kernel_launch: unexpected problem (n_in %d, out %d, ws %zu); nothing launched\n", n_in, out_size, ws_size); ready = -1; return; }
        if (hipFuncSetAttribute((const void*)fwd_kernel, hipFuncAttributeMaxDynamicSharedMemorySize, LDS_BYTES) != hipSuccess) { fprintf(stderr, "kernel_launch: hipFuncSetAttribute failed\n"); ready = -1; return; }
        int per_cu = 0;
        if (hipOccupancyMaxActiveBlocksPerMultiprocessor(&per_cu, (const void*)fwd_kernel, NTHREADS, LDS_BYTES) != hipSuccess || per_cu < 1) fprintf(stderr, "kernel_launch: occupancy query reports %d workgroups per CU\n", per_cu);
        (void)hipGetLastError();
        ready = 1;
    }
    if (ready < 0) return;
    (void)in_sizes;
    if (hipMemsetAsync((char*)d_ws + WS_CTL, 0, CTL_ZERO_BYTES, stream) != hipSuccess) return;
    Params p{};
    for (int i = 0; i < 39; ++i) p.in[i] = (const float*)d_in[i];
    p.out = (float*)d_out; p.ws = (unsigned char*)d_ws;
    hipLaunchKernelGGL(fwd_kernel, dim3(GRID), dim3(NTHREADS), LDS_BYTES, stream, p);
}
```

```cpp
#include <hip/hip_runtime.h>
#include <hip/hip_bf16.h>
#include <cstdio>
#include <cstdint>
#include <cmath>

constexpr int D = 1024, NBATCH = 16, SEQ = 2048, CTXL = 256, LT = CTXL + SEQ  , R = NBATCH * LT  ;
constexpr int NP0 = 2816;
constexpr int NP1 = 2048;
constexpr int C_MQ = 0, C_MK = 512, C_MV = 1024, C_MO = 1536, C_AQ = 2048, C_AK = 2560, C_AV = 2688;
constexpr int C_U = 0, C_Z = 512, C_XS = 1024, C_B = 1536, C_C = 1792;
constexpr int NWAVES = 8, NTHREADS = 512, GRID = 256;
constexpr int ROWS_PER_WG = R / GRID  , ROWS_PER_WAVE = ROWS_PER_WG / NWAVES  ;
constexpr int NCLS = 24, MAXPOS = 43008  ;
constexpr float NORM_EPS = 1e-6f;

constexpr size_t MiB = 1u << 20;
constexpr size_t WS_CTL = 0, CTL_ZERO_BYTES = 1 * MiB;
constexpr size_t WS_MOD = 1 * MiB;
constexpr size_t WS_WIN0 = 2 * MiB, WS_WOUT0 = 8 * MiB, WS_WIN1 = 10 * MiB  , WS_WOUT1 = 14 * MiB + 512 * 1024, WS_WGLU = 16 * MiB + 512 * 1024;
constexpr size_t WS_GU0 = 18 * MiB, WS_D0 = 50 * MiB, WS_GU1 = 66 * MiB, WS_D1 = 98 * MiB;
constexpr size_t WS_GATES = 114 * MiB;
constexpr size_t WS_ROUTE = 117 * MiB;
constexpr size_t WS_XR = 404 * MiB;
constexpr size_t WS_HB = 134 * MiB;
constexpr size_t WS_P = 206 * MiB;
constexpr size_t WS_Y0 = 404 * MiB, WS_Y1 = 440 * MiB;
constexpr size_t OUT_YS0 = 0, OUT_YS1 = 36 * MiB, OUT_YD0 = 72 * MiB  , WS_YD1 = 350 * MiB;
constexpr size_t WS_G = WS_GU0;
constexpr size_t WS_H2S = WS_P, WS_ACT = WS_P + 84 * MiB;
constexpr size_t WS_END = 494 * MiB;
constexpr size_t RT_CLS = 0, RT_WTS = 147456, RT_CNT = RT_WTS + 294912, RT_TOK = RT_CNT + 24576, RT_WPOS = RT_TOK + 172032;
constexpr int CW_BAR = 4096, CW_Q = 8192;

constexpr int SCRATCH_BYTES = 155648;
constexpr int MISC_OFF = SCRATCH_BYTES;
constexpr int LDS_BYTES = SCRATCH_BYTES + 256;

#define GAS __attribute__((address_space(1)))
#define LAS __attribute__((address_space(3)))
typedef unsigned short bf16_t;
typedef short bf16x8 __attribute__((ext_vector_type(8)));
typedef short s16x4 __attribute__((ext_vector_type(4)));
typedef float f32x4 __attribute__((ext_vector_type(4)));
typedef float f32x16 __attribute__((ext_vector_type(16)));
typedef unsigned u32x4 __attribute__((ext_vector_type(4)));
typedef unsigned u32x2 __attribute__((ext_vector_type(2)));
typedef float f32x2_t __attribute__((ext_vector_type(2)));
typedef __bf16 bf16x2_t __attribute__((ext_vector_type(2)));
typedef GAS unsigned gu32;

__device__ __forceinline__ unsigned pk2(float lo, float hi) { f32x2_t v = {lo, hi}; bf16x2_t b = __builtin_convertvector(v, bf16x2_t); return __builtin_bit_cast(unsigned, b); }
__device__ __forceinline__ unsigned short f2bf(float f) { return (unsigned short)(pk2(f, 0.f) & 0xffffu); }
__device__ __forceinline__ float bflo(unsigned u) { return __uint_as_float(u << 16); }
__device__ __forceinline__ float bfhi(unsigned u) { return __uint_as_float(u & 0xffff0000u); }
__device__ __forceinline__ float bf2f(unsigned short u) { return __uint_as_float(((unsigned)u) << 16); }
template <int CTRL, int ROWMASK = 0xf> __device__ __forceinline__ float dppf(float v) { return __int_as_float(__builtin_amdgcn_update_dpp(0, __float_as_int(v), CTRL, ROWMASK, 0xf, false)); }
template <int M> __device__ __forceinline__ float xorl(float v) {
    if constexpr (M == 1) return dppf<0xB1>(v);
    else if constexpr (M == 2) return dppf<0x4E>(v);
    else if constexpr (M == 32) { const auto rr = __builtin_amdgcn_permlane32_swap(__float_as_uint(v), __float_as_uint(v), false, false);
        const unsigned a = rr[0], b = rr[1]; const unsigned own = __float_as_uint(v); return __uint_as_float(a == own ? b : a) ; }
    else return __int_as_float(__builtin_amdgcn_ds_swizzle(__float_as_int(v), 0x1F | (M << 10)));
}
__device__ __forceinline__ float rdlane(float v, int l) { return __int_as_float(__builtin_amdgcn_readlane(__float_as_int(v), l)); }
__device__ __forceinline__ float wave_sum(float v) {
    v += dppf<0xB1>(v); v += dppf<0x4E>(v); v += dppf<0x141>(v); v += dppf<0x140>(v);
    const float r0 = rdlane(v, 0), r1 = rdlane(v, 16), r2 = rdlane(v, 32), r3 = rdlane(v, 48);
    return (r0 + r1) + (r2 + r3);
}
__device__ __forceinline__ float lane_get(float v, int idx) { return __int_as_float(__builtin_amdgcn_ds_bpermute(idx << 2, __float_as_int(v))); }
__device__ __forceinline__ int lane_geti(int v, int idx) { return __builtin_amdgcn_ds_bpermute(idx << 2, v); }
__device__ __forceinline__ float sigmoidf_(float x) { return 1.f / (1.f + __expf(-x)); }
__device__ __forceinline__ float siluf_(float x) { return x / (1.f + __expf(-x)); }
__device__ __forceinline__ int opaque_tid(int wave_s) { int l; asm volatile("v_mbcnt_lo_u32_b32 %0, -1, 0\n\tv_mbcnt_hi_u32_b32 %0, -1, %0" : "=v"(l)); return (wave_s << 6) | l; }
#define LDS_WAIT() asm volatile("s_waitcnt lgkmcnt(0)" ::: "memory")
#define VM_WAIT() asm volatile("s_waitcnt vmcnt(0)" ::: "memory")

__device__ __forceinline__ int wave_row0(int bid, int w) { return bid * ROWS_PER_WG + w * ROWS_PER_WAVE; }
__device__ __forceinline__ bool row_is_ctx(int r) { return (r % LT) < CTXL; }

#define XB_TMO      128
#define XB_XCNT(j)  (256  + 64 * (j))
#define XB_XSUB(j)  (1280 + 64 * (j))
#define XB_XGEN(j)  (2304 + 64 * (j))
#define XB_TOP      3328
#define XB_TOPGEN   3392
#define XCD_BAR_WORDS 3456
#define XB_SPIN_CAP (1u << 22)

__device__ __forceinline__ unsigned xb_ld(unsigned* p)              { return __hip_atomic_load(p, __ATOMIC_RELAXED, __HIP_MEMORY_SCOPE_AGENT); }
__device__ __forceinline__ unsigned xb_add(unsigned* p, unsigned v) { return __hip_atomic_fetch_add(p, v, __ATOMIC_RELAXED, __HIP_MEMORY_SCOPE_AGENT); }
__device__ __forceinline__ unsigned xb_xcc_id() { return (unsigned)__builtin_amdgcn_s_getreg((3 << 11) | 20) & 0xFu; }
#define XB_SPIN(cond, bar) do { unsigned _sp = 0; while (cond) { __builtin_amdgcn_s_sleep(1); \
    if ((++_sp & 255u) == 0u) { if (xb_ld(&(bar)[XB_TMO])) break; if (_sp > XB_SPIN_CAP) { atomicAdd(&(bar)[XB_TMO], 1u); break; } } } } while (0)

struct XcdBarrier { unsigned* bar; volatile LAS unsigned* st; };

__device__ __forceinline__ XcdBarrier xcd_barrier_post(unsigned* bar, volatile LAS unsigned* st, int tid) {
    XcdBarrier b; b.bar = bar; b.st = st;
    if (tid == 0) (void)xb_add(&bar[XB_XCNT(xb_xcc_id())], 1u);
    return b;
}
__device__ __forceinline__ void xcd_barrier_complete(unsigned* bar, unsigned x, unsigned& nloc, unsigned& nx) {
    const unsigned G = gridDim.x * gridDim.y * gridDim.z;
    unsigned sum, cnt, mine, sp = 0u;
    for (;;) {
        sum = 0u; cnt = 0u; mine = 0u;
#pragma unroll
        for (unsigned j = 0; j < 16; ++j) { const unsigned c = xb_ld(&bar[XB_XCNT(j)]); sum += c; cnt += (c > 0u) ? 1u : 0u; mine = (j == x) ? c : mine; }
        if (sum == G) break;
        __builtin_amdgcn_s_sleep(1);
        if ((++sp & 255u) == 0u) { if (xb_ld(&bar[XB_TMO])) break; if (sp > XB_SPIN_CAP) { atomicAdd(&bar[XB_TMO], 1u); break; } }
    }
    nloc = mine > 0u ? mine : 1u; nx = cnt > 0u ? cnt : 1u;
}
__device__ __forceinline__ void xcd_barrier(const XcdBarrier& b, int tid) {
    asm volatile("s_waitcnt vmcnt(0)" ::: "memory");
    __syncthreads();
    if (tid == 0) {
        unsigned* bar = b.bar; const unsigned bx = xb_xcc_id();
        __builtin_amdgcn_s_waitcnt(0);
        unsigned nloc = b.st[0], nx = b.st[1];
        if (nloc == 0u) { xcd_barrier_complete(bar, bx, nloc, nx); b.st[0] = nloc; b.st[1] = nx; }
        const unsigned old = xb_add(&bar[XB_XSUB(bx)], 1u);
        const unsigned gen = old / nloc;
        if (old + 1u == (gen + 1u) * nloc) {
            __builtin_amdgcn_fence(__ATOMIC_RELEASE, "agent");
            asm volatile("s_waitcnt vmcnt(0)" ::: "memory");
            const unsigned og = xb_add(&bar[XB_TOP], 1u);
            const unsigned tg = og / nx;
            if (og + 1u == (tg + 1u) * nx) xb_add(&bar[XB_TOPGEN], 1u);
            else XB_SPIN(xb_ld(&bar[XB_TOPGEN]) == tg, bar);
            __builtin_amdgcn_fence(__ATOMIC_ACQUIRE, "agent");
            xb_add(&bar[XB_XGEN(bx)], 1u);
            asm volatile("s_waitcnt vmcnt(0)" ::: "memory");
        } else {
            XB_SPIN(xb_ld(&bar[XB_XGEN(bx)]) == gen, bar);
            __builtin_amdgcn_fence(__ATOMIC_ACQUIRE, "agent");
            asm volatile("s_waitcnt vmcnt(0)" ::: "memory");
        }
    }
    __syncthreads();
}

struct Params { const float* in[39]; float* out; unsigned char* ws; };
enum { I_X = 0, I_C, I_CTX, I_CCTX, I_ADAW, I_ADAB, I_NMIX, I_NFFN, I_EVWIN, I_EVWOUT, I_MLGB, I_MLNORM, I_QNORM, I_KNORM, I_ODWIN, I_ODWOUT,
       I_S5ARE, I_S5AIM, I_S5LDT, I_S5BRE, I_S5BIM, I_S5CRE, I_S5CIM, I_S5D, I_GLUW, I_GLUB, I_CONVW, I_CONVB, I_DTB, I_ALOG, I_SSDD, I_SSDNORM,
       I_GRW, I_GRB, I_ERW, I_ERB, I_WG, I_WU, I_WD };

struct Frame {
    LAS unsigned char* lds; volatile LAS unsigned* MISC; gu32* ctl;
    int tid, lane, wave, vcu, G, bid, wave_s;
    const Params* p; unsigned char* ws;
};
__device__ __forceinline__ bf16_t* xr_row(const Frame& F, int r) { return (bf16_t*)(F.ws + WS_XR) + (size_t)r * D; }
__device__ __forceinline__ const float* xin_row(const Frame& F, int r) {
    const int b = r / LT, p = r % LT;
    return p < CTXL ? F.p->in[I_CTX] + ((size_t)(b * CTXL + p)) * D : F.p->in[I_X] + ((size_t)(b * SEQ + p - CTXL)) * D;
}
__device__ __forceinline__ int q_next(Frame& F, int q) {
    __syncthreads();
    if (F.tid == 0) F.MISC[16] = __hip_atomic_fetch_add((unsigned*)(F.ctl + CW_Q + 64 * q), 1u, __ATOMIC_RELAXED, __HIP_MEMORY_SCOPE_AGENT);
    __syncthreads();
    return (int)F.MISC[16];
}

__device__ __forceinline__ void tr_item(const float* src, int ldw, int k0, int c0, bf16_t* dst, size_t dp, int r0, int kd0, LAS float* scr, int lane) {
    f32x4 v[8];
#pragma unroll
    for (int i = 0; i < 8; ++i) { const int kk = (lane >> 3) + 8 * i; v[i] = *(const GAS f32x4*)(src + (size_t)(k0 + kk) * ldw + c0 + 4 * (lane & 7)); }
#pragma unroll
    for (int i = 0; i < 8; ++i) { const int kk = (lane >> 3) + 8 * i; LAS float* d = scr + kk * 33 + 4 * (lane & 7); d[0] = v[i].x; d[1] = v[i].y; d[2] = v[i].z; d[3] = v[i].w; }
    LDS_WAIT(); asm volatile("" ::: "memory");
    const int c = lane & 7;
#pragma unroll
    for (int j = 0; j < 4; ++j) { const int n = (lane >> 3) + 8 * j; const LAS float* s = scr + (8 * c) * 33 + n;
        u32x4 o; o.x = pk2(s[0 * 33], s[1 * 33]); o.y = pk2(s[2 * 33], s[3 * 33]); o.z = pk2(s[4 * 33], s[5 * 33]); o.w = pk2(s[6 * 33], s[7 * 33]);
        *(GAS u32x4*)(dst + (size_t)(r0 + n) * dp + kd0 + 8 * c) = o; }
    LDS_WAIT(); asm volatile("" ::: "memory");
}
constexpr int TRL0 = 16 * 89 + 512 + 16 * 768, TRL1 = 16 * 65 + 512 + 8 * 16 + 16 * 768;
__device__ __forceinline__ void tr_moe_item(Frame& F, int l, int r, LAS float* scr) {
    const Params& P = *F.p; constexpr int IM = 768;
    const int e = r / IM, q = r % IM;
    if (q < 512) {
        const int up = q >> 8, qq = q & 255, kb = qq / 16, nb = qq % 16, n0 = nb * 32, blk = n0 >> 7, within = n0 & 127;
        const float* src = P.in[up ? I_WU : I_WG] + ((size_t)(l * 16 + e)) * 1024 * 512;
        bf16_t* dst = (bf16_t*)(F.ws + (l ? WS_GU1 : WS_GU0)) + (size_t)e * 1024 * 1024;
        tr_item(src, 512, kb * 64, n0, dst, 1024, blk * 256 + up * 128 + within, kb * 64, scr, F.lane);
    } else {
        const int qq = q - 512, kb = qq / 32, nb = qq % 32;
        const float* src = P.in[I_WD] + ((size_t)(l * 16 + e)) * 512 * 1024;
        tr_item(src, 1024, kb * 64, nb * 32, (bf16_t*)(F.ws + (l ? WS_D1 : WS_D0)) + (size_t)e * 1024 * 512, 512, nb * 32, kb * 64, scr, F.lane);
    }
}
template <int LIST> __device__ __forceinline__ void tr_list_range(Frame& F, int lo, int hi, int slot, int nslots) {
    const Params& P = *F.p;
    LAS float* scr = (LAS float*)(F.lds + F.wave * 16384);
    for (int it = lo + slot; it < hi; it += nslots) {
        int r = it;
        if (LIST == 0) {
            constexpr int I0 = 16 * 89, I1 = 512;
            if (r < I0) { const int kb = r / 89, nb = r % 89, n0 = nb * 32; tr_item(P.in[I_EVWIN], 2832, kb * 64, nb == 88 ? 2048 : n0 + (n0 >= 2048 ? 16 : 0), (bf16_t*)(F.ws + WS_WIN0), 1024, n0, kb * 64, scr, F.lane); continue; } r -= I0;
            if (r < I1) { const int kb = r / 32, nb = r % 32; tr_item(P.in[I_EVWOUT], 1024, kb * 64, nb * 32, (bf16_t*)(F.ws + WS_WOUT0), 1024, nb * 32, kb * 64, scr, F.lane); continue; } r -= I1;
            tr_moe_item(F, 0, r, scr);
        } else {
            constexpr int I2 = 16 * 65, I3 = 512, I4 = 8 * 16;
            if (r < I2) { const int kb = r / 65, nb = r % 65; tr_item(P.in[I_ODWIN], 2064, kb * 64, nb == 64 ? 2032 : nb * 32, (bf16_t*)(F.ws + WS_WIN1), 1024, nb * 32, kb * 64, scr, F.lane); continue; } r -= I2;
            if (r < I3) { const int kb = r / 32, nb = r % 32; tr_item(P.in[I_ODWOUT], 1024, kb * 64, nb * 32, (bf16_t*)(F.ws + WS_WOUT1), 1024, nb * 32, kb * 64, scr, F.lane); continue; } r -= I3;
            if (r < I4) { const int kb = r / 16, nb = r % 16; tr_item(P.in[I_GLUW], 512, kb * 64, nb * 32, (bf16_t*)(F.ws + WS_WGLU), 512, nb * 32, kb * 64, scr, F.lane); continue; } r -= I4;
            tr_moe_item(F, 1, r, scr);
        }
    }
}
__device__ __forceinline__ void p0_prologue(Frame& F) {
    const Params& P = *F.p;
    if (F.bid < 192) {
        const int l = F.bid / 96, cb = F.bid % 96;
        LAS float* sc = (LAS float*)F.lds;
        LAS float* red = (LAS float*)(F.lds + 17 * 1024 * 4);
        {
#pragma unroll 1
            for (int h = 0; h < 2; ++h) {
                float cv[17];
#pragma unroll
                for (int u = 0; u < 17; ++u) { const int i = F.tid + (17 * h + u) * NTHREADS; const int m = i >> 10, k = i & 1023; cv[u] = m < 16 ? P.in[I_C][m * 1024 + k] : P.in[I_CCTX][k]; }
#pragma unroll
                for (int u = 0; u < 17; ++u) sc[F.tid + (17 * h + u) * NTHREADS] = siluf_(cv[u]);
            }
        }
        __syncthreads();
        const int kq = F.tid >> 6, col = F.tid & 63;
        float acc[17];
#pragma unroll
        for (int m = 0; m < 17; ++m) acc[m] = 0.f;
        const float* w = P.in[I_ADAW] + (size_t)l * 1024 * 6144 + cb * 64 + col;
#pragma unroll 1
        for (int k0 = kq; k0 < 1024; k0 += 128) {
            float wv[16];
#pragma unroll
            for (int u = 0; u < 16; ++u) wv[u] = w[(size_t)(k0 + 8 * u) * 6144];
#pragma unroll
            for (int u = 0; u < 16; ++u) {
#pragma unroll
                for (int m = 0; m < 17; ++m) acc[m] += sc[m * 1024 + k0 + 8 * u] * wv[u];
                if ((u & 1) == 1) __builtin_amdgcn_sched_barrier(0); }
        }
#pragma unroll
        for (int m = 0; m < 17; ++m) red[(kq * 17 + m) * 64 + col] = acc[m];
        __syncthreads();
        for (int i = F.tid; i < 17 * 64; i += NTHREADS) { const int m = i >> 6, c2 = i & 63; float s = 0.f;
#pragma unroll
            for (int q = 0; q < 8; ++q) s += red[(q * 17 + m) * 64 + c2];
            ((float*)(F.ws + WS_MOD))[((size_t)l * 17 + m) * 6144 + cb * 64 + c2] = s + P.in[I_ADAB][l * 6144 + cb * 64 + c2]; }
        __syncthreads();
    }
    {
        u32x4* z0 = (u32x4*)(F.ws + WS_WIN0 + (size_t)2848 * 2048); u32x4* z1 = (u32x4*)(F.ws + WS_WIN1 + (size_t)2080 * 2048);
        const int n16 = 224 * 2048 / 16; const u32x4 zz = (u32x4){0u, 0u, 0u, 0u};
        for (int i = F.bid * NTHREADS + F.tid; i < n16; i += F.G * NTHREADS) { z0[i] = zz; z1[i] = zz; }
    }
    tr_list_range<0>(F, 0, TRL0, F.vcu * NWAVES + F.wave, F.G * NWAVES);
    tr_list_range<1>(F, 0, TRL1, F.vcu * NWAVES + F.wave, F.G * NWAVES);
}

#ifndef NPD
#define NPD 3
#endif
#ifndef NPD0
#define NPD0 3
#endif
template <int MODE> __device__ __forceinline__ void norm_phase(Frame& F) {
    const Params& P = *F.p;
    constexpr int NS = (MODE == 0) ? 0 : (MODE == 2 ? 16 : 20);
    constexpr int layer = (MODE >= 2) ? 1 : 0;
    constexpr bool ROUTER = (MODE == 1 || MODE == 3);
    LAS f32x4* Wsm = (LAS f32x4*)F.lds;
    LAS int* cnt = (LAS int*)(F.lds + 4 * NS * 64 * 16);
    LAS f32x4* ABm = (LAS f32x4*)(F.lds + 4 * NS * 64 * 16 + 256);
    if constexpr (NS > 0) {
        LAS float* Wf = (LAS float*)F.lds;
        constexpr int NQ = NS / 4, NLD = 1024 * NQ / NTHREADS;
        f32x4 vv[NLD];
#pragma unroll
        for (int u = 0; u < NLD; ++u) { const int f = F.tid + u * NTHREADS; const int qd = f >> 10, k = f & 1023;
            if (MODE == 2) vv[u] = *(const f32x4*)(P.in[I_ODWIN] + (size_t)k * 2064 + 2048 + 4 * qd);
            else vv[u] = (qd == 0) ? *(const f32x4*)(P.in[I_GRW] + (size_t)layer * 4096 + k * 4) : *(const f32x4*)(P.in[I_ERW] + (size_t)layer * 16384 + k * 16 + 4 * (qd - 1)); }
#pragma unroll
        for (int u = 0; u < NLD; ++u) { const int f = F.tid + u * NTHREADS; const int qd = f >> 10, k = f & 1023;
            const int j = k >> 8, ln = (k & 255) >> 2, e = k & 3;
#pragma unroll
            for (int c = 0; c < 4; ++c) Wf[((j * NS + 4 * qd + c) * 64 + ln) * 4 + e] = vv[u][c]; }
    }
    if (F.tid < 32) cnt[F.tid] = 0;
    constexpr bool DEAL = (MODE == 2);
    const int rw0 = F.bid * ROWS_PER_WG;
    const int m_first = DEAL ? 16 : (((rw0 % LT) < CTXL) ? 16 : rw0 / LT);
    {
        const float* gain_ = P.in[(MODE == 1 || MODE == 3) ? I_NFFN : I_NMIX] + ((MODE >= 2) ? 1 : 0) * 1024;
        const float* mod_ = (const float*)(F.ws + WS_MOD) + (size_t)((MODE >= 2) ? 1 : 0) * 17 * 6144;
        constexpr int SH_ = (MODE == 1 || MODE == 3) ? 3072 : 0, SC_ = (MODE == 1 || MODE == 3) ? 4096 : 1024;
        const int rl = rw0 + ROWS_PER_WG - 1; const int m_last = DEAL ? (F.bid >> 4) : (((rl % LT) < CTXL) ? 16 : rl / LT);
        { const int slot = F.tid >> 8, i4 = F.tid & 255; const int m = slot ? m_last : m_first;
          const f32x4 g = ((const f32x4*)gain_)[i4], s2 = ((const f32x4*)(mod_ + m * 6144 + SC_))[i4], b2 = ((const f32x4*)(mod_ + m * 6144 + SH_))[i4];
          ABm[(slot * 2 + 0) * 256 + i4] = g * (s2 + 1.0f); ABm[(slot * 2 + 1) * 256 + i4] = b2; }
    }
    __syncthreads();
    const float* gain = P.in[ROUTER ? I_NFFN : I_NMIX] + layer * 1024;
    const float* mod = (const float*)(F.ws + WS_MOD) + (size_t)layer * 17 * 6144;
    constexpr int SH = ROUTER ? 3072 : 0, SC = ROUTER ? 4096 : 1024;
    constexpr int NE0 = ROUTER ? 4 : 0;
    bf16_t* HB = (bf16_t*)(F.ws + WS_HB);
    int cur = -1; f32x4 Av[4], Bv[4];
    const int r0 = wave_row0(F.bid, F.wave);
    const int rA = DEAL ? (F.bid >> 4) * LT + 16 * (F.bid & 15) + 2 * F.wave : r0;
    const int rB = DEAL ? (F.bid >> 4) * LT + CTXL + 128 * (F.bid & 15) + 16 * F.wave : r0 + 2;
    auto rowof = [&](int i) -> int { return i < 2 ? rA + i : rB + i - 2; };
    constexpr int PD = (MODE == 0) ? NPD0 : NPD;
    f32x4 nx[PD][4]; u32x2 nb[PD][4];
    auto ldrow = [&](int r, f32x4 (&a)[4], u32x2 (&bq)[4]) {
        if (MODE == 0) { const float* src = xin_row(F, r);
#pragma unroll
            for (int j = 0; j < 4; ++j) a[j] = ((const GAS f32x4*)src)[64 * j + F.lane]; }
        else { const bf16_t* src = xr_row(F, r);
#pragma unroll
            for (int j = 0; j < 4; ++j) bq[j] = ((const GAS u32x2*)src)[64 * j + F.lane]; } };
#pragma unroll
    for (int q = 0; q < PD; ++q) ldrow(rowof(q), nx[q], nb[q]);
    auto rowbody = [&](const int q, const int ri, const bool pre) {
        const int r = rowof(ri); const int b = r / LT; const bool isctx = (r % LT) < CTXL;
        f32x4 v[4];
#pragma unroll
        for (int j = 0; j < 4; ++j) { if (MODE == 0) v[j] = nx[q][j]; else v[j] = (f32x4){bflo(nb[q][j].x), bfhi(nb[q][j].x), bflo(nb[q][j].y), bfhi(nb[q][j].y)}; }
        if (pre) ldrow(rowof(ri + PD), nx[q], nb[q]);
        if (MODE == 3 && isctx) return;
        const int m = isctx ? 16 : b;
        if (m != cur) { cur = m; const int slot = (m == m_first) ? 0 : 1;
#pragma unroll
            for (int j = 0; j < 4; ++j) { Av[j] = ABm[(slot * 2 + 0) * 256 + 64 * j + F.lane]; Bv[j] = ABm[(slot * 2 + 1) * 256 + 64 * j + F.lane]; } }
        float ss = 0.f;
#pragma unroll
        for (int j = 0; j < 4; ++j) ss += (v[j].x * v[j].x + v[j].y * v[j].y) + (v[j].z * v[j].z + v[j].w * v[j].w);
        const float rstd = rsqrtf(wave_sum(ss) * (1.f / D) + NORM_EPS);
#pragma unroll
        for (int j = 0; j < 4; ++j) v[j] = v[j] * rstd * Av[j] + Bv[j];
        GAS u32x2* o8 = (GAS u32x2*)(HB + (size_t)r * D) + F.lane;
#pragma unroll
        for (int j = 0; j < 4; ++j) { u32x2 w; w.x = pk2(v[j].x, v[j].y); w.y = pk2(v[j].z, v[j].w); o8[64 * j] = w; }
        if constexpr (NS > 0) {
        auto coldot = [&](int n) -> float { f32x2_t a2 = {0.f, 0.f};
#pragma unroll
            for (int j = 0; j < 4; ++j) { const f32x4 w = Wsm[(j * NS + n) * 64 + F.lane];
                a2 = __builtin_elementwise_fma((f32x2_t){v[j].x, v[j].y}, (f32x2_t){w.x, w.y}, a2); a2 = __builtin_elementwise_fma((f32x2_t){v[j].z, v[j].w}, (f32x2_t){w.z, w.w}, a2); }
            return a2.x + a2.y; };
        auto reduce4 = [&](float (&p)[4]) {
            const bool b3 = F.lane & 8, b2 = F.lane & 4;
            float t2[2];
#pragma unroll
            for (int i = 0; i < 2; ++i) { const float keep = b3 ? p[i + 2] : p[i], send = b3 ? p[i] : p[i + 2]; t2[i] = keep + dppf<0x140>(send); }
            float e; { const float keep = b2 ? t2[1] : t2[0], send = b2 ? t2[0] : t2[1]; e = keep + dppf<0x141>(send); }
            e += dppf<0xB1>(e); e += dppf<0x4E>(e);
            e += xorl<16>(e); e += xorl<32>(e);
#pragma unroll
            for (int i = 0; i < 4; ++i) p[i] = rdlane(e, 4 * i);
        };
        if constexpr (!ROUTER) {
        if (isctx) {
        float a16[16];
#pragma unroll
        for (int g4 = 0; g4 < NS / 4; ++g4) {
#pragma unroll
            for (int q = 0; q < 4; ++q) a16[4 * g4 + q] = coldot(4 * g4 + q);
            asm volatile("" ::: "memory");
        }
        float e16;
        {
            const bool b5 = F.lane & 32, b4 = F.lane & 16, b3 = F.lane & 8, b2 = F.lane & 4;
            float t8[8], t4[4], t2[2];
#pragma unroll
            for (int i = 0; i < 8; ++i) { const float keep = b5 ? a16[i + 8] : a16[i], send = b5 ? a16[i] : a16[i + 8]; t8[i] = keep + xorl<32>(send); }
#pragma unroll
            for (int i = 0; i < 4; ++i) { const float keep = b4 ? t8[i + 4] : t8[i], send = b4 ? t8[i] : t8[i + 4]; t4[i] = keep + xorl<16>(send); }
#pragma unroll
            for (int i = 0; i < 2; ++i) { const float keep = b3 ? t4[i + 2] : t4[i], send = b3 ? t4[i] : t4[i + 2]; t2[i] = keep + xorl<8>(send); }
            { const float keep = b2 ? t2[1] : t2[0], send = b2 ? t2[0] : t2[1]; e16 = keep + xorl<4>(send); }
            e16 += xorl<2>(e16); e16 += xorl<1>(e16);
        }
            if ((F.lane & 3) == 0) ((float*)(F.ws + WS_GATES))[(size_t)r * 16 + (F.lane >> 2)] = e16;
        }
        } else {
            float grp[4];
#pragma unroll
            for (int n = 0; n < 4; ++n) grp[n] = coldot(n);
            reduce4(grp);
            const float* grb = P.in[I_GRB] + layer * 4; const float* erb = P.in[I_ERB] + layer * 16;
            float gl[4]; int gi = 0; float gm = -1e30f;
#pragma unroll
            for (int n = 0; n < 4; ++n) { gl[n] = grp[n] + grb[n]; if (gl[n] > gm) { gm = gl[n]; gi = n; } }
            float gs = 0.f;
#pragma unroll
            for (int n = 0; n < 4; ++n) gs += __expf(gl[n] - gm);
            const float gp = 1.f / gs;
            float el[4];
#pragma unroll
            for (int n = 0; n < 4; ++n) el[n] = 0.f;
            {
                const int gis = __builtin_amdgcn_readfirstlane(gi);
                if (gis == 0) { _Pragma("unroll") for (int n = 0; n < 4; ++n) el[n] = coldot(4 + n); }
                else if (gis == 1) { _Pragma("unroll") for (int n = 0; n < 4; ++n) el[n] = coldot(8 + n); }
                else if (gis == 2) { _Pragma("unroll") for (int n = 0; n < 4; ++n) el[n] = coldot(12 + n); }
                else { _Pragma("unroll") for (int n = 0; n < 4; ++n) el[n] = coldot(16 + n); }
            }
            reduce4(el);
#pragma unroll
            for (int n = 0; n < 4; ++n) el[n] += erb[4 * gi + n];
            int i0 = 0; float v0 = el[0];
#pragma unroll
            for (int n = 1; n < 4; ++n) if (el[n] > v0) { v0 = el[n]; i0 = n; }
            int i1 = -1; float v1 = -1e30f;
#pragma unroll
            for (int n = 0; n < 4; ++n) if (n != i0 && el[n] > v1) { v1 = el[n]; i1 = n; }
            const float e1 = __expf(v1 - v0); const float w0 = gp / (1.f + e1), w1 = gp * e1 / (1.f + e1);
            const int ea = i0 < i1 ? i0 : i1, eb = i0 < i1 ? i1 : i0; const float wa = i0 < i1 ? w0 : w1, wb = i0 < i1 ? w1 : w0;
            const int pidx = (ea == 0) ? (eb - 1) : (ea == 1 ? eb + 1 : 5);
            const int cls = gi * 6 + pidx;
            if (F.lane == 0) {
                ((int*)(F.ws + WS_ROUTE + RT_CLS))[r] = cls;
                ((float*)(F.ws + WS_ROUTE + RT_WTS))[2 * (size_t)r] = wa; ((float*)(F.ws + WS_ROUTE + RT_WTS))[2 * (size_t)r + 1] = wb;
                atomicAdd((int*)&cnt[cls], 1);
            }
        }
        }
    };
#pragma unroll 1
    for (int rb = 0; rb + PD < ROWS_PER_WAVE; rb += PD) {
#pragma unroll
        for (int q = 0; q < PD; ++q) rowbody(q, rb + q, true);
    }
#pragma unroll
    for (int q = 0; q < PD; ++q) rowbody(q, ROWS_PER_WAVE - PD + q, false);
    if (ROUTER) {
        __syncthreads();
        if (F.tid < NCLS) ((int*)(F.ws + WS_ROUTE + RT_CNT))[F.bid * NCLS + F.tid] = cnt[F.tid];
    }
}

struct MoeTab { LAS int* base; LAS int* tot; LAS int* mine; LAS int* ntile; };
__device__ __forceinline__ MoeTab moe_tables(Frame& F, LAS unsigned char* at, bool with_mine) {
    MoeTab T; T.base = (LAS int*)at; T.tot = T.base + 32; T.mine = T.tot + 32; T.ntile = T.mine + 32;
    const int* cnt = (const int*)(F.ws + WS_ROUTE + RT_CNT);
    LAS int* part = T.ntile + 32;
    __syncthreads();
    { const int c = F.tid & 31, pt = F.tid >> 5; int t = 0, m = 0;
      if (c < NCLS) {
#pragma unroll
          for (int i = 0; i < 16; ++i) { const int w = pt * 16 + i; const int v = cnt[w * NCLS + c]; t += v; m += (w < F.bid) ? v : 0; } }
      part[(pt * 2 + 0) * 32 + c] = t; part[(pt * 2 + 1) * 32 + c] = m; }
    __syncthreads();
    if (F.tid < NCLS) { int t = 0, m = 0; for (int pt = 0; pt < 16; ++pt) { t += part[(pt * 2 + 0) * 32 + F.tid]; m += part[(pt * 2 + 1) * 32 + F.tid]; } T.tot[F.tid] = t; T.mine[F.tid] = m; }
    __syncthreads();
    if (F.tid == 0) { int pos = 0; for (int c = 0; c < NCLS; ++c) { T.base[c] = pos; pos += ((T.tot[c] + 255) >> 8) << 8; } T.ntile[0] = pos >> 8; }
    __syncthreads();
    (void)with_mine;
    return T;
}
__device__ __forceinline__ void cls_experts(int cls, int& ea, int& eb) {
    const int g = cls / 6, pi = cls % 6; int a, b;
    if (pi < 3) { a = 0; b = pi + 1; } else if (pi < 5) { a = 1; b = pi - 1; } else { a = 2; b = 3; }
    ea = g * 4 + a; eb = g * 4 + b;
}
template <int LAYER> __device__ __forceinline__ void route_phase(Frame& F) {
    MoeTab T = moe_tables(F, F.lds, true);
    LAS int* posr = (LAS int*)(F.lds + 8192);
    const int* clsg = (const int*)(F.ws + WS_ROUTE + RT_CLS);
    int* tok = (int*)(F.ws + WS_ROUTE + RT_TOK); float* wpos = (float*)(F.ws + WS_ROUTE + RT_WPOS); const float* wts = (const float*)(F.ws + WS_ROUTE + RT_WTS);
    if (F.wave == 0) {
        int run = 0;
        for (int q = 0; q < 3; ++q) {
            const int i = q * 64 + F.lane; int cls = -1;
            if (i < ROWS_PER_WG) { const int r = wave_row0(F.bid, i / ROWS_PER_WAVE) + i % ROWS_PER_WAVE; if (!(LAYER == 1 && row_is_ctx(r))) cls = clsg[r]; }
            int mypos = -1;
            for (int c = 0; c < NCLS; ++c) {
                const unsigned long long mask = __ballot(cls == c);
                const int rank = __popcll(mask & ((1ull << F.lane) - 1ull));
                const int runc = __builtin_amdgcn_readlane(run, c);
                if (cls == c) mypos = T.base[c] + T.mine[c] + runc + rank;
                if (F.lane == c) run += __popcll(mask);
            }
            if (i < ROWS_PER_WG) posr[i] = mypos;
        }
    }
    __syncthreads();
    for (int i = F.tid; i < ROWS_PER_WG; i += NTHREADS) { const int pos = posr[i];
        if (pos >= 0) { const int r = wave_row0(F.bid, i / ROWS_PER_WAVE) + i % ROWS_PER_WAVE; tok[pos] = r; wpos[2 * (size_t)pos] = wts[2 * (size_t)r]; wpos[2 * (size_t)pos + 1] = wts[2 * (size_t)r + 1]; } }
    if (F.bid < NCLS) {
        const int c = F.bid, lo = T.base[c] + T.tot[c], hi = T.base[c] + (((T.tot[c] + 255) >> 8) << 8);
        for (int p = lo + F.tid; p < hi; p += NTHREADS) { tok[p] = -1; wpos[2 * (size_t)p] = 0.f; wpos[2 * (size_t)p + 1] = 0.f; }
    }
}
namespace pg8 {
constexpr int BM = 256, BK = 64, HALF = 128, HTB = HALF * BK * 2, STAGE_BYTES = 8 * HTB;
__host__ __device__ __forceinline__ int lds_byte(int r, int c) { const int st = (r >> 4) * 2 + (c >> 5), rr = r & 15, cc = c & 31, ob = rr * 64 + cc * 2; return st * 1024 + (ob ^ (((ob >> 9) & 1) << 5)); }
__host__ __device__ __forceinline__ void stage_rc(int b, int& R_, int& C_) { const int st = b / 1024, sb = b % 1024, swz = sb ^ (((sb >> 9) & 1) << 5); R_ = (st >> 1) * 16 + swz / 64; C_ = (st & 1) * 32 + (swz % 64) / 2; }
__host__ __device__ __forceinline__ int perm32(int rho) { const int n = rho >> 4, i = rho & 15; return 8 * (i >> 2) + 4 * n + (i & 3); }

struct Unit { const char* a; const char* b; int bdelta; int pm, pn, aux; const int* rows; };
struct Gemm { int pitchA, pitchB, K; };

template <class Epi, class Sched, bool ALIGN_EPI, bool GATHER = false>
__device__ __forceinline__ void gemm_phase(LAS unsigned char* lds, const Gemm g, const Sched& S, const Epi& E, int wave_s) {
    const int tid = opaque_tid(wave_s), wid = __builtin_amdgcn_readfirstlane(tid >> 6), lane = tid & 63, wr = wid >> 2, wc = wid & 3, fr = lane & 15, fq = lane >> 4;
    const int K = g.K, nt = K / BK;
    unsigned voffA[2], voffB[2]; int RA[2], CA[2];
#pragma unroll
    for (int i = 0; i < 2; ++i) { int R_, C_; stage_rc(tid * 16 + i * 8192, R_, C_); const int Rb = Epi::PERM ? ((R_ & ~31) + perm32(R_ & 31)) : R_; RA[i] = R_; CA[i] = C_;
        voffA[i] = (unsigned)(R_ * g.pitchA + C_) * 2u; voffB[i] = (unsigned)(Rb * g.pitchB + C_) * 2u; }
    unsigned gC[2][2], gN[2][2];
    auto gload = [&](const Unit& u, unsigned (&go)[2][2]) {
#pragma unroll
        for (int h = 0; h < 2; ++h)
#pragma unroll
            for (int i = 0; i < 2; ++i) { int r = u.rows[h * HALF + RA[i]]; r = r < 0 ? 0 : r; go[h][i] = (unsigned)(r * g.pitchA + CA[i]) * 2u; } };
    const size_t kstep = (size_t)(BK * 2);
    const size_t hstepA = (size_t)HALF * g.pitchA * 2, hstepB = (size_t)HALF * g.pitchB * 2;
    const unsigned ldsw = (unsigned)wid * 1024u;
    const int aoff = lds_byte(wr * 64 + fr, fq * 8), boff = lds_byte(wc * 32 + fr, fq * 8);
#define PG8_SA(b, h) (((b) * 2 + (h)) * HTB)
#define PG8_SB(b, h) ((4 + (b) * 2 + (h)) * HTB)
#define PG8_STAGE(bufoff, gbase, voff) do { _Pragma("unroll") for (int _i = 0; _i < 2; ++_i) \
        __builtin_amdgcn_global_load_lds((const unsigned*)((const char*)(gbase) + (voff)[_i]), (LAS unsigned*)(lds + (bufoff) + ldsw + _i * 8192), 16, 0, 0); } while (0)
#define PG8_STAGE_A(bufoff, gbase, h, NX) do { if constexpr (GATHER) { _Pragma("unroll") for (int _i = 0; _i < 2; ++_i) { const unsigned _o = (NX) ? gN[h][_i] : gC[h][_i]; \
        __builtin_amdgcn_global_load_lds((const unsigned*)((const char*)(gbase) + _o), (LAS unsigned*)(lds + (bufoff) + ldsw + _i * 8192), 16, 0, 0); } } \
    else { PG8_STAGE(bufoff, (const char*)(gbase) + (h) * hstepA, voffA); } } while (0)
#define PG8_LDA(dst, b, h) do { _Pragma("unroll") for (int m = 0; m < 4; ++m) _Pragma("unroll") for (int k = 0; k < 2; ++k) dst[m][k] = *(const LAS bf16x8*)(lds + PG8_SA(b, h) + aoff + m * 2048 + k * 1024); } while (0)
#define PG8_LDB(dst, b, h) do { _Pragma("unroll") for (int n = 0; n < 2; ++n) _Pragma("unroll") for (int k = 0; k < 2; ++k) dst[n][k] = *(const LAS bf16x8*)(lds + PG8_SB(b, h) + boff + n * 2048 + k * 1024); } while (0)
#define PG8_MMA(ai, bj, At, Bt) do { __builtin_amdgcn_s_setprio(1); _Pragma("unroll") for (int m = 0; m < 4; ++m) _Pragma("unroll") for (int n = 0; n < 2; ++n) _Pragma("unroll") for (int k = 0; k < 2; ++k) \
        acc[ai][bj][m][n] = __builtin_amdgcn_mfma_f32_16x16x32_bf16(Bt[n][k], At[m][k], acc[ai][bj][m][n], 0, 0, 0); __builtin_amdgcn_s_setprio(0); } while (0)
#define PG8_WAIT_V(n) asm volatile("s_waitcnt vmcnt(" #n ")" ::: "memory")
#define PG8_WAIT_L(n) asm volatile("s_waitcnt lgkmcnt(" #n ")" ::: "memory")
#define PG8_BAR __builtin_amdgcn_s_barrier()
#define PG8_SCHED __builtin_amdgcn_sched_barrier(0)
    Unit cur, nxt; int ui = 0;
    if (!S.next(0, cur)) return;
    f32x4 acc[2][2][4][2];
#pragma unroll
    for (int a = 0; a < 2; ++a)
#pragma unroll
        for (int b = 0; b < 2; ++b)
#pragma unroll
            for (int m = 0; m < 4; ++m)
#pragma unroll
                for (int n = 0; n < 2; ++n) acc[a][b][m][n] = (f32x4){0.f, 0.f, 0.f, 0.f};
    bf16x8 At[4][2], B0[2][2], B1[2][2];
    const char* cA = cur.a; const char* cB = cur.b;
    if constexpr (GATHER) gload(cur, gC);
    PG8_STAGE(PG8_SB(0, 0), cB, voffB); PG8_STAGE(PG8_SB(0, 1), cB + hstepB, voffB); PG8_STAGE_A(PG8_SA(0, 0), cA, 0, false); PG8_STAGE_A(PG8_SA(0, 1), cA, 1, false);
    if (wr == 1) PG8_BAR;
    PG8_WAIT_V(2); PG8_BAR;
    PG8_STAGE(PG8_SB(1, 0), cB + kstep, voffB); PG8_STAGE_A(PG8_SA(1, 0), cA + kstep, 0, false); PG8_STAGE(PG8_SB(1, 1), cB + hstepB + kstep, voffB);
    PG8_WAIT_V(6); PG8_BAR;
    for (;;) {
        const bool has_next = S.next(ui + 1, nxt);
        const char* nA = has_next ? nxt.a : cA; const char* nB = has_next ? nxt.b : cB;
        if constexpr (GATHER) { if (has_next) gload(nxt, gN); else { _Pragma("unroll") for (int h = 0; h < 2; ++h) _Pragma("unroll") for (int i = 0; i < 2; ++i) gN[h][i] = gC[h][i]; } }
        const int bdelta = cur.bdelta;
        for (int t = 0; t < nt; t += 2) {
            const bool last = (t == nt - 2);
            const char* a1 = cA + (size_t)(t + 1) * kstep;
            const char* a2 = last ? nA : cA + (size_t)(t + 2) * kstep;
            const char* b2 = last ? nB : cB + (size_t)(t + 2) * kstep + ((2 * (t + 2) >= nt) ? bdelta : 0);
            const char* a3 = a2 + kstep; const char* b3 = b2 + kstep;
            PG8_LDB(B0, 0, 0); PG8_LDB(B1, 0, 1); PG8_SCHED; PG8_LDA(At, 0, 0); PG8_STAGE_A(PG8_SA(1, 1), a1, 1, false);
            PG8_WAIT_V(8); PG8_WAIT_L(0); PG8_BAR; PG8_MMA(0, 0, At, B0); PG8_MMA(0, 1, At, B1); PG8_BAR; PG8_SCHED;
            PG8_LDA(At, 0, 1); PG8_STAGE(PG8_SB(0, 0), b2, voffB); PG8_STAGE(PG8_SB(0, 1), b2 + hstepB, voffB); PG8_STAGE_A(PG8_SA(0, 0), a2, 0, last);
            PG8_WAIT_V(8); PG8_WAIT_L(0); PG8_BAR; PG8_MMA(1, 0, At, B0); PG8_MMA(1, 1, At, B1); PG8_BAR; PG8_SCHED;
            PG8_LDB(B0, 1, 0); PG8_LDB(B1, 1, 1); PG8_SCHED; PG8_LDA(At, 1, 0); PG8_STAGE_A(PG8_SA(0, 1), a2, 1, last);
            PG8_WAIT_V(8); PG8_WAIT_L(0); PG8_BAR; PG8_MMA(0, 0, At, B0); PG8_MMA(0, 1, At, B1); PG8_BAR; PG8_SCHED;
            PG8_LDA(At, 1, 1); PG8_STAGE(PG8_SB(1, 0), b3, voffB); PG8_STAGE(PG8_SB(1, 1), b3 + hstepB, voffB); PG8_STAGE_A(PG8_SA(1, 0), a3, 0, last);
            PG8_WAIT_V(8); PG8_WAIT_L(0); PG8_BAR; PG8_MMA(1, 0, At, B0); PG8_MMA(1, 1, At, B1); PG8_BAR; PG8_SCHED;
        }
        if constexpr (ALIGN_EPI) { if (wr == 0) PG8_BAR; }
        E(acc, cur, wr, wc, fr, fq);
        if (!has_next) break;
#pragma unroll
        for (int a = 0; a < 2; ++a)
#pragma unroll
            for (int b = 0; b < 2; ++b)
#pragma unroll
                for (int m = 0; m < 4; ++m)
#pragma unroll
                    for (int n = 0; n < 2; ++n) acc[a][b][m][n] = (f32x4){0.f, 0.f, 0.f, 0.f};
        cur = nxt; cA = nA; cB = nB; ++ui;
        if constexpr (GATHER) { _Pragma("unroll") for (int h = 0; h < 2; ++h) _Pragma("unroll") for (int i = 0; i < 2; ++i) gC[h][i] = gN[h][i]; }
        if constexpr (ALIGN_EPI) { if (wr == 1) PG8_BAR; }
    }
    PG8_WAIT_V(0);
    if constexpr (!ALIGN_EPI) { if (wr == 0) PG8_BAR; }
    PG8_BAR;
#undef PG8_SA
#undef PG8_SB
#undef PG8_STAGE
#undef PG8_STAGE_A
#undef PG8_LDA
#undef PG8_LDB
#undef PG8_MMA
#undef PG8_WAIT_V
#undef PG8_WAIT_L
#undef PG8_BAR
#undef PG8_SCHED
}

__device__ __forceinline__ bool order_next(int i, int G, int c, int nM, int nN, int& im, int& pn) {
    const int nwg = nM * nN; const long L = (long)i * G + c; if (L >= nwg) return false;
    int wgid = (int)L; { const int q = nwg / 8, r = nwg % 8, xcd = wgid % 8, off = wgid / 8; wgid = (xcd < r ? xcd * (q + 1) : r * (q + 1) + (xcd - r) * q) + off; }
    const int WGM = 8, nig = WGM * nN, gid = wgid / nig, fm = gid * WGM, gsz = (nM - fm) < WGM ? (nM - fm) : WGM;
    im = fm + ((wgid % nig) % gsz); pn = (wgid % nig) / gsz; return true;
}
template <bool LATENT> struct DenseSched {
    const char* A; const char* B; int nN, G, c; size_t strideA, strideB;
    __device__ __forceinline__ bool next(int i, Unit& u) const {
        int im, pn; if (!order_next(i, G, c, LATENT ? 128 : 144, nN, im, pn)) return false;
        const int tile = LATENT ? (9 * (im >> 3) + 1 + (im & 7)) : im;
        u.a = A + (size_t)tile * strideA; u.b = B + (size_t)pn * strideB; u.bdelta = 0; u.pm = tile; u.pn = pn; u.aux = 0; u.rows = nullptr; return true;
    }
};
struct InProj1Sched {
    const char* A; const char* B; int G, c; size_t strideA, strideB;
    __device__ __forceinline__ bool next(int i, Unit& u) const {
        const long L = (long)i * G + c; int tile, pn;
        if (L < 144 * 8) { if (!order_next(i, G, c, 144, 8, tile, pn)) return false; }
        else { const int q = (int)(L - 144 * 8); if (q >= 128) return false; tile = 9 * (q >> 3) + 1 + (q & 7); pn = 8; }
        u.a = A + (size_t)tile * strideA; u.b = B + (size_t)pn * strideB; u.bdelta = 0; u.pm = tile; u.pn = pn; u.aux = 0; u.rows = nullptr; return true;
    }
};
struct MoeSched {
    const char* A; const char* B; int nN, G, c, nT; const LAS int* base; bool down; const int* tok;
    __device__ __forceinline__ bool next(int i, Unit& u) const {
        int tile, un; if (!order_next(i, G, c, nT, nN, tile, un)) return false;
        int cls = 0;
#pragma unroll 1
        for (int q = 1; q < NCLS; ++q) if (base[q] <= tile * 256) cls = q;
        int ea, eb; cls_experts(cls, ea, eb);
        u.pm = tile; u.pn = un; u.rows = tok + tile * 256; u.a = down ? A + (size_t)tile * (256 * 1024 * 2) : A;
        if (!down) { const int e = (un < 4) ? ea : eb, blk = un & 3; u.b = B + (size_t)e * (1024 * 1024 * 2) + (size_t)blk * (256 * 1024 * 2); u.bdelta = 0; u.aux = un; }
        else { u.b = B + (size_t)ea * (1024 * 512 * 2) + (size_t)un * (256 * 512 * 2); u.bdelta = (eb - ea) * (1024 * 512 * 2) - 8 * 128; u.aux = 0; }
        return true;
    }
};

struct EpiStoreBf16 {
    static constexpr bool PERM = true;
    bf16_t* O; int ldc; int gate_pn; float* gates; int gate_fq0;
    __device__ __forceinline__ void operator()(const f32x4 (&acc)[2][2][4][2], const Unit& u, int wr, int wc, int fr, int fq) const {
        const int row0 = u.pm * BM + wr * 64 + fr, col0 = u.pn * BM + wc * 32 + 8 * fq;
        if (u.pn == gate_pn) {
            if (wc == 0 && (fq >> 1) == (gate_fq0 >> 1)) {
#pragma unroll
                for (int ai = 0; ai < 2; ++ai)
#pragma unroll
                    for (int m = 0; m < 4; ++m) { float* gp = gates + (size_t)(row0 + ai * HALF + m * 16) * 16 + 8 * (fq & 1);
                        *(f32x4*)gp = acc[ai][0][m][0]; *(f32x4*)(gp + 4) = acc[ai][0][m][1]; } }
            return;
        }
#pragma unroll
        for (int ai = 0; ai < 2; ++ai)
#pragma unroll
            for (int m = 0; m < 4; ++m) { bf16_t* rowp = O + (size_t)(row0 + ai * HALF + m * 16) * ldc + col0;
#pragma unroll
                for (int bj = 0; bj < 2; ++bj) { const f32x4 v0 = acc[ai][bj][m][0], v1 = acc[ai][bj][m][1];
                    u32x4 w; w.x = pk2(v0[0], v0[1]); w.y = pk2(v0[2], v0[3]); w.z = pk2(v1[0], v1[1]); w.w = pk2(v1[2], v1[3]);
                    *(u32x4*)(rowp + bj * HALF) = w; } }
    }
};
template <bool FROM_INPUTS> struct EpiResid {
    static constexpr bool PERM = true;
    const float* xin; const float* ctxin; bf16_t* xr; const float* mod  ;
    __device__ __forceinline__ void operator()(const f32x4 (&acc)[2][2][4][2], const Unit& u, int wr, int wc, int fr, int fq) const {
        const int b = u.pm / 9, t9 = u.pm % 9; const bool isctx = t9 == 0;
        const size_t rowoff = isctx ? (size_t)b * CTXL : (size_t)b * SEQ + (size_t)(t9 - 1) * 256;
        const float* src = (isctx ? ctxin : xin) + rowoff * D;
        bf16_t* dst = xr + (size_t)u.pm * BM * D;
        const float* gv = mod + (isctx ? 16 : b) * 6144;
        const int col0 = u.pn * BM + wc * 32 + 8 * fq;
        f32x4 g4[2][2];
#pragma unroll
        for (int bj = 0; bj < 2; ++bj)
#pragma unroll
            for (int n = 0; n < 2; ++n) g4[bj][n] = *(const f32x4*)(gv + col0 + bj * HALF + n * 4);
#pragma unroll
        for (int ai = 0; ai < 2; ++ai)
#pragma unroll
            for (int m = 0; m < 4; ++m) { const size_t off = (size_t)(ai * HALF + wr * 64 + m * 16 + fr) * D + col0;
#pragma unroll
                for (int bj = 0; bj < 2; ++bj) { f32x4 s0, s1;
                    if (FROM_INPUTS) { s0 = *(const f32x4*)(src + off + bj * HALF); s1 = *(const f32x4*)(src + off + bj * HALF + 4); }
                    else { const u32x4 q = *(const u32x4*)(dst + off + bj * HALF); s0 = (f32x4){bflo(q.x), bfhi(q.x), bflo(q.y), bfhi(q.y)}; s1 = (f32x4){bflo(q.z), bfhi(q.z), bflo(q.w), bfhi(q.w)}; }
                    s0 = s0 + g4[bj][0] * acc[ai][bj][m][0]; s1 = s1 + g4[bj][1] * acc[ai][bj][m][1];
                    u32x4 w; w.x = pk2(s0[0], s0[1]); w.y = pk2(s0[2], s0[3]); w.z = pk2(s1[0], s1[1]); w.w = pk2(s1[2], s1[3]);
                    *(u32x4*)(dst + off + bj * HALF) = w; }
                if (m & 1) asm volatile("" ::: "memory"); }
    }
};
struct EpiGlu {
    static constexpr bool PERM = true;
    const bf16_t* G; bf16_t* O; const float* bias;
    __device__ __forceinline__ void operator()(const f32x4 (&acc)[2][2][4][2], const Unit& u, int wr, int wc, int fr, int fq) const {
        const int row0 = u.pm * BM + wr * 64 + fr, col0 = u.pn * BM + wc * 32 + 8 * fq;
#pragma unroll
        for (int bj = 0; bj < 2; ++bj) { const f32x4 b0 = *(const f32x4*)(bias + col0 + bj * HALF), b1 = *(const f32x4*)(bias + col0 + bj * HALF + 4);
#pragma unroll
            for (int ai = 0; ai < 2; ++ai)
#pragma unroll
                for (int m = 0; m < 4; ++m) { const int row = row0 + ai * HALF + m * 16;
                    const u32x4 gq = *(const u32x4*)(G + (size_t)row * 512 + col0 + bj * HALF);
                    const f32x4 v0 = acc[ai][bj][m][0] + b0, v1 = acc[ai][bj][m][1] + b1;
                    u32x4 w;
                    w.x = pk2(bflo(gq.x) * sigmoidf_(v0[0]), bfhi(gq.x) * sigmoidf_(v0[1])); w.y = pk2(bflo(gq.y) * sigmoidf_(v0[2]), bfhi(gq.y) * sigmoidf_(v0[3]));
                    w.z = pk2(bflo(gq.z) * sigmoidf_(v1[0]), bfhi(gq.z) * sigmoidf_(v1[1])); w.w = pk2(bflo(gq.w) * sigmoidf_(v1[2]), bfhi(gq.w) * sigmoidf_(v1[3]));
                    *(u32x4*)(O + (size_t)row * D + col0 + bj * HALF) = w; } }
    }
};
struct EpiSwiGlu {
    static constexpr bool PERM = true;
    bf16_t* ACT; const float* wpos;
    __device__ __forceinline__ void operator()(const f32x4 (&acc)[2][2][4][2], const Unit& u, int wr, int wc, int fr, int fq) const {
        const int slot = u.aux >> 2, blk = u.aux & 3;
        const int row0 = u.pm * BM + wr * 64 + fr, col0 = slot * 512 + blk * 128 + wc * 32 + 8 * fq;
#pragma unroll
        for (int ai = 0; ai < 2; ++ai)
#pragma unroll
            for (int m = 0; m < 4; ++m) { const int row = row0 + ai * HALF + m * 16; const float w = wpos[2 * (size_t)row + slot];
                const f32x4 g0 = acc[ai][0][m][0], g1 = acc[ai][0][m][1], u0 = acc[ai][1][m][0], u1 = acc[ai][1][m][1];
                u32x4 o;
                o.x = pk2(w * siluf_(g0[0]) * u0[0], w * siluf_(g0[1]) * u0[1]); o.y = pk2(w * siluf_(g0[2]) * u0[2], w * siluf_(g0[3]) * u0[3]);
                o.z = pk2(w * siluf_(g1[0]) * u1[0], w * siluf_(g1[1]) * u1[1]); o.w = pk2(w * siluf_(g1[2]) * u1[2], w * siluf_(g1[3]) * u1[3]);
                *(u32x4*)(ACT + (size_t)row * D + col0) = o; }
    }
};
template <bool FINAL> struct EpiDown {
    static constexpr bool PERM = true;
    const int* tok; float* outp; bf16_t* xr; const float* mod  ;
    __device__ __forceinline__ void operator()(const f32x4 (&acc)[2][2][4][2], const Unit& u, int wr, int wc, int fr, int fq) const {
        const int col0 = u.pn * BM + wc * 32 + 8 * fq;
#pragma unroll
        for (int ai = 0; ai < 2; ++ai)
#pragma unroll
            for (int m = 0; m < 4; ++m) { const int pos = u.pm * BM + ai * HALF + wr * 64 + m * 16 + fr; const int r = tok[pos];
                if (r >= 0) { const int b = r / LT, p = r % LT; const bool isctx = p < CTXL;
                    bf16_t* xp = xr + (size_t)r * D + col0;
                    float* op = outp + ((size_t)(b * SEQ + p - CTXL)) * D + col0;
                    const float* gv = mod + (isctx ? 16 : b) * 6144 + col0;
#pragma unroll
                    for (int bj = 0; bj < 2; ++bj) { const u32x4 q = *(const u32x4*)(xp + bj * HALF);
                        const f32x4 g0 = *(const f32x4*)(gv + bj * HALF), g1 = *(const f32x4*)(gv + bj * HALF + 4);
                        const f32x4 s0 = (f32x4){bflo(q.x), bfhi(q.x), bflo(q.y), bfhi(q.y)} + g0 * acc[ai][bj][m][0], s1 = (f32x4){bflo(q.z), bfhi(q.z), bflo(q.w), bfhi(q.w)} + g1 * acc[ai][bj][m][1];
                        if (FINAL) { *(f32x4*)(op + bj * HALF) = s0; *(f32x4*)(op + bj * HALF + 4) = s1; }
                        else { u32x4 w; w.x = pk2(s0[0], s0[1]); w.y = pk2(s0[2], s0[3]); w.z = pk2(s1[0], s1[1]); w.w = pk2(s1[2], s1[3]); *(u32x4*)(xp + bj * HALF) = w; } } }
                if (m & 1) asm volatile("" ::: "memory"); }
    }
};
}
namespace attn_body {
constexpr int DH = 64, PQ = NP0, PO = D;
constexpr int NW = 8, QBLK = 32, QB = QBLK * NW, KVBLK = 64;
__device__ __forceinline__ int crow(int r, int hi) { return (r & 3) + 8 * (r >> 2) + 4 * hi; }
#define SBAR() __builtin_amdgcn_sched_barrier(0)
constexpr int NSLOT = 3, SLOTB = 8192;
constexpr int LDS_K = 0, LDS_V = NSLOT * SLOTB, LDS_WS = 2 * NSLOT * SLOTB, LDS_OST = LDS_WS + NW * 64 * 4, LDS_BYTES_A = LDS_OST + NW * 4096;
constexpr float C2 = 0.125f * 1.4426950408889634f;
__device__ __forceinline__ void glds16(const void* gsrc, unsigned lds_dst) { unsigned keep;
    asm volatile("s_mov_b32 %0, m0\n\ts_mov_b32 m0, %2\n\ts_nop 0\n\tglobal_load_lds_dwordx4 %1, off\n\ts_mov_b32 m0, %0" : "=&s"(keep) : "v"(gsrc), "s"(lds_dst) : "memory"); }
__device__ __forceinline__ float max3f(float a, float b, float c) { float r; asm("v_max3_f32 %0, %1, %2, %3" : "=v"(r) : "v"(a), "v"(b), "v"(c)); return r; }
__device__ __forceinline__ float max2f(float a, float b) { float r; asm("v_max_f32_e32 %0, %1, %2" : "=v"(r) : "v"(a), "v"(b)); return r; }
__device__ __forceinline__ float fadd_s(float a, float b) { float r; asm("v_add_f32_e32 %0, %1, %2" : "=v"(r) : "v"(a), "v"(b)); return r; }
__device__ __forceinline__ float fsub_s(float a, float b) { float r; asm("v_sub_f32_e32 %0, %1, %2" : "=v"(r) : "v"(a), "v"(b)); return r; }
__device__ __forceinline__ unsigned cvtpk_s(float lo, float hi) { return pk2(lo, hi); }
#define WAIT_BAR(N) asm volatile("s_waitcnt vmcnt(" #N ") lgkmcnt(0)\n\ts_barrier" ::: "memory")

__device__ __forceinline__ void qkt(f32x16& p0, f32x16& p1, const char* Kslot, const bf16x8* qr, const f32x16& negm, int r32, int hi) {
    const char* kb = Kslot + hi * 1024 + r32 * 16;
#pragma unroll
    for (int d0 = 0; d0 < 4; ++d0) {
        const bf16x8 b0 = *reinterpret_cast<const bf16x8*>(kb + d0 * 2048);
        const bf16x8 b1 = *reinterpret_cast<const bf16x8*>(kb + d0 * 2048 + 512);
        if (d0 == 0) { p0 = __builtin_amdgcn_mfma_f32_32x32x16_bf16(b0, qr[0], negm, 0, 0, 0); p1 = __builtin_amdgcn_mfma_f32_32x32x16_bf16(b1, qr[0], negm, 0, 0, 0); }
        else { p0 = __builtin_amdgcn_mfma_f32_32x32x16_bf16(b0, qr[d0], p0, 0, 0, 0); p1 = __builtin_amdgcn_mfma_f32_32x32x16_bf16(b1, qr[d0], p1, 0, 0, 0); } }
}
typedef __attribute__((address_space(3))) const char* lds_cptr;
typedef short v4i16_t __attribute__((ext_vector_type(4)));
__device__ __forceinline__ void kload8(bf16x8* kf, lds_cptr kp) {
    kf[0] = *(const LAS bf16x8*)(kp);        kf[1] = *(const LAS bf16x8*)(kp + 512);
    kf[2] = *(const LAS bf16x8*)(kp + 2048); kf[3] = *(const LAS bf16x8*)(kp + 2560);
    kf[4] = *(const LAS bf16x8*)(kp + 4096); kf[5] = *(const LAS bf16x8*)(kp + 4608);
    kf[6] = *(const LAS bf16x8*)(kp + 6144); kf[7] = *(const LAS bf16x8*)(kp + 6656);
}
__device__ __forceinline__ void kload2(bf16x8* kf, lds_cptr kp, int j) { kf[2 * j] = *(const LAS bf16x8*)(kp + j * 2048); kf[2 * j + 1] = *(const LAS bf16x8*)(kp + j * 2048 + 512); }
__device__ __forceinline__ s16x4 vtr(lds_cptr p) { return __builtin_bit_cast(s16x4, __builtin_amdgcn_ds_read_tr16_b64_v4i16((LAS v4i16_t*)p)); }
__device__ __forceinline__ float rowmax(const f32x16& p0, const f32x16& p1) {
    float a = max3f(p0[0], p0[1], p1[0]), b = max3f(p0[2], p0[3], p1[1]); a = max3f(a, p1[2], p1[3]);
#pragma unroll
    for (int r = 4; r < 16; r += 4) { a = max3f(a, p0[r], p0[r + 1]); b = max3f(b, p0[r + 2], p0[r + 3]); a = max3f(a, p1[r], p1[r + 1]); b = max3f(b, p1[r + 2], p1[r + 3]); }
    const float m = max2f(a, b);
    auto rr = __builtin_amdgcn_permlane32_swap(__float_as_uint(m), __float_as_uint(m), false, false);
    return max2f(__uint_as_float(rr[0]), __uint_as_float(rr[1]));
}
__device__ __forceinline__ void pv(f32x16* o, int vb, bf16x8 pa0, bf16x8 pa1, bf16x8 pa2, bf16x8 pa3) {
#pragma unroll
    for (int d0 = 0; d0 < 2; ++d0) { s16x4 lo[4], hi[4];
#pragma unroll
        for (int ks = 0; ks < 4; ++ks) {
            asm volatile("ds_read_b64_tr_b16 %0,%1 offset:%c2" : "=&v"(lo[ks]) : "v"(vb), "i"(d0 * 4096 + ks * 1024) : "memory");
            asm volatile("ds_read_b64_tr_b16 %0,%1 offset:%c2" : "=&v"(hi[ks]) : "v"(vb), "i"(d0 * 4096 + ks * 1024 + 512) : "memory"); }
        asm volatile("s_waitcnt lgkmcnt(0)" ::: "memory"); SBAR();
#define PK(k) (bf16x8){lo[k][0], lo[k][1], lo[k][2], lo[k][3], hi[k][0], hi[k][1], hi[k][2], hi[k][3]}
        o[d0] = __builtin_amdgcn_mfma_f32_32x32x16_bf16(pa0, PK(0), o[d0], 0, 0, 0);
        o[d0] = __builtin_amdgcn_mfma_f32_32x32x16_bf16(pa1, PK(1), o[d0], 0, 0, 0);
        o[d0] = __builtin_amdgcn_mfma_f32_32x32x16_bf16(pa2, PK(2), o[d0], 0, 0, 0);
        o[d0] = __builtin_amdgcn_mfma_f32_32x32x16_bf16(pa3, PK(3), o[d0], 0, 0, 0);
#undef PK
    }
}
__device__ __forceinline__ void rope_cs(float pos, int i, float& c, float& s) {
    const float inv = exp2f(-(float)i * 0.83048202372184058696f);
    float rev = pos * inv * 0.15915494309189533577f; rev = rev - floorf(rev);
    c = __builtin_amdgcn_cosf(rev); s = __builtin_amdgcn_sinf(rev);
}

template <int THRL> __device__ __forceinline__ void attn_unit(int b, int h, int qb, const bf16_t* Pbuf, bf16_t* O, const float* qgain, char* shm, int wave_s) {
    const int tid = opaque_tid(wave_s), lane = tid & 63, r32 = lane & 31, hi = lane >> 5; const int wid = __builtin_amdgcn_readfirstlane(tid >> 6);
    const long rowbase = (long)b * LT; const int q0 = qb * QB; const int kvh = h >> 2;
    const bf16_t* Qw = Pbuf + (rowbase + q0 + wid * QBLK) * PQ + C_AQ + h * DH;
    const bf16_t* Kh = Pbuf + rowbase * PQ + C_AK + kvh * DH; const bf16_t* Vh = Pbuf + rowbase * PQ + C_AV + kvh * DH;
    const unsigned lds0 = (unsigned)(uintptr_t)shm;
    float* wsf = (float*)(shm + LDS_WS) + wid * 64;
    const bf16_t* ksrc = Kh + (long)lane * PQ + wid * 8;
    const bf16_t* vsrc = Vh + (long)(16 * (wid & 3) + (lane >> 2)) * PQ + (wid >> 2) * 32 + (lane & 3) * 8;
    const unsigned kdst = lds0 + LDS_K + wid * 1024, vdst = lds0 + LDS_V + wid * 1024;
#define DMA_K(t, slot) glds16(ksrc + (long)(t) * KVBLK * PQ, (unsigned)__builtin_amdgcn_readfirstlane(kdst + (slot)))
#define DMA_V(t, slot) glds16(vsrc + (long)(t) * KVBLK * PQ, (unsigned)__builtin_amdgcn_readfirstlane(vdst + (slot)))
    const int vb0 = (int)(lds0 + LDS_V) + ((lane >> 4) & 1) * 32 + (lane & 3) * 8 + (4 * hi + ((lane & 15) >> 2)) * 64;
    const char* Kbase = shm + LDS_K; bf16x8 kf[8];
    const lds_cptr shm3 = (lds_cptr)shm; const lds_cptr kp0 = shm3 + LDS_K + hi * 1024 + r32 * 16; const lds_cptr vp0 = shm3 + LDS_V + ((lane >> 4) & 1) * 32 + (lane & 3) * 8 + (4 * hi + ((lane & 15) >> 2)) * 64;
    const int NT = (qb == 0) ? (CTXL / KVBLK) : (LT / KVBLK);
    DMA_K(0, 0); DMA_V(0, 0); DMA_K(1, SLOTB);
    bf16x8 qr[4];
    {
        u32x4 raw[4];
#pragma unroll
        for (int d0 = 0; d0 < 4; ++d0) raw[d0] = *reinterpret_cast<const u32x4*>(&Qw[(long)r32 * PQ + d0 * 16 + hi * 8]);
        float qf[4][8]; float ss = 0.f;
#pragma unroll
        for (int d0 = 0; d0 < 4; ++d0) {
            qf[d0][0] = bflo(raw[d0].x); qf[d0][1] = bfhi(raw[d0].x); qf[d0][2] = bflo(raw[d0].y); qf[d0][3] = bfhi(raw[d0].y);
            qf[d0][4] = bflo(raw[d0].z); qf[d0][5] = bfhi(raw[d0].z); qf[d0][6] = bflo(raw[d0].w); qf[d0][7] = bfhi(raw[d0].w);
#pragma unroll
            for (int j = 0; j < 8; ++j) ss += qf[d0][j] * qf[d0][j]; }
        ss += xorl<32>(ss);
        const float rstd = rsqrtf(ss * (1.f / 64.f) + NORM_EPS);
#pragma unroll
        for (int d0 = 0; d0 < 4; ++d0)
#pragma unroll
            for (int j = 0; j < 8; ++j) qf[d0][j] *= rstd * qgain[d0 * 16 + hi * 8 + j];
        if (qb > 0) {
            const int t = q0 - CTXL + wid * QBLK + r32; const float prow = (float)(t >> 6), pcol = (float)(t & 63);
#pragma unroll
            for (int j = 0; j < 8; ++j) { float c, s;
                rope_cs(prow, hi * 8 + j, c, s); { const float x1 = qf[0][j], x2 = qf[1][j]; qf[0][j] = x1 * c - x2 * s; qf[1][j] = x2 * c + x1 * s; }
                rope_cs(pcol, hi * 8 + j, c, s); { const float x1 = qf[2][j], x2 = qf[3][j]; qf[2][j] = x1 * c - x2 * s; qf[3][j] = x2 * c + x1 * s; } }
        }
#pragma unroll
        for (int d0 = 0; d0 < 4; ++d0) { u32x4 w; w.x = pk2(qf[d0][0] * C2, qf[d0][1] * C2); w.y = pk2(qf[d0][2] * C2, qf[d0][3] * C2); w.z = pk2(qf[d0][4] * C2, qf[d0][5] * C2); w.w = pk2(qf[d0][6] * C2, qf[d0][7] * C2);
            qr[d0] = __builtin_bit_cast(bf16x8, w); }
    }
    float mhat = 0.f, l_reg = 0.f; f32x16 o[2]; o[0] = f32x16{}; o[1] = f32x16{}; f32x16 negm = f32x16{}; asm volatile("" : "+v"(negm));
    bool resc = false;
#define START(P0, P1) do { const float rm = rowmax(P0, P1); resc = false; \
    { const float dl = rm; mhat = fadd_s(mhat, dl); \
      _Pragma("unroll") for (int r = 0; r < 16; ++r) { P0[r] = fsub_s(P0[r], dl); P1[r] = fsub_s(P1[r], dl); } \
      _Pragma("unroll") for (int r = 0; r < 16; ++r) negm[r] = -mhat; asm volatile("" : "+v"(negm)); } \
    _Pragma("unroll") for (int r = 0; r < 16; ++r) P0[r] = __builtin_amdgcn_exp2f(P0[r]); } while (0)
#define RESC() do { if (resc) { asm volatile("s_waitcnt lgkmcnt(0)" ::: "memory"); \
      _Pragma("unroll") for (int d_ = 0; d_ < 2; ++d_) _Pragma("unroll") for (int r = 0; r < 16; ++r) o[d_][r] *= wsf[crow(r, hi)]; } } while (0)
    f32x16 pA0, pA1, pB0, pB1;
    int sl_prev = 0, sl_cur = 0, sl_next = SLOTB;
#define ROT() do { sl_prev = sl_cur; sl_cur = sl_next; sl_next = (sl_next == (NSLOT - 1) * SLOTB) ? 0 : sl_next + SLOTB; } while (0)
    DMA_K(2, 2 * SLOTB);
    WAIT_BAR(3);
    qkt(pA0, pA1, Kbase, qr, negm, r32, hi); asm volatile("s_nop 15\n\ts_nop 7" : "+v"(pA0), "+v"(pA1));
    START(pA0, pA1);
    _Pragma("unroll") for (int r = 0; r < 16; ++r) pA1[r] = __builtin_amdgcn_exp2f(pA1[r]);
    WAIT_BAR(0);
    DMA_K(3, 0); DMA_V(1, SLOTB);
    ROT();
    kload8(kf, kp0 + sl_cur);
    WAIT_BAR(2);
    s16x4 vlo[8], vhi[8]; u32x4 pw0, pw1, pw2, pw3;
#define PKW(P, B) cvtpk_s(P[B], P[B + 1])
#define PAF(k) __builtin_bit_cast(bf16x8, pw##k)
#define VFR(i) (bf16x8){vlo[i][0], vlo[i][1], vlo[i][2], vlo[i][3], vhi[i][0], vhi[i][1], vhi[i][2], vhi[i][3]}
#define PIN(x) asm volatile("" : "+v"(x))
#define MX3(a, b, c) __builtin_fmaxf(__builtin_fmaxf((a), (b)), (c))
#define GAPA(MF, A0, A1, A2, A3, W0, W1, PW) do { MF; sacc += A0; sacc += A1; sacc += A2; sacc += A3; PIN(sacc); W0; W1; PIN(PW); SBAR(); } while (0)
#define EX(v) __builtin_amdgcn_exp2f(v)
#define GAPB(MF, X, B) do { MF; X[B] = EX(X[B]); X[B + 1] = EX(X[B + 1]); X[B + 2] = EX(X[B + 2]); X[B + 3] = EX(X[B + 3]); PIN(X); SBAR(); } while (0)
#define VRD(i) do { vlo[i] = vtr(vp_ + (((i) >> 2) * 4096 + ((i) & 3) * 1024)); vhi[i] = vtr(vp_ + (((i) >> 2) * 4096 + ((i) & 3) * 1024 + 512)); } while (0)
#define KRD(G_, j) do { if (G_) { kload2(kf, kp0 + sl_next, j); SBAR(); } } while (0)
#define STEP(C0, C1, P0, P1, t, GK, GV, GL) do { SBAR(); \
    const lds_cptr vp_ = vp0 + sl_prev; \
    VRD(0); SBAR(); float sacc = (P0[0] + P0[1]); \
    GAPA(C0 = __builtin_amdgcn_mfma_f32_32x32x16_bf16(kf[0], qr[0], negm, 0, 0, 0), P0[2], P0[3], P0[4], P0[5],     pw0[0] = PKW(P0, 0), pw0[1] = PKW(P0, 2), pw0); \
    VRD(4); SBAR(); GAPA(C1 = __builtin_amdgcn_mfma_f32_32x32x16_bf16(kf[1], qr[0], negm, 0, 0, 0), P0[6], P0[7], P0[8], P0[9],     pw0[2] = PKW(P0, 4), pw0[3] = PKW(P0, 6), pw0); \
    VRD(1); SBAR(); GAPA(C0 = __builtin_amdgcn_mfma_f32_32x32x16_bf16(kf[2], qr[1], C0, 0, 0, 0),   P0[10], P0[11], P0[12], P0[13], pw1[0] = PKW(P0, 8), pw1[1] = PKW(P0, 10), pw1); \
    VRD(5); SBAR(); GAPA(C1 = __builtin_amdgcn_mfma_f32_32x32x16_bf16(kf[3], qr[1], C1, 0, 0, 0),   P0[14], P0[15], P1[0], P1[1],   pw1[2] = PKW(P0, 12), pw1[3] = PKW(P0, 14), pw1); \
    VRD(2); SBAR(); GAPA(C0 = __builtin_amdgcn_mfma_f32_32x32x16_bf16(kf[4], qr[2], C0, 0, 0, 0),   P1[2], P1[3], P1[4], P1[5],     pw2[0] = PKW(P1, 0), pw2[1] = PKW(P1, 2), pw2); \
    VRD(6); SBAR(); GAPA(C1 = __builtin_amdgcn_mfma_f32_32x32x16_bf16(kf[5], qr[2], C1, 0, 0, 0),   P1[6], P1[7], P1[8], P1[9],     pw2[2] = PKW(P1, 4), pw2[3] = PKW(P1, 6), pw2); \
    VRD(3); SBAR(); GAPA(C0 = __builtin_amdgcn_mfma_f32_32x32x16_bf16(kf[6], qr[3], C0, 0, 0, 0),   P1[10], P1[11], P1[12], P1[13], pw3[0] = PKW(P1, 8), pw3[1] = PKW(P1, 10), pw3); \
    VRD(7); SBAR(); GAPA(C1 = __builtin_amdgcn_mfma_f32_32x32x16_bf16(kf[7], qr[3], C1, 0, 0, 0),   P1[14], P1[15], 0.f, 0.f,       pw3[2] = PKW(P1, 12), pw3[3] = PKW(P1, 14), pw3); \
    l_reg += sacc; \
    if (GK) { DMA_K((t) + 3, sl_cur); } if (GV) { DMA_V((t) + 1, sl_next); } \
    { float a = MX3(C0[0], C0[1], C1[0]), b_ = MX3(C0[2], C0[3], C1[1]); a = MX3(a, C1[2], C1[3]); \
      _Pragma("unroll") for (int r = 4; r < 16; r += 4) { a = MX3(a, C0[r], C0[r + 1]); b_ = MX3(b_, C0[r + 2], C0[r + 3]); a = MX3(a, C1[r], C1[r + 1]); b_ = MX3(b_, C1[r + 2], C1[r + 3]); } \
      float rm = __builtin_fmaxf(a, b_); { auto rr = __builtin_amdgcn_permlane32_swap(__float_as_uint(rm), __float_as_uint(rm), false, false); rm = __builtin_fmaxf(__uint_as_float(rr[0]), __uint_as_float(rr[1])); } \
      resc = false; \
      if (__builtin_expect(__any(rm > (float)THRL), 0)) { const float dl = __builtin_fmaxf(rm, 0.f); mhat += dl; \
        _Pragma("unroll") for (int r = 0; r < 16; ++r) { C0[r] -= dl; C1[r] -= dl; } \
        _Pragma("unroll") for (int r = 0; r < 16; ++r) negm[r] = -mhat; asm volatile("" : "+v"(negm)); \
        const float f = __builtin_amdgcn_exp2f(-dl); l_reg *= f; if (hi == 0) wsf[r32] = f; resc = true; } } \
    SBAR(); \
    GAPB(o[0] = __builtin_amdgcn_mfma_f32_32x32x16_bf16(PAF(0), VFR(0), o[0], 0, 0, 0), C0, 0); \
    GAPB(o[1] = __builtin_amdgcn_mfma_f32_32x32x16_bf16(PAF(0), VFR(4), o[1], 0, 0, 0), C0, 4); \
    KRD(GL, 0); GAPB(o[0] = __builtin_amdgcn_mfma_f32_32x32x16_bf16(PAF(1), VFR(1), o[0], 0, 0, 0), C0, 8); \
    KRD(GL, 1); GAPB(o[1] = __builtin_amdgcn_mfma_f32_32x32x16_bf16(PAF(1), VFR(5), o[1], 0, 0, 0), C0, 12); \
    KRD(GL, 2); GAPB(o[0] = __builtin_amdgcn_mfma_f32_32x32x16_bf16(PAF(2), VFR(2), o[0], 0, 0, 0), C1, 0); \
    KRD(GL, 3); GAPB(o[1] = __builtin_amdgcn_mfma_f32_32x32x16_bf16(PAF(2), VFR(6), o[1], 0, 0, 0), C1, 4); \
    GAPB(o[0] = __builtin_amdgcn_mfma_f32_32x32x16_bf16(PAF(3), VFR(3), o[0], 0, 0, 0), C1, 8); \
    GAPB(o[1] = __builtin_amdgcn_mfma_f32_32x32x16_bf16(PAF(3), VFR(7), o[1], 0, 0, 0), C1, 12); \
    } while (0)
    int t = 1;
    for (; t + 5 < NT; t += 2) {
        STEP(pB0, pB1, pA0, pA1, t, true, true, true);     WAIT_BAR(2); RESC(); ROT();
        STEP(pA0, pA1, pB0, pB1, t + 1, true, true, true); WAIT_BAR(2); RESC(); ROT();
    }
#define ENDW(tt) do { if ((tt) + 3 < NT) { WAIT_BAR(2); } else if ((tt) + 2 < NT) { WAIT_BAR(1); } else { WAIT_BAR(0); } } while (0)
    for (; t + 1 < NT; t += 2) {
        STEP(pB0, pB1, pA0, pA1, t, (t + 3 < NT), (t + 1 < NT), (t + 1 < NT));         ENDW(t);     RESC(); ROT();
        STEP(pA0, pA1, pB0, pB1, t + 1, (t + 4 < NT), (t + 2 < NT), (t + 2 < NT));     ENDW(t + 1); RESC(); ROT();
    }
    STEP(pB0, pB1, pA0, pA1, NT - 1, false, false, false); RESC();
    { float sacc = pB0[0] + pB0[1]; _Pragma("unroll") for (int r = 2; r < 16; ++r) sacc += pB0[r]; _Pragma("unroll") for (int r = 0; r < 16; ++r) sacc += pB1[r]; l_reg += sacc;
      pw0 = (u32x4){PKW(pB0, 0), PKW(pB0, 2), PKW(pB0, 4), PKW(pB0, 6)}; pw1 = (u32x4){PKW(pB0, 8), PKW(pB0, 10), PKW(pB0, 12), PKW(pB0, 14)}; pw2 = (u32x4){PKW(pB1, 0), PKW(pB1, 2), PKW(pB1, 4), PKW(pB1, 6)}; pw3 = (u32x4){PKW(pB1, 8), PKW(pB1, 10), PKW(pB1, 12), PKW(pB1, 14)};
      SBAR(); pv(o, vb0 + sl_cur, PAF(0), PAF(1), PAF(2), PAF(3)); }
#undef PKW
#undef PAF
#undef VFR
#undef PIN
#undef MX3
#undef GAPA
#undef GAPB
#undef EX
#undef VRD
#undef KRD
#undef STEP
#undef ENDW
    { auto rr = __builtin_amdgcn_permlane32_swap(__float_as_uint(l_reg), __float_as_uint(l_reg), false, false); l_reg = __uint_as_float(rr[0]) + __uint_as_float(rr[1]); }
    if (hi == 0) wsf[32 + r32] = l_reg; asm volatile("s_waitcnt lgkmcnt(0)" ::: "memory");
    float rli[16];
#pragma unroll
    for (int r = 0; r < 16; ++r) rli[r] = __builtin_amdgcn_rcpf(wsf[32 + crow(r, hi)]);
    bf16_t* Ow = O + (rowbase + q0 + wid * QBLK) * PO + 512 + h * DH;
    { bf16_t* stg = (bf16_t*)(shm + LDS_OST) + wid * 2048;
#pragma unroll
      for (int r = 0; r < 16; ++r) { const int orow = crow(r, hi);
#pragma unroll
          for (int d0 = 0; d0 < 2; ++d0) stg[orow * 64 + d0 * 32 + r32] = f2bf(o[d0][r] * rli[r]); }
      asm volatile("s_waitcnt lgkmcnt(0)" ::: "memory");
#pragma unroll
      for (int i = 0; i < 4; ++i) { const int row = i * 8 + (lane >> 3), ch = lane & 7; const u32x4 v = *(const u32x4*)(stg + row * 64 + ch * 8); *(u32x4*)(Ow + (long)row * PO + ch * 8) = v; } }
    asm volatile("s_waitcnt lgkmcnt(0)\n\ts_barrier" ::: "memory");
#undef DMA_K
#undef DMA_V
#undef START
#undef RESC
#undef ROT
}
#undef SBAR
#undef WAIT_BAR
}

__device__ __forceinline__ void knorm_phase(Frame& F) {
    bf16_t* Pb = (bf16_t*)(F.ws + WS_P); const float* kg = F.p->in[I_KNORM];
    const int kvh = F.lane >> 5, half = (F.lane >> 4) & 1, i = F.lane & 15, d1 = half * 32 + i, d2 = d1 + 16;
    const float g1 = kg[d1], g2 = kg[d2];
    const int r0 = wave_row0(F.bid, F.wave);
#pragma unroll 1
    for (int ri3 = 0; ri3 < ROWS_PER_WAVE; ri3 += 6) {
        float x1[6], x2[6];
#pragma unroll
        for (int q = 0; q < 6; ++q) { const bf16_t* kp = Pb + (size_t)(r0 + ri3 + q) * NP0 + C_AK + kvh * 64; x1[q] = bf2f(kp[d1]); x2[q] = bf2f(kp[d2]); }
#pragma unroll
        for (int q = 0; q < 6; ++q) {
            const int r = r0 + ri3 + q, p = r % LT;
            bf16_t* kp = Pb + (size_t)r * NP0 + C_AK + kvh * 64;
            float a1 = x1[q], a2 = x2[q];
            float ss = a1 * a1 + a2 * a2;
            ss += xorl<1>(ss); ss += xorl<2>(ss); ss += xorl<4>(ss); ss += xorl<8>(ss); ss += xorl<16>(ss);
            const float rstd = rsqrtf(ss * (1.f / 64.f) + NORM_EPS);
            a1 *= rstd * g1; a2 *= rstd * g2;
            if (p >= CTXL) { const int t = p - CTXL; const float pos = half ? (float)(t & 63) : (float)(t >> 6); float c, s; attn_body::rope_cs(pos, i, c, s);
                const float y1 = a1 * c - a2 * s, y2 = a2 * c + a1 * s; a1 = y1; a2 = y2; }
            kp[d1] = f2bf(a1); kp[d2] = f2bf(a2);
        }
    }
}
namespace mix {
typedef LAS unsigned char* lptr;
__device__ __forceinline__ bf16x8 frag(const LAS unsigned char* base, int pitch, int row0, int k0, int lane) {
    return *(const LAS bf16x8*)(base + (row0 + (lane & 15)) * pitch + (k0 + 8 * (lane >> 4)) * 2);
}
#define MFMA16(a, b, c) __builtin_amdgcn_mfma_f32_16x16x32_bf16(a, b, c, 0, 0, 0)
__device__ __forceinline__ float log_sigmoid(float x) { return fminf(x, 0.f) - log1pf(__expf(-fabsf(x))); }
__device__ __forceinline__ float softplus(float x) { return fmaxf(x, 0.f) + log1pf(__expf(-fabsf(x))); }
template <int CTRL> __device__ __forceinline__ float dpp_old(float oldv, float v) { return __int_as_float(__builtin_amdgcn_update_dpp(__float_as_int(oldv), __float_as_int(v), CTRL, 0xf, 0xf, false)); }
__device__ __forceinline__ float scan_add(float v, int lane) {
    v += dpp_old<0x111>(0.f, v); v += dpp_old<0x112>(0.f, v); v += dpp_old<0x114>(0.f, v); v += dpp_old<0x118>(0.f, v);
    const float t0 = rdlane(v, 15), t1 = rdlane(v, 31), t2 = rdlane(v, 47);
    float off = (lane >= 16) ? t0 : 0.f; off += (lane >= 32) ? t1 : 0.f; off += (lane >= 48) ? t2 : 0.f;
    return v + off;
}
__device__ __forceinline__ float scan_max(float v, int lane) {
    const float ninf = -INFINITY;
    v = fmaxf(v, dpp_old<0x111>(ninf, v)); v = fmaxf(v, dpp_old<0x112>(ninf, v)); v = fmaxf(v, dpp_old<0x114>(ninf, v)); v = fmaxf(v, dpp_old<0x118>(ninf, v));
    const float t0 = rdlane(v, 15), t1 = rdlane(v, 31), t2 = rdlane(v, 47);
    float off = (lane >= 16) ? t0 : ninf; off = fmaxf(off, (lane >= 32) ? t1 : ninf); off = fmaxf(off, (lane >= 48) ? t2 : ninf);
    return fmaxf(v, off);
}
__device__ __forceinline__ void unpack8(const u32x4 r, float* f) { f[0] = bflo(r.x); f[1] = bfhi(r.x); f[2] = bflo(r.y); f[3] = bfhi(r.y); f[4] = bflo(r.z); f[5] = bfhi(r.z); f[6] = bflo(r.w); f[7] = bfhi(r.w); }

typedef short v4i16_t __attribute__((ext_vector_type(4)));
__device__ __forceinline__ bf16x8 trfrag(const LAS unsigned char* base, int pitch, int k0, int c0, int lane) {
    const int g = lane >> 4, i = lane & 15, q = i >> 2, pp = i & 3;
    const LAS unsigned char* a0 = base + (k0 + 8 * g + q) * pitch + (c0 + 4 * pp) * 2;
    const v4i16_t lo = __builtin_amdgcn_ds_read_tr16_b64_v4i16((LAS v4i16_t*)a0);
    const v4i16_t hi = __builtin_amdgcn_ds_read_tr16_b64_v4i16((LAS v4i16_t*)(a0 + 4 * pitch));
    return (bf16x8){lo[0], lo[1], lo[2], lo[3], hi[0], hi[1], hi[2], hi[3]};
}
__device__ __forceinline__ void mlstm_unit(Frame& F, int b, int hd, int dir) {
    const int tid = F.tid, lane = F.lane, w = F.wave, l15 = lane & 15, l4 = lane >> 4;
    const bf16_t* Pb = (const bf16_t*)(F.ws + WS_P); const float* GT = (const float*)(F.ws + WS_GATES);
    bf16_t* Y = (bf16_t*)(F.ws + (dir ? WS_Y1 : WS_Y0));
    lptr L = F.lds;
    constexpr int PQK = 272, PT = 144;
    lptr Qs = L, Ks = L + 17408, Kw = L + 34816, Vs = L + 52224, Sw = L + 69632, Cb = L + 78848;
    LAS float* fl = (LAS float*)(L + 113664);
    LAS float *rj = fl, *cs = fl + 64, *gg = fl + 128, *eneg = fl + 192, *wend = fl + 256, *denp = fl + 320  , *nq = fl + 448, *n0 = fl + 512  , *scl = fl + 640, *npart = fl + 704  ;
    const float gbi = F.p->in[I_MLGB][dir * 8 + hd], gbf = F.p->in[I_MLGB][dir * 8 + 4 + hd];
    for (int i = tid; i < 34816 / 4; i += NTHREADS) ((LAS unsigned*)Cb)[i] = 0u;
    if (tid < 128) n0[tid] = 0.f;
    f32x4 accC[8];
#pragma unroll
    for (int i = 0; i < 8; ++i) accC[i] = (f32x4){0.f, 0.f, 0.f, 0.f};
    float m0 = 0.f;
    const size_t rowb = (size_t)b * LT;
    const float kscale = 0.08838834764831845f;
    const int sg = dir ? -1 : 1;
    const int pr = tid >> 4, pc = tid & 15;
    u32x4 nq_[2], nk_[2], nv_[2]; float ngi = 0.f, ngf = 0.f;
    {
        const int p0 = dir ? 255 : 0;
#pragma unroll
        for (int i = 0; i < 2; ++i) { const bf16_t* rp = Pb + (rowb + (size_t)(p0 + sg * (pr + 32 * i))) * NP0 + hd * 128 + 8 * pc;
            nq_[i] = *(const u32x4*)(rp + C_MQ); nk_[i] = *(const u32x4*)(rp + C_MK); nv_[i] = *(const u32x4*)(rp + C_MV); }
        if (w == 0) { const size_t nrow = rowb + (size_t)(p0 + sg * lane); ngi = GT[nrow * 16 + dir * 8 + hd]; ngf = GT[nrow * 16 + dir * 8 + 4 + hd]; }
    }
    for (int c = 0; c < 36; ++c) {
        const int p0 = dir ? (c < 4 ? 255 - 64 * c : 2559 - 64 * c) : 64 * c;
        if (w == 0) {
            const float li = ngi + gbi;
            const float lf = log_sigmoid(ngf + gbf);
            const float bb = scan_add(lf, lane);
            const float csv = li - bb;
            const float pm = scan_max(csv, lane);
            const float inter = bb + m0;
            const float mj = fmaxf(inter, bb + pm);
            const float bend = rdlane(bb, 63), pmend = rdlane(pm, 63);
            const float mnew = fmaxf(bend + m0, pmend + bend);
            rj[lane] = bb - mj; cs[lane] = csv; gg[lane] = __expf(inter - mj); eneg[lane] = __expf(-mj);
            wend[lane] = __expf(csv + bend - mnew);
            if (lane == 0) scl[0] = __expf(bend + m0 - mnew);
            m0 = mnew;
        }
        __syncthreads();
#pragma unroll
        for (int i = 0; i < 2; ++i) {
            const int row = pr + 32 * i; const float we = wend[row];
            *(LAS u32x4*)(Qs + row * PQK + pc * 16) = nq_[i]; *(LAS u32x4*)(Vs + row * PQK + pc * 16) = nv_[i];
            float kf[8]; unpack8(nk_[i], kf);
#pragma unroll
            for (int e = 0; e < 8; ++e) kf[e] *= kscale;
            u32x4 ka; ka.x = pk2(kf[0], kf[1]); ka.y = pk2(kf[2], kf[3]); ka.z = pk2(kf[4], kf[5]); ka.w = pk2(kf[6], kf[7]);
            *(LAS u32x4*)(Ks + row * PQK + pc * 16) = ka;
            u32x4 kb; kb.x = pk2(kf[0] * we, kf[1] * we); kb.y = pk2(kf[2] * we, kf[3] * we); kb.z = pk2(kf[4] * we, kf[5] * we); kb.w = pk2(kf[6] * we, kf[7] * we);
            *(LAS u32x4*)(Kw + row * PQK + pc * 16) = kb;
        }
        {
            const int cn = (c < 35) ? c + 1 : c; const int pn0 = dir ? (cn < 4 ? 255 - 64 * cn : 2559 - 64 * cn) : 64 * cn;
#pragma unroll
            for (int i = 0; i < 2; ++i) { const bf16_t* rp = Pb + (rowb + (size_t)(pn0 + sg * (pr + 32 * i))) * NP0 + hd * 128 + 8 * pc;
                nq_[i] = *(const u32x4*)(rp + C_MQ); nk_[i] = *(const u32x4*)(rp + C_MK); nv_[i] = *(const u32x4*)(rp + C_MV); }
            if (w == 0) { const size_t nrow = rowb + (size_t)(pn0 + sg * lane); ngi = GT[nrow * 16 + dir * 8 + hd]; ngf = GT[nrow * 16 + dir * 8 + 4 + hd]; }
        }
        __syncthreads();
        {
            const int jt = w >> 1, sh = w & 1; float rsum = 0.f;
            const int j = 16 * jt + l15; const float rjj = rj[j];
#pragma unroll
            for (int si = 0; si < 2; ++si) {
                const int st = 2 * sh + si; const int s0 = 16 * st + 4 * l4;
                u32x2 o; o.x = 0u; o.y = 0u;
                if (st <= jt) {
                    f32x4 a = (f32x4){0.f, 0.f, 0.f, 0.f};
#pragma unroll
                    for (int ks = 0; ks < 4; ++ks) a = MFMA16(frag(Ks, PQK, 16 * st, 32 * ks, lane), frag(Qs, PQK, 16 * jt, 32 * ks, lane), a);
                    float vv[4]; const f32x4 c4 = *(const LAS f32x4*)(cs + s0);
#pragma unroll
                    for (int r = 0; r < 4; ++r) { const int s = s0 + r; vv[r] = (s <= j) ? a[r] * __expf(rjj + c4[r]) : 0.f; rsum += vv[r]; }
                    o.x = pk2(vv[0], vv[1]); o.y = pk2(vv[2], vv[3]);
                }
                *(LAS u32x2*)(Sw + j * PT + s0 * 2) = o;
            }
            rsum += xorl<16>(rsum); rsum += xorl<32>(rsum);
            if (l4 == 0) denp[sh * 64 + j] = rsum;
            const int jq = tid >> 3, kp = tid & 7; float a = 0.f;
            const u32x4 qa = *(const LAS u32x4*)(Qs + jq * PQK + kp * 32), qb = *(const LAS u32x4*)(Qs + jq * PQK + kp * 32 + 16);
            float qf[16]; unpack8(qa, qf); unpack8(qb, qf + 8);
#pragma unroll
            for (int e = 0; e < 16; ++e) a += qf[e] * n0[16 * kp + e];
            a += xorl<1>(a); a += xorl<2>(a); a += xorl<4>(a);
            if (kp == 0) nq[jq] = a;
        }
        __syncthreads();
        {
            const int jt = w & 3, vh = w >> 2, j = 16 * jt + l15;
            bf16x8 bS[2], bQ[4];
#pragma unroll
            for (int ks = 0; ks < 2; ++ks) bS[ks] = frag(Sw, PT, 16 * jt, 32 * ks, lane);
#pragma unroll
            for (int ks = 0; ks < 4; ++ks) bQ[ks] = frag(Qs, PQK, 16 * jt, 32 * ks, lane);
            const float g = gg[j], den = denp[j] + denp[64 + j] + g * nq[j];
            const float sc = 1.f / fmaxf(fabsf(den), eneg[j]);
            bf16_t* yrow = Y + (rowb + (size_t)(p0 + sg * j)) * 512 + hd * 128;
            bf16x8 fv[2][2], fc[2][4];
#pragma unroll
            for (int ks = 0; ks < 2; ++ks) fv[0][ks] = trfrag(Vs, PQK, 32 * ks, 16 * (4 * vh), lane);
#pragma unroll
            for (int ks = 0; ks < 4; ++ks) fc[0][ks] = frag(Cb, PQK, 16 * (4 * vh), 32 * ks, lane);
#pragma unroll
            for (int vi = 0; vi < 4; ++vi) {
                const int vt = 4 * vh + vi;
                if (vi < 3) {
#pragma unroll
                    for (int ks = 0; ks < 2; ++ks) fv[(vi + 1) & 1][ks] = trfrag(Vs, PQK, 32 * ks, 16 * (vt + 1), lane);
#pragma unroll
                    for (int ks = 0; ks < 4; ++ks) fc[(vi + 1) & 1][ks] = frag(Cb, PQK, 16 * (vt + 1), 32 * ks, lane); }
                __builtin_amdgcn_sched_barrier(0);
                f32x4 a1 = (f32x4){0.f, 0.f, 0.f, 0.f}, a2 = (f32x4){0.f, 0.f, 0.f, 0.f};
#pragma unroll
                for (int ks = 0; ks < 2; ++ks) a1 = MFMA16(fv[vi & 1][ks], bS[ks], a1);
#pragma unroll
                for (int ks = 0; ks < 4; ++ks) a2 = MFMA16(fc[vi & 1][ks], bQ[ks], a2);
                __builtin_amdgcn_sched_barrier(0);
                u32x2 o; o.x = pk2((a1[0] + g * a2[0]) * sc, (a1[1] + g * a2[1]) * sc); o.y = pk2((a1[2] + g * a2[2]) * sc, (a1[3] + g * a2[3]) * sc);
                *(u32x2*)(yrow + 16 * vt + 4 * l4) = o;
            }
        }
        const float decay = scl[0];
        {
            bf16x8 bV[2];
#pragma unroll
            for (int ks = 0; ks < 2; ++ks) bV[ks] = trfrag(Vs, PQK, 32 * ks, 16 * w, lane);
            bf16x8 fk[2][2];
#pragma unroll
            for (int ks = 0; ks < 2; ++ks) fk[0][ks] = trfrag(Kw, PQK, 32 * ks, 0, lane);
#pragma unroll
            for (int kt = 0; kt < 8; ++kt) {
                if (kt < 7) {
#pragma unroll
                    for (int ks = 0; ks < 2; ++ks) fk[(kt + 1) & 1][ks] = trfrag(Kw, PQK, 32 * ks, 16 * (kt + 1), lane); }
                __builtin_amdgcn_sched_barrier(0);
                f32x4 a = accC[kt] * decay;
#pragma unroll
                for (int ks = 0; ks < 2; ++ks) a = MFMA16(fk[kt & 1][ks], bV[ks], a);
                accC[kt] = a;
                __builtin_amdgcn_sched_barrier(0);
            }
            float s0_ = 0.f, s1_ = 0.f;
#pragma unroll
            for (int r = 0; r < 8; ++r) { const unsigned u = *(const LAS unsigned*)(Kw + (8 * w + r) * PQK + lane * 4); s0_ += bflo(u); s1_ += bfhi(u); }
            npart[w * 128 + 2 * lane] = s0_; npart[w * 128 + 2 * lane + 1] = s1_;
        }
        __syncthreads();
#pragma unroll
        for (int kt = 0; kt < 8; ++kt) { u32x2 o; o.x = pk2(accC[kt][0], accC[kt][1]); o.y = pk2(accC[kt][2], accC[kt][3]);
            *(LAS u32x2*)(Cb + (16 * w + l15) * PQK + (16 * kt + 4 * l4) * 2) = o; }
        if (tid < 128) { float a = 0.f;
#pragma unroll
            for (int q = 0; q < 8; ++q) a += npart[q * 128 + tid];
            n0[tid] = decay * n0[tid] + a; }
    }
    __syncthreads();
}

__device__ __forceinline__ void ssd_unit(Frame& F, int b, int hd, int dir) {
    const int tid = F.tid, lane = F.lane, w = F.wave, l15 = lane & 15, l4 = lane >> 4;
    const bf16_t* XB = (const bf16_t*)(F.ws + WS_HB); const float* GT = (const float*)(F.ws + WS_GATES);
    bf16_t* Y = dir ? (bf16_t*)(F.ws + WS_YD1) : (bf16_t*)((unsigned char*)F.p->out + OUT_YD0);
    lptr L = F.lds;
    constexpr int PP = 272, PX = 144;
    lptr Cm = L, BmW = L + 34816, Xr = L + 69632, Xs = L + 88064, Hb = L + 106496;
    LAS float* fl = (LAS float*)(L + 123904);
    LAS float *dtl = fl, *acsl = fl + 128;
    const int grp = hd >> 2;
    const float dtb = F.p->in[I_DTB][dir * 8 + hd], aneg = -__expf(F.p->in[I_ALOG][dir * 8 + hd]), dsk = F.p->in[I_SSDD][hd];
    for (int i = tid; i < 17408 / 4; i += NTHREADS) ((LAS unsigned*)Hb)[i] = 0u;
    f32x4 hacc[4];
#pragma unroll
    for (int i = 0; i < 4; ++i) hacc[i] = (f32x4){0.f, 0.f, 0.f, 0.f};
    const size_t rowb = (size_t)b * LT;
    const int sg = dir ? -1 : 1;
    const int rc = tid >> 4, cc = tid & 15, rx = tid >> 3, cx = tid & 7;
    u32x4 nC[4], nB[4], nX[2]; float ng[2];
    {
        const int p0 = dir ? 255 : 0;
#pragma unroll
        for (int i = 0; i < 4; ++i) { const bf16_t* rp = XB + (rowb + (size_t)(p0 + sg * (rc + 32 * i))) * D; nB[i] = *(const u32x4*)(rp + 512 + grp * 128 + 8 * cc); nC[i] = *(const u32x4*)(rp + 768 + grp * 128 + 8 * cc); }
#pragma unroll
        for (int i = 0; i < 2; ++i) { const bf16_t* rp = XB + (rowb + (size_t)(p0 + sg * (rx + 64 * i))) * D; nX[i] = *(const u32x4*)(rp + hd * 64 + 8 * cx); }
#pragma unroll
        for (int h2 = 0; h2 < 2; ++h2) ng[h2] = GT[(rowb + (size_t)(p0 + sg * (lane + 64 * h2))) * 16 + dir * 8 + hd];
    }
    __syncthreads();
    for (int c = 0; c < 18; ++c) {
        const int p0 = dir ? (c < 2 ? 255 - 128 * c : 2559 - 128 * c) : 128 * c;
        float dt2[2], acs2[2], de2[2];
        {
            float da[2];
#pragma unroll
            for (int h2 = 0; h2 < 2; ++h2) { dt2[h2] = softplus(ng[h2] + dtb); da[h2] = dt2[h2] * aneg; }
            acs2[0] = scan_add(da[0], lane); const float tot0 = rdlane(acs2[0], 63);
            acs2[1] = scan_add(da[1], lane) + tot0; const float aend = rdlane(acs2[1], 63);
            de2[0] = __expf(aend - acs2[0]) * dt2[0]; de2[1] = __expf(aend - acs2[1]) * dt2[1];
            if (w == 0) { dtl[lane] = dt2[0]; dtl[64 + lane] = dt2[1]; acsl[lane] = acs2[0]; acsl[64 + lane] = acs2[1]; }
        }
#pragma unroll
        for (int i = 0; i < 4; ++i) { *(LAS u32x4*)(BmW + (rc + 32 * i) * PP + cc * 16) = nB[i]; *(LAS u32x4*)(Cm + (rc + 32 * i) * PP + cc * 16) = nC[i]; }
#pragma unroll
        for (int i = 0; i < 2; ++i) {
            *(LAS u32x4*)(Xr + (rx + 64 * i) * PX + cx * 16) = nX[i];
            const float de = lane_get(i ? de2[1] : de2[0], rx);
            float xf[8]; unpack8(nX[i], xf);
            u32x4 o; o.x = pk2(xf[0] * de, xf[1] * de); o.y = pk2(xf[2] * de, xf[3] * de); o.z = pk2(xf[4] * de, xf[5] * de); o.w = pk2(xf[6] * de, xf[7] * de);
            *(LAS u32x4*)(Xs + (rx + 64 * i) * PX + cx * 16) = o;
        }
        {
            const int cn = (c < 17) ? c + 1 : c; const int pn0 = dir ? (cn < 2 ? 255 - 128 * cn : 2559 - 128 * cn) : 128 * cn;
#pragma unroll
            for (int i = 0; i < 4; ++i) { const bf16_t* rp = XB + (rowb + (size_t)(pn0 + sg * (rc + 32 * i))) * D; nB[i] = *(const u32x4*)(rp + 512 + grp * 128 + 8 * cc); nC[i] = *(const u32x4*)(rp + 768 + grp * 128 + 8 * cc); }
#pragma unroll
            for (int i = 0; i < 2; ++i) { const bf16_t* rp = XB + (rowb + (size_t)(pn0 + sg * (rx + 64 * i))) * D; nX[i] = *(const u32x4*)(rp + hd * 64 + 8 * cx); }
#pragma unroll
            for (int h2 = 0; h2 < 2; ++h2) ng[h2] = GT[(rowb + (size_t)(pn0 + sg * (lane + 64 * h2))) * 16 + dir * 8 + hd];
        }
        __syncthreads();
        f32x4 cb[8];
        {
            bf16x8 bC[4];
#pragma unroll
            for (int ks = 0; ks < 4; ++ks) bC[ks] = frag(Cm, PP, 16 * w, 32 * ks, lane);
            bf16x8 fa[2][4];
#pragma unroll
            for (int ks = 0; ks < 4; ++ks) fa[0][ks] = frag(BmW, PP, 0, 32 * ks, lane);
#pragma unroll
            for (int st = 0; st < 8; ++st) { cb[st] = (f32x4){0.f, 0.f, 0.f, 0.f};
                if (st <= w) {
                    if (st < 7 && st + 1 <= w) {
#pragma unroll
                        for (int ks = 0; ks < 4; ++ks) fa[(st + 1) & 1][ks] = frag(BmW, PP, 16 * (st + 1), 32 * ks, lane); }
                    __builtin_amdgcn_sched_barrier(0);
#pragma unroll
                    for (int ks = 0; ks < 4; ++ks) cb[st] = MFMA16(fa[st & 1][ks], bC[ks], cb[st]);
                    __builtin_amdgcn_sched_barrier(0); } }
        }
        {
            const int pt = w >> 1, nh = w & 1; const float cdec = __expf(acsl[127]);
            bf16x8 bX[4];
#pragma unroll
            for (int ks = 0; ks < 4; ++ks) bX[ks] = trfrag(Xs, PX, 32 * ks, 16 * pt, lane);
            bf16x8 fb[2][4];
#pragma unroll
            for (int ks = 0; ks < 4; ++ks) fb[0][ks] = trfrag(BmW, PP, 32 * ks, 16 * (4 * nh), lane);
#pragma unroll
            for (int ni = 0; ni < 4; ++ni) { f32x4 a = hacc[ni] * cdec;
                if (ni < 3) {
#pragma unroll
                    for (int ks = 0; ks < 4; ++ks) fb[(ni + 1) & 1][ks] = trfrag(BmW, PP, 32 * ks, 16 * (4 * nh + ni + 1), lane); }
                __builtin_amdgcn_sched_barrier(0);
#pragma unroll
                for (int ks = 0; ks < 4; ++ks) a = MFMA16(fb[ni & 1][ks], bX[ks], a);
                __builtin_amdgcn_sched_barrier(0);
                hacc[ni] = a; }
        }
        __syncthreads();
        {
            const int l = 16 * w + l15; const float al = acsl[l];
            f32x4 a4[8], d4[8];
#pragma unroll
            for (int st = 0; st < 8; ++st) { a4[st] = *(const LAS f32x4*)(acsl + 16 * st + 4 * l4); d4[st] = *(const LAS f32x4*)(dtl + 16 * st + 4 * l4); }
#pragma unroll
            for (int st = 0; st < 8; ++st) { const int s0 = 16 * st + 4 * l4; float vv[4];
#pragma unroll
                for (int r = 0; r < 4; ++r) { const int s = s0 + r; vv[r] = (s <= l) ? cb[st][r] * __expf(al - a4[st][r]) * d4[st][r] : 0.f; }
                u32x2 o; o.x = pk2(vv[0], vv[1]); o.y = pk2(vv[2], vv[3]);
                *(LAS u32x2*)(BmW + l * PP + s0 * 2) = o; }
        }
        __syncthreads();
        {
            const int l = 16 * w + l15; const float ea = __expf(acsl[l]);
            bf16x8 bW[4], bC[4];
#pragma unroll
            for (int ks = 0; ks < 4; ++ks) { bW[ks] = frag(BmW, PP, 16 * w, 32 * ks, lane); bC[ks] = frag(Cm, PP, 16 * w, 32 * ks, lane); }
            bf16_t* yrow = Y + (rowb + (size_t)(p0 + sg * l)) * 512 + hd * 64;
            bf16x8 fx[2][4], fh[2][4];
#pragma unroll
            for (int ks = 0; ks < 4; ++ks) { fx[0][ks] = trfrag(Xr, PX, 32 * ks, 0, lane); fh[0][ks] = frag(Hb, PP, 0, 32 * ks, lane); }
#pragma unroll
            for (int pt = 0; pt < 4; ++pt) {
                f32x4 a1 = (f32x4){0.f, 0.f, 0.f, 0.f}, a2 = (f32x4){0.f, 0.f, 0.f, 0.f};
                if (pt < 3) {
#pragma unroll
                    for (int ks = 0; ks < 4; ++ks) { fx[(pt + 1) & 1][ks] = trfrag(Xr, PX, 32 * ks, 16 * (pt + 1), lane); fh[(pt + 1) & 1][ks] = frag(Hb, PP, 16 * (pt + 1), 32 * ks, lane); } }
                __builtin_amdgcn_sched_barrier(0);
#pragma unroll
                for (int ks = 0; ks < 4; ++ks) { a1 = MFMA16(fx[pt & 1][ks], bW[ks], a1); a2 = MFMA16(fh[pt & 1][ks], bC[ks], a2); }
                __builtin_amdgcn_sched_barrier(0);
                float o4[4];
#pragma unroll
                for (int r = 0; r < 4; ++r) o4[r] = a1[r] + ea * a2[r];
                if (dir == 0) { const u32x2 xq = *(const LAS u32x2*)(Xr + l * PX + (16 * pt + 4 * l4) * 2);
                    o4[0] += dsk * bflo(xq.x); o4[1] += dsk * bfhi(xq.x); o4[2] += dsk * bflo(xq.y); o4[3] += dsk * bfhi(xq.y); }
                u32x2 o; o.x = pk2(o4[0], o4[1]); o.y = pk2(o4[2], o4[3]);
                *(u32x2*)(yrow + 16 * pt + 4 * l4) = o;
            }
        }
        __syncthreads();
        {
            const int pt = w >> 1, nh = w & 1;
#pragma unroll
            for (int ni = 0; ni < 4; ++ni) { u32x2 o; o.x = pk2(hacc[ni][0], hacc[ni][1]); o.y = pk2(hacc[ni][2], hacc[ni][3]);
                *(LAS u32x2*)(Hb + (16 * pt + l15) * PP + (16 * (4 * nh + ni) + 4 * l4) * 2) = o; }
        }
    }
    __syncthreads();
}

__device__ __forceinline__ void s5_unit(Frame& F, int b, int dir, int gq) {
    const int lane = F.lane, w = F.wave, nn = lane & 31, hi = lane >> 5, l15 = lane & 15, l4 = lane >> 4;
    const Params& P = *F.p;
    const bf16_t* Pb = (const bf16_t*)(F.ws + WS_P);
    bf16_t* Y = (bf16_t*)((unsigned char*)F.p->out + (dir ? OUT_YS1 : OUT_YS0));
    const int G = gq * 8 + w, dg = dir * 32 + G;
    lptr Hs = F.lds + w * 8704; constexpr int PH = 272;
    float abr[2], abi[2];
    bf16x8 bfr[4], cfr[4];
    {
        const float dt = __expf(P.in[I_S5LDT][dg]);
        float zr[2], zi[2];
#pragma unroll
        for (int s = 0; s < 2; ++s) {
            const int n = nn + 32 * s; const float are = P.in[I_S5ARE][dg * 64 + n], aim = P.in[I_S5AIM][dg * 64 + n];
            const float mag = __expf(dt * are); float rev = dt * aim * 0.15915494309189533577f; rev = rev - floorf(rev);
            abr[s] = mag * __builtin_amdgcn_cosf(rev); abi[s] = mag * __builtin_amdgcn_sinf(rev);
            const float den = are * are + aim * aim;
            zr[s] = ((abr[s] - 1.f) * are + abi[s] * aim) / den; zi[s] = (abi[s] * are - (abr[s] - 1.f) * aim) / den;
        }
#pragma unroll
        for (int ct = 0; ct < 4; ++ct) {
            const int s = ct & 1, n = nn + 32 * s; const bool im = ct >= 2;
            const float* br = P.in[I_S5BRE] + ((size_t)dg * 64 + n) * 16 + 8 * hi; const float* bi = P.in[I_S5BIM] + ((size_t)dg * 64 + n) * 16 + 8 * hi;
            float v[8];
#pragma unroll
            for (int j = 0; j < 8; ++j) v[j] = im ? (zr[s] * bi[j] + zi[s] * br[j]) : (zr[s] * br[j] - zi[s] * bi[j]);
            u32x4 o; o.x = pk2(v[0], v[1]); o.y = pk2(v[2], v[3]); o.z = pk2(v[4], v[5]); o.w = pk2(v[6], v[7]);
            bfr[ct] = __builtin_bit_cast(bf16x8, o);
        }
#pragma unroll
        for (int ks = 0; ks < 4; ++ks) {
            const int n0 = (32 * ks + 8 * l4) >> 1;
            const float* cre = P.in[I_S5CRE] + ((size_t)dg * 16 + l15) * 64 + n0; const float* cim = P.in[I_S5CIM] + ((size_t)dg * 16 + l15) * 64 + n0;
            float v[8];
#pragma unroll
            for (int j = 0; j < 4; ++j) { v[2 * j] = cre[j]; v[2 * j + 1] = -cim[j]; }
            u32x4 o; o.x = pk2(v[0], v[1]); o.y = pk2(v[2], v[3]); o.z = pk2(v[4], v[5]); o.w = pk2(v[6], v[7]);
            cfr[ks] = __builtin_bit_cast(bf16x8, o);
        }
    }
    float pwr[2][8], pwi[2][8];
#pragma unroll
    for (int s = 0; s < 2; ++s) { float pr = abr[s], pi = abi[s];
#pragma unroll
        for (int r = 0; r < 8; ++r) { pwr[s][r] = pr; pwi[s][r] = pi; const float tr = pr * abr[s] - pi * abi[s], ti = pr * abi[s] + pi * abr[s]; pr = tr; pi = ti; } }
    float sr[2] = {0.f, 0.f}, si[2] = {0.f, 0.f};
    const size_t rowb = (size_t)b * LT;
    const int rho = nn, tau_a = 16 * ((rho >> 2) & 1) + (rho & 3) + 4 * (rho >> 3);
    u32x4 unext = *(const u32x4*)(Pb + (rowb + (size_t)((dir ? 255 : 0) + (dir ? -1 : 1) * tau_a)) * NP1 + C_U + G * 16 + 8 * hi);
    for (int blk = 0; blk < 72; ++blk) {
        const int i0 = 32 * blk; const int p0 = dir ? (i0 < 256 ? 255 - i0 : 2559 - i0) : i0; const int sg = dir ? -1 : 1;
        const u32x4 ua = unext;
        { const int i1 = (blk < 71) ? 32 * (blk + 1) : i0; const int p1 = dir ? (i1 < 256 ? 255 - i1 : 2559 - i1) : i1;
          unext = *(const u32x4*)(Pb + (rowb + (size_t)(p1 + sg * tau_a)) * NP1 + C_U + G * 16 + 8 * hi); }
        const bf16x8 af = __builtin_bit_cast(bf16x8, ua);
        f32x16 acc[4];
#pragma unroll
        for (int ct = 0; ct < 4; ++ct) { f32x16 z = f32x16{}; acc[ct] = __builtin_amdgcn_mfma_f32_32x32x16_bf16(af, bfr[ct], z, 0, 0, 0);
            asm volatile("s_nop 15\n\ts_nop 15" : "+v"(acc[ct]));
        }
#pragma unroll
        for (int s = 0; s < 2; ++s) {
            float xr = hi ? 0.f : sr[s], xi = hi ? 0.f : si[s];
#pragma unroll
            for (int r = 0; r < 16; ++r) { const float nr = abr[s] * xr - abi[s] * xi + acc[s][r], ni = abr[s] * xi + abi[s] * xr + acc[2 + s][r]; xr = nr; xi = ni; acc[s][r] = nr; acc[2 + s][r] = ni; }
            float cr = lane_get(xr, nn), ci = lane_get(xi, nn);
            if (!hi) { cr = 0.f; ci = 0.f; }
#pragma unroll
            for (int r = 0; r < 8; ++r) { acc[s][r] += pwr[s][r] * cr - pwi[s][r] * ci; acc[2 + s][r] += pwr[s][r] * ci + pwi[s][r] * cr; }
            { const float tr = pwr[s][7] * cr - pwi[s][7] * ci, ti = pwr[s][7] * ci + pwi[s][7] * cr; cr = tr; ci = ti; }
#pragma unroll
            for (int r = 0; r < 8; ++r) { acc[s][8 + r] += pwr[s][r] * cr - pwi[s][r] * ci; acc[2 + s][8 + r] += pwr[s][r] * ci + pwi[s][r] * cr; }
            sr[s] = lane_get(acc[s][15], nn + 32); si[s] = lane_get(acc[2 + s][15], nn + 32);
        }
#pragma unroll
        for (int r = 0; r < 16; ++r) {
            const int tau = 16 * hi + r; lptr hp = Hs + tau * PH;
            *(LAS unsigned*)(hp + nn * 4) = pk2(acc[0][r], acc[2][r]); *(LAS unsigned*)(hp + (32 + nn) * 4) = pk2(acc[1][r], acc[3][r]);
        }
        LDS_WAIT();
#pragma unroll
        for (int tt = 0; tt < 2; ++tt) {
            f32x4 a = (f32x4){0.f, 0.f, 0.f, 0.f};
#pragma unroll
            for (int ks = 0; ks < 4; ++ks) a = MFMA16(cfr[ks], frag(Hs, PH, 16 * tt, 32 * ks, lane), a);
            const int tau = 16 * tt + l15;
            u32x2 o; o.x = pk2(a[0], a[1]); o.y = pk2(a[2], a[3]);
            *(u32x2*)(Y + (rowb + (size_t)(p0 + sg * tau)) * 512 + G * 16 + 4 * l4) = o;
        }
        LDS_WAIT();
    }
}
#undef MFMA16
}
__device__ __forceinline__ void finalize0_phase(Frame& F) {
    const bf16_t* Y0 = (const bf16_t*)(F.ws + WS_Y0); const bf16_t* Y1 = (const bf16_t*)(F.ws + WS_Y1); const bf16_t* Pb = (const bf16_t*)(F.ws + WS_P);
    bf16_t* MIX = (bf16_t*)(F.ws + WS_HB); const float* gn = F.p->in[I_MLNORM] + 8 * F.lane;
    float g[8];
#pragma unroll
    for (int e = 0; e < 8; ++e) g[e] = gn[e];
    const int r0 = wave_row0(F.bid, F.wave);
#pragma unroll 1
    for (int ri3 = 0; ri3 < ROWS_PER_WAVE; ri3 += 3) {
        u32x4 a[3], b[3], o[3];
#pragma unroll
        for (int q = 0; q < 3; ++q) { const size_t r = r0 + ri3 + q;
            a[q] = *(const u32x4*)(Y0 + r * 512 + 8 * F.lane); b[q] = *(const u32x4*)(Y1 + r * 512 + 8 * F.lane); o[q] = *(const u32x4*)(Pb + r * NP0 + C_MO + 8 * F.lane); }
#pragma unroll
        for (int q = 0; q < 3; ++q) { const size_t r = r0 + ri3 + q;
            float x[8], y[8], og[8]; mix::unpack8(a[q], x); mix::unpack8(b[q], y); mix::unpack8(o[q], og);
            float ss = 0.f;
#pragma unroll
            for (int e = 0; e < 8; ++e) { x[e] += y[e]; ss += x[e] * x[e]; }
            ss += xorl<1>(ss); ss += xorl<2>(ss); ss += xorl<4>(ss); ss += xorl<8>(ss);
            const float rstd = rsqrtf(ss * (1.f / 128.f) + NORM_EPS);
#pragma unroll
            for (int e = 0; e < 8; ++e) x[e] = x[e] * rstd * g[e] * sigmoidf_(og[e]);
            u32x4 w; w.x = pk2(x[0], x[1]); w.y = pk2(x[2], x[3]); w.z = pk2(x[4], x[5]); w.w = pk2(x[6], x[7]);
            *(u32x4*)(MIX + r * D + 8 * F.lane) = w; }
    }
}
__device__ __forceinline__ float gelu_tanh(float x) { const float a = 0.7978845608028654f * (x + 0.044715f * x * x * x); const float t = 1.f - 2.f / (1.f + __expf(2.f * a)); return 0.5f * x * (1.f + t); }
__device__ __forceinline__ void finalize1_phase(Frame& F) {
    const bf16_t* S0 = (const bf16_t*)((const unsigned char*)F.p->out + OUT_YS0); const bf16_t* S1 = (const bf16_t*)((const unsigned char*)F.p->out + OUT_YS1);
    const bf16_t* D0 = (const bf16_t*)((const unsigned char*)F.p->out + OUT_YD0); const bf16_t* D1 = (const bf16_t*)(F.ws + WS_YD1); const bf16_t* Pb = (const bf16_t*)(F.ws + WS_P);
    bf16_t* MIX = (bf16_t*)(F.ws + WS_HB); bf16_t* Gb = (bf16_t*)(F.ws + WS_G);
    float sd[8], gn[8];
#pragma unroll
    for (int e = 0; e < 8; ++e) { sd[e] = F.p->in[I_S5D][8 * F.lane + e]; gn[e] = F.p->in[I_SSDNORM][8 * F.lane + e]; }
    const int r0 = wave_row0(F.bid, F.wave);
#pragma unroll 1
    for (int ri3 = 0; ri3 < ROWS_PER_WAVE; ri3 += 3) {
        u32x4 a[3], b[3], u[3], c[3], d[3], z[3];
#pragma unroll
        for (int q = 0; q < 3; ++q) { const size_t r = r0 + ri3 + q;
            a[q] = *(const u32x4*)(S0 + r * 512 + 8 * F.lane); b[q] = *(const u32x4*)(S1 + r * 512 + 8 * F.lane); u[q] = *(const u32x4*)(Pb + r * NP1 + C_U + 8 * F.lane);
            c[q] = *(const u32x4*)(D0 + r * 512 + 8 * F.lane); d[q] = *(const u32x4*)(D1 + r * 512 + 8 * F.lane); z[q] = *(const u32x4*)(Pb + r * NP1 + C_Z + 8 * F.lane); }
#pragma unroll
        for (int q = 0; q < 3; ++q) { const size_t r = r0 + ri3 + q;
            if (row_is_ctx((int)r)) continue;
            {
                float x[8], y[8], uu[8]; mix::unpack8(a[q], x); mix::unpack8(b[q], y); mix::unpack8(u[q], uu);
#pragma unroll
                for (int e = 0; e < 8; ++e) x[e] = gelu_tanh(x[e] + y[e] + sd[e] * uu[e]);
                u32x4 w; w.x = pk2(x[0], x[1]); w.y = pk2(x[2], x[3]); w.z = pk2(x[4], x[5]); w.w = pk2(x[6], x[7]);
                *(u32x4*)(Gb + r * 512 + 8 * F.lane) = w;
            }
            {
                float x[8], y[8], zz[8]; mix::unpack8(c[q], x); mix::unpack8(d[q], y); mix::unpack8(z[q], zz);
                float ss = 0.f;
#pragma unroll
                for (int e = 0; e < 8; ++e) { x[e] = (x[e] + y[e]) * siluf_(zz[e]); ss += x[e] * x[e]; }
                const float rstd = rsqrtf(wave_sum(ss) * (1.f / 512.f) + NORM_EPS);
#pragma unroll
                for (int e = 0; e < 8; ++e) x[e] = x[e] * rstd * gn[e];
                u32x4 w; w.x = pk2(x[0], x[1]); w.y = pk2(x[2], x[3]); w.z = pk2(x[4], x[5]); w.w = pk2(x[6], x[7]);
                *(u32x4*)(MIX + r * D + 512 + 8 * F.lane) = w;
            }
        }
    }
}

__device__ __forceinline__ void conv_phase(Frame& F) {
    const bf16_t* Pb = (const bf16_t*)(F.ws + WS_P); bf16_t* XB = (bf16_t*)(F.ws + WS_HB);
    const int c0 = 16 * F.lane;
    float w0[16], w1[16], w2[16], bb[16];
#pragma unroll
    for (int e = 0; e < 16; ++e) { w0[e] = F.p->in[I_CONVW][c0 + e]; w1[e] = F.p->in[I_CONVW][1024 + c0 + e]; w2[e] = F.p->in[I_CONVW][2048 + c0 + e]; bb[e] = F.p->in[I_CONVB][c0 + e]; }
    const int r0 = wave_row0(F.bid, F.wave);
    const u32x4 z4 = (u32x4){0u, 0u, 0u, 0u};
    auto ld = [&](int r, u32x4& a, u32x4& b2) { const bf16_t* p = Pb + (size_t)r * NP1 + C_XS + c0; a = *(const u32x4*)p; b2 = *(const u32x4*)(p + 8); };
    u32x4 pa, pb, ca, cb2, na, nb;
    ld(r0 > 0 ? r0 - 1 : 0, pa, pb);
    ld(r0, ca, cb2);
#pragma unroll 1
    for (int ri = 0; ri < ROWS_PER_WAVE; ++ri) {
        const int r = r0 + ri, p = r % LT;
        ld(r + 1 < R ? r + 1 : R - 1, na, nb);
        const bool okm = (p != 0) && (p != CTXL), okp = (p != CTXL - 1) && (p != LT - 1);
        float xm[16], x0[16], xp[16];
        mix::unpack8(okm ? pa : z4, xm); mix::unpack8(okm ? pb : z4, xm + 8); mix::unpack8(ca, x0); mix::unpack8(cb2, x0 + 8); mix::unpack8(okp ? na : z4, xp); mix::unpack8(okp ? nb : z4, xp + 8);
        float y[16];
#pragma unroll
        for (int e = 0; e < 16; ++e) y[e] = siluf_(w0[e] * xm[e] + w1[e] * x0[e] + w2[e] * xp[e] + bb[e]);
        u32x4 o0, o1; o0.x = pk2(y[0], y[1]); o0.y = pk2(y[2], y[3]); o0.z = pk2(y[4], y[5]); o0.w = pk2(y[6], y[7]);
        o1.x = pk2(y[8], y[9]); o1.y = pk2(y[10], y[11]); o1.z = pk2(y[12], y[13]); o1.w = pk2(y[14], y[15]);
        bf16_t* q = XB + (size_t)r * D + c0; *(u32x4*)q = o0; *(u32x4*)(q + 8) = o1;
        pa = ca; pb = cb2; ca = na; cb2 = nb;
    }
}

#ifndef ONLY
#define ONLY -1
#endif
#ifndef REP
#define REP -1
#endif
#ifndef DUMP
#define DUMP -1
#endif
#ifndef DUMPSRC
#define DUMPSRC 0
#endif
#define PORD(k) ((k) <= 12 ? (k) : ((k) == 21 ? 13 : (k) + 1))
#define LIVE(k) (DUMP < 0 || PORD(k) <= PORD(DUMP))
#ifndef REPSEL
#define REPSEL 0
#endif
__global__ void __launch_bounds__(NTHREADS, 2) fwd_kernel(Params prm) {
    extern __shared__ __attribute__((aligned(16))) unsigned char lds[];
    Frame F;
    F.lds = (LAS unsigned char*)lds; F.MISC = (volatile LAS unsigned*)(F.lds + MISC_OFF);
    F.tid = threadIdx.x; F.lane = F.tid & 63; F.wave = __builtin_amdgcn_readfirstlane(F.tid >> 6); F.wave_s = F.wave;
    F.G = gridDim.x; F.bid = blockIdx.x; F.vcu = (F.G % 8 == 0) ? (F.bid % 8) * (F.G / 8) + F.bid / 8 : F.bid;
    F.p = &prm; F.ws = prm.ws; F.ctl = (gu32*)(prm.ws + WS_CTL);
    if (F.tid < 64) F.MISC[F.tid] = 0u;
    __syncthreads();
    XcdBarrier bar = xcd_barrier_post((unsigned*)(F.ctl + CW_BAR), F.MISC + 8, F.tid);
#define GRID_BAR() xcd_barrier(bar, opaque_tid(F.wave_s))
#ifdef TMASK
    unsigned long long tp_t0 = 0, tp_acc = 0;
#define TP_BEGIN(k) do { if (((TMASK) >> (k)) & 1) tp_t0 = __builtin_amdgcn_s_memrealtime(); } while (0)
#define TP_END(k) do { if (((TMASK) >> (k)) & 1) tp_acc += __builtin_amdgcn_s_memrealtime() - tp_t0; } while (0)
#else
#define TP_BEGIN(k) do {} while (0)
#define TP_END(k) do {} while (0)
#endif
#ifndef UBLK
#define UBLK 0
#endif
    bool ut_done4 = false;
#if defined(TMASK) && defined(USEL)
#define UT_BEGIN(k) do { if (USEL == (k) && F.bid == UBLK) tp_t0 = __builtin_amdgcn_s_memrealtime(); } while (0)
#define UT_END(k) do { if (USEL == (k) && F.bid == UBLK) tp_acc += __builtin_amdgcn_s_memrealtime() - tp_t0; } while (0)
#else
#define UT_BEGIN(k) do {} while (0)
#define UT_END(k) do {} while (0)
#endif
#define PH() do { F.tid = opaque_tid(F.wave_s); F.lane = F.tid & 63; F.wave = F.wave_s; } while (0)
    const char* ws = (const char*)prm.ws;
    const float* mod0 = (const float*)(ws + WS_MOD); const float* mod1 = mod0 + 17 * 6144;


    TP_BEGIN(0); if (LIVE(0) && (ONLY < 0 || ONLY == 0)) { for (int rep = 0; rep < ((REP == 0) ? 2 : 1); ++rep) { if (rep) GRID_BAR(); PH();
    p0_prologue(F); } }
    GRID_BAR(); TP_END(0);
    TP_BEGIN(1); if (LIVE(1) && (ONLY < 0 || ONLY == 1)) { for (int rep = 0; rep < ((REP == 1) ? 2 : 1); ++rep) { if (rep) GRID_BAR(); PH();
    norm_phase<0>(F); } }
    GRID_BAR(); TP_END(1);
    TP_BEGIN(2); if (LIVE(2) && (ONLY < 0 || ONLY == 2)) { for (int rep = 0; rep < ((REP == 2) ? 2 : 1); ++rep) { if (rep) GRID_BAR(); PH();
    {
        pg8::Gemm g{D, D, D}; pg8::DenseSched<false> S{ws + WS_HB, ws + WS_WIN0, NP0 / 256 + 1, F.G, F.bid, (size_t)256 * D * 2, (size_t)256 * D * 2};
        pg8::EpiStoreBf16 E{(bf16_t*)(prm.ws + WS_P), NP0, NP0 / 256, (float*)(prm.ws + WS_GATES), 0};
        pg8::gemm_phase<pg8::EpiStoreBf16, pg8::DenseSched<false>, true>(F.lds, g, S, E, F.wave_s);
    }
    } }
    GRID_BAR(); TP_END(2);
    TP_BEGIN(3); if (LIVE(3) && (ONLY < 0 || ONLY == 3)) { for (int rep = 0; rep < ((REP == 3) ? 2 : 1); ++rep) { if (rep) GRID_BAR(); PH();
    knorm_phase(F); } }
    GRID_BAR(); TP_END(3);
    TP_BEGIN(4); if (LIVE(4) && (ONLY < 0 || ONLY == 4 || ONLY == 40 || ONLY == 41)) { for (int rep = 0; rep < ((REP == 4) ? 2 : 1); ++rep) { if (rep) GRID_BAR(); PH();
    {
        if (ONLY != 41 && !(rep == 1 && REPSEL == 2) && F.bid < 128) {
            UT_BEGIN(3); const int u = F.bid;
            mix::mlstm_unit(F, u >> 3, (u >> 1) & 3, u & 1); UT_END(3);
        }
        if (ONLY != 40 && !(rep == 1 && REPSEL == 1)) for (;;) {
            const int a = q_next(F, 1 + 4 * rep);
            if (a >= 1152) break;
            int b, h, qb;
            if (a < 1024) { qb = 1 + (a & 7); b = a >> 6; h = ((a >> 5) & 1) * 4 + ((a >> 3) & 3); } else { const int a2 = a - 1024; b = a2 >> 3; h = a2 & 7; qb = 0; }
            const bool tm_ = (a < 1024) && (F.bid == UBLK) && !ut_done4; if (tm_) { UT_BEGIN(4); }
            attn_body::attn_unit<8>(b, h, qb, (const bf16_t*)(prm.ws + WS_P), (bf16_t*)(prm.ws + WS_HB), prm.in[I_QNORM], (char*)lds, F.wave_s);
            if (tm_) { UT_END(4); ut_done4 = true; }
        }
    }
    } }
    GRID_BAR(); TP_END(4);
    TP_BEGIN(5); if (LIVE(5) && (ONLY < 0 || ONLY == 5)) { for (int rep = 0; rep < ((REP == 5) ? 2 : 1); ++rep) { if (rep) GRID_BAR(); PH();
    finalize0_phase(F); } }
    GRID_BAR(); TP_END(5);
    TP_BEGIN(6); if (LIVE(6) && (ONLY < 0 || ONLY == 6)) { for (int rep = 0; rep < ((REP == 6) ? 2 : 1); ++rep) { if (rep) GRID_BAR(); PH();
    {
        pg8::Gemm g{D, D, D}; pg8::DenseSched<false> S{ws + WS_HB, ws + WS_WOUT0, 4, F.G, F.bid, (size_t)256 * D * 2, (size_t)256 * D * 2};
        pg8::EpiResid<true> E{prm.in[I_X], prm.in[I_CTX], (bf16_t*)(prm.ws + WS_XR), mod0 + 2048};
        pg8::gemm_phase<pg8::EpiResid<true>, pg8::DenseSched<false>, true>(F.lds, g, S, E, F.wave_s);
        if (false) { PH(); tr_list_range<1>(F, 0, TRL1 / 2, (F.bid - 64) * NWAVES + F.wave, 192 * NWAVES); }
    }
    } }
    GRID_BAR(); TP_END(6);
    TP_BEGIN(7); if (LIVE(7) && (ONLY < 0 || ONLY == 7)) { for (int rep = 0; rep < ((REP == 7) ? 2 : 1); ++rep) { if (rep) GRID_BAR(); PH();
    norm_phase<1>(F); } }
    GRID_BAR(); TP_END(7);
    TP_BEGIN(8); if (LIVE(8) && (ONLY < 0 || ONLY == 8)) { for (int rep = 0; rep < ((REP == 8) ? 2 : 1); ++rep) { if (rep) GRID_BAR(); PH();
    route_phase<0>(F); } }
    GRID_BAR(); TP_END(8);
    TP_BEGIN(9); if (LIVE(9) && (ONLY < 0 || ONLY == 9)) { for (int rep = 0; rep < ((REP == 9) ? 2 : 1); ++rep) { if (rep) GRID_BAR(); PH();
    {
        MoeTab T = moe_tables(F, F.lds + 131072, false);
        pg8::Gemm g{D, D, D}; pg8::MoeSched S{ws + WS_HB, ws + WS_GU0, 8, F.G, F.bid, T.ntile[0], T.base, false, (const int*)(ws + WS_ROUTE + RT_TOK)};
        pg8::EpiSwiGlu E{(bf16_t*)(prm.ws + WS_ACT), (const float*)(ws + WS_ROUTE + RT_WPOS)};
        pg8::gemm_phase<pg8::EpiSwiGlu, pg8::MoeSched, true, true>(F.lds, g, S, E, F.wave_s);
    }
    } }
    GRID_BAR(); TP_END(9);
    TP_BEGIN(10); if (LIVE(10) && (ONLY < 0 || ONLY == 10)) { for (int rep = 0; rep < ((REP == 10) ? 2 : 1); ++rep) { if (rep) GRID_BAR(); PH();
    {
        MoeTab T = moe_tables(F, F.lds + 131072, false);
        pg8::Gemm g{D, 512, D}; pg8::MoeSched S{ws + WS_ACT, ws + WS_D0, 4, F.G, F.bid, T.ntile[0], T.base, true, (const int*)(ws + WS_ROUTE + RT_TOK)};
        pg8::EpiDown<false> E{(const int*)(ws + WS_ROUTE + RT_TOK), prm.out, (bf16_t*)(prm.ws + WS_XR), mod0 + 5120};
        pg8::gemm_phase<pg8::EpiDown<false>, pg8::MoeSched, true>(F.lds, g, S, E, F.wave_s);
        {
            const int nu = 4 * T.ntile[0]; int third = nu - 2 * F.G; third = third < 0 ? 0 : (third > F.G - 32 ? F.G - 32 : third);
            if (false) { PH(); tr_list_range<1>(F, TRL1 / 2, TRL1, (F.bid - third) * NWAVES + F.wave, (F.G - third) * NWAVES); }
        }
    }
    } }
    GRID_BAR(); TP_END(10);
    TP_BEGIN(11); if (LIVE(11) && (ONLY < 0 || ONLY == 11)) { for (int rep = 0; rep < ((REP == 11) ? 2 : 1); ++rep) { if (rep) GRID_BAR(); PH();
    norm_phase<2>(F); } }
    GRID_BAR(); TP_END(11);
    TP_BEGIN(12); if (LIVE(12) && (ONLY < 0 || ONLY == 12)) { for (int rep = 0; rep < ((REP == 12) ? 2 : 1); ++rep) { if (rep) GRID_BAR(); PH();
    {
        pg8::Gemm g{D, D, D}; pg8::InProj1Sched S{ws + WS_HB, ws + WS_WIN1, F.G, F.bid, (size_t)256 * D * 2, (size_t)256 * D * 2};
        pg8::EpiStoreBf16 E{(bf16_t*)(prm.ws + WS_P), NP1, NP1 / 256, (float*)(prm.ws + WS_GATES), 2};
        pg8::gemm_phase<pg8::EpiStoreBf16, pg8::InProj1Sched, true>(F.lds, g, S, E, F.wave_s);
    }
    } }
    GRID_BAR(); TP_END(12);
    TP_BEGIN(21); if (LIVE(21) && (ONLY < 0 || ONLY == 21)) { for (int rep = 0; rep < ((REP == 21) ? 2 : 1); ++rep) { if (rep) GRID_BAR(); PH();
    conv_phase(F); } }
    GRID_BAR(); TP_END(21);
    TP_BEGIN(13); if (LIVE(13) && (ONLY < 0 || ONLY == 13 || ONLY == 130 || ONLY == 131)) { for (int rep = 0; rep < ((REP == 13) ? 2 : 1); ++rep) { if (rep) GRID_BAR(); PH();
    {
        if (ONLY != 131 && !(rep == 1 && REPSEL == 2) && F.bid < 128) {
            UT_BEGIN(1); const int u = F.bid;
            mix::s5_unit(F, u >> 3, (u >> 2) & 1, u & 3); UT_END(1);
        }
        if (ONLY != 130 && !(rep == 1 && REPSEL == 1)) for (int it = 0;; ++it) {
            const int a = q_next(F, 3 + 4 * rep);
            if (a >= 256) break;
            if (it == 0) UT_BEGIN(2);
            mix::ssd_unit(F, a >> 4, (a >> 1) & 7, a & 1);
            if (it == 0) UT_END(2);
        }
    }
    } }
    GRID_BAR(); TP_END(13);
    TP_BEGIN(14); if (LIVE(14) && (ONLY < 0 || ONLY == 14)) { for (int rep = 0; rep < ((REP == 14) ? 2 : 1); ++rep) { if (rep) GRID_BAR(); PH();
    finalize1_phase(F); } }
    GRID_BAR(); TP_END(14);
    TP_BEGIN(15); if (LIVE(15) && (ONLY < 0 || ONLY == 15)) { for (int rep = 0; rep < ((REP == 15) ? 2 : 1); ++rep) { if (rep) GRID_BAR(); PH();
    {
        pg8::Gemm g{512, 512, 512}; pg8::DenseSched<true> S{ws + WS_G, ws + WS_WGLU, 2, F.G, F.bid, (size_t)256 * 512 * 2, (size_t)256 * 512 * 2};
        pg8::EpiGlu E{(const bf16_t*)(ws + WS_G), (bf16_t*)(prm.ws + WS_HB), prm.in[I_GLUB]};
        pg8::gemm_phase<pg8::EpiGlu, pg8::DenseSched<true>, true>(F.lds, g, S, E, F.wave_s);
    }
    } }
    GRID_BAR(); TP_END(15);
    TP_BEGIN(16); if (LIVE(16) && (ONLY < 0 || ONLY == 16)) { for (int rep = 0; rep < ((REP == 16) ? 2 : 1); ++rep) { if (rep) GRID_BAR(); PH();
    {
        pg8::Gemm g{D, D, D}; pg8::DenseSched<true> S{ws + WS_HB, ws + WS_WOUT1, 4, F.G, F.bid, (size_t)256 * D * 2, (size_t)256 * D * 2};
        pg8::EpiResid<false> E{prm.in[I_X], prm.in[I_CTX], (bf16_t*)(prm.ws + WS_XR), mod1 + 2048};
        pg8::gemm_phase<pg8::EpiResid<false>, pg8::DenseSched<true>, true>(F.lds, g, S, E, F.wave_s);
    }
    } }
    GRID_BAR(); TP_END(16);
    TP_BEGIN(17); if (LIVE(17) && (ONLY < 0 || ONLY == 17)) { for (int rep = 0; rep < ((REP == 17) ? 2 : 1); ++rep) { if (rep) GRID_BAR(); PH();
    norm_phase<3>(F); } }
    GRID_BAR(); TP_END(17);
    TP_BEGIN(18); if (LIVE(18) && (ONLY < 0 || ONLY == 18)) { for (int rep = 0; rep < ((REP == 18) ? 2 : 1); ++rep) { if (rep) GRID_BAR(); PH();
    route_phase<1>(F); } }
    GRID_BAR(); TP_END(18);
    TP_BEGIN(19); if (LIVE(19) && (ONLY < 0 || ONLY == 19)) { for (int rep = 0; rep < ((REP == 19) ? 2 : 1); ++rep) { if (rep) GRID_BAR(); PH();
    {
        MoeTab T = moe_tables(F, F.lds + 131072, false);
        pg8::Gemm g{D, D, D}; pg8::MoeSched S{ws + WS_HB, ws + WS_GU1, 8, F.G, F.bid, T.ntile[0], T.base, false, (const int*)(ws + WS_ROUTE + RT_TOK)};
        pg8::EpiSwiGlu E{(bf16_t*)(prm.ws + WS_ACT), (const float*)(ws + WS_ROUTE + RT_WPOS)};
        pg8::gemm_phase<pg8::EpiSwiGlu, pg8::MoeSched, true, true>(F.lds, g, S, E, F.wave_s);
    }
    } }
    GRID_BAR(); TP_END(19);
    TP_BEGIN(20); if (LIVE(20) && (ONLY < 0 || ONLY == 20)) { for (int rep = 0; rep < ((REP == 20) ? 2 : 1); ++rep) { if (rep) GRID_BAR(); PH();
    {
        MoeTab T = moe_tables(F, F.lds + 131072, false);
        pg8::Gemm g{D, 512, D}; pg8::MoeSched S{ws + WS_ACT, ws + WS_D1, 4, F.G, F.bid, T.ntile[0], T.base, true, (const int*)(ws + WS_ROUTE + RT_TOK)};
        pg8::EpiDown<true> E{(const int*)(ws + WS_ROUTE + RT_TOK), prm.out, (bf16_t*)(prm.ws + WS_XR), mod1 + 5120};
        pg8::gemm_phase<pg8::EpiDown<true>, pg8::MoeSched, true>(F.lds, g, S, E, F.wave_s);
    }
} }
    GRID_BAR(); TP_END(20);
#ifdef EXTRA_BARS
    for (int i = 0; i < EXTRA_BARS; ++i) GRID_BAR();
#endif
#ifdef FINALHASH
    {
        PH();
        for (size_t i = (size_t)F.bid * NTHREADS + F.tid; i < (size_t)NBATCH * SEQ * D / 4; i += (size_t)GRID * NTHREADS) {
            const u32x4 w = ((const u32x4*)prm.out)[i];
            auto hsh = [](unsigned v) -> float { return (float)(((v * 2654435761u) >> 12) & 0xFFFFu) * (1.f / 65536.f); };
            ((f32x4*)prm.out)[i] = (f32x4){hsh(w.x), hsh(w.y), hsh(w.z), hsh(w.w)};
        }
    }
#endif
    if (DUMP >= 0) {
        PH();
#ifdef DUMPCOPY
        {
            const u32x4* src = (const u32x4*)((const unsigned char*)prm.out + (DUMPCOPY ? OUT_YS1 : OUT_YS0)); u32x4* dst = (u32x4*)(prm.ws + WS_G);
            for (size_t i = (size_t)F.bid * NTHREADS + F.tid; i < (size_t)R * 512 * 2 / 16; i += (size_t)GRID * NTHREADS) dst[i] = src[i];
            GRID_BAR(); PH();
        }
#endif
        const bf16_t* sb = (const bf16_t*)(prm.ws + (DUMPSRC == 0 ? WS_XR : (DUMPSRC == 1 ? WS_HB : (DUMPSRC == 2 ? WS_P : WS_G))));
        constexpr int spitch = (DUMPSRC == 2) ? NP1 : ((DUMPSRC == 3) ? 512 : D);
        for (size_t i = (size_t)F.bid * NTHREADS + F.tid; i < (size_t)NBATCH * SEQ * D / 4; i += (size_t)GRID * NTHREADS) {
            const size_t e = i * 4; const int col = (int)(e % D); const size_t tr = e / D; const int b = (int)(tr / SEQ), t = (int)(tr % SEQ);
            const size_t r = (size_t)b * LT + CTXL + t;
            const int c2 = (DUMPSRC == 3) ? (col & 511) : col;
            if (DUMPSRC == 5) { const u32x2 w = *(const u32x2*)((const bf16_t*)(prm.ws + WS_ACT) + e); ((f32x4*)prm.out)[i] = (f32x4){bflo(w.x), bfhi(w.x), bflo(w.y), bfhi(w.y)}; continue; }
            if (DUMPSRC == 7) { const int* cg = (const int*)(prm.ws + WS_ROUTE + RT_CNT); f32x4 o = {0.f, 0.f, 0.f, 0.f};
                if (i < 1536) o = (f32x4){(float)cg[4 * i], (float)cg[4 * i + 1], (float)cg[4 * i + 2], (float)cg[4 * i + 3]};
                ((f32x4*)prm.out)[i] = o; continue; }
            if (DUMPSRC == 8) { f32x4 o = {0.f, 0.f, 0.f, 0.f}; const int* clsg = (const int*)(prm.ws + WS_ROUTE + RT_CLS); const float* wts = (const float*)(prm.ws + WS_ROUTE + RT_WTS);
                auto hs8 = [](unsigned v) -> float { return (float)(((v * 2654435761u) >> 12) & 0xFFFFu) * (1.f / 65536.f); };
                if (col == 0) o = (f32x4){hs8((unsigned)clsg[r]), hs8(__float_as_uint(wts[2 * r])), hs8(__float_as_uint(wts[2 * r + 1])), 0.f};
                ((f32x4*)prm.out)[i] = o; continue; }
            if (DUMPSRC == 6) { f32x4 o = {0.f, 0.f, 0.f, 0.f}; const int idx = b * SEQ + t;
                const int* clsg = (const int*)(prm.ws + WS_ROUTE + RT_CLS); const float* wts = (const float*)(prm.ws + WS_ROUTE + RT_WTS);
                const int* tok = (const int*)(prm.ws + WS_ROUTE + RT_TOK); const float* wpos = (const float*)(prm.ws + WS_ROUTE + RT_WPOS);
                if (col == 0) o = (f32x4){(float)clsg[r], wts[2 * r], wts[2 * r + 1], (float)tok[idx]};
                else if (col == 4) o = (f32x4){0.f, wpos[2 * (size_t)idx], wpos[2 * (size_t)idx + 1], 0.f};
                ((f32x4*)prm.out)[i] = o; continue; }
            const u32x2 w = *(const u32x2*)(sb + r * spitch + c2);
#ifdef DUMPHASH
            { auto hsh = [](unsigned v) -> float { return (float)(((v * 2654435761u) >> 12) & 0xFFFFu) * (1.f / 65536.f); };
              ((f32x4*)prm.out)[i] = (f32x4){hsh(w.x & 0xffffu), hsh(w.x >> 16), hsh(w.y & 0xffffu), hsh(w.y >> 16)}; continue; }
#endif
            ((f32x4*)prm.out)[i] = (f32x4){bflo(w.x), bfhi(w.x), bflo(w.y), bfhi(w.y)};
        }
    }
#ifdef BWTEST
    {
        GRID_BAR();
        const unsigned long long tb0 = __builtin_amdgcn_s_memrealtime();
        PH();
        const f32x4* src = (const f32x4*)prm.in[I_X]; f32x4* dst = (f32x4*)(prm.ws + WS_P);
        const size_t n4 = (size_t)NBATCH * SEQ * D / 4; const size_t stride = (size_t)GRID * NTHREADS;
        for (size_t i = (size_t)F.bid * NTHREADS + F.tid; i < n4; i += stride * BWTEST) {
            f32x4 v[BWTEST];
#pragma unroll
            for (int u = 0; u < BWTEST; ++u) v[u] = (i + u * stride < n4) ? src[i + u * stride] : (f32x4){0.f, 0.f, 0.f, 0.f};
#pragma unroll
            for (int u = 0; u < BWTEST; ++u) if (i + u * stride < n4) dst[i + u * stride] = v[u];
        }
        GRID_BAR();
        tp_acc += __builtin_amdgcn_s_memrealtime() - tb0;
    }
#endif
#ifdef TMASK
    if (F.bid == UBLK) { const unsigned long long t_end = __builtin_amdgcn_s_memrealtime() + (unsigned long long)(TAMP) * tp_acc; while (__builtin_amdgcn_s_memrealtime() < t_end) __builtin_amdgcn_s_sleep(32); }
#endif
#undef GRID_BAR
}

extern "C" void kernel_launch(void* const* d_in, const int* in_sizes, int n_in, void* d_out, int out_size, void* d_ws, size_t ws_size, hipStream_t stream) {
    static int ready = 0;
    if (ready == 0) {
        if (n_in != 39 || out_size != NBATCH * SEQ * D || ws_size < WS_END) { fprintf(stderr, "kernel_launch: unexpected problem (n_in %d, out %d, ws %zu); nothing launched\n", n_in, out_size, ws_size); ready = -1; return; }
        if (hipFuncSetAttribute((const void*)fwd_kernel, hipFuncAttributeMaxDynamicSharedMemorySize, LDS_BYTES) != hipSuccess) { fprintf(stderr, "kernel_launch: hipFuncSetAttribute failed\n"); ready = -1; return; }
        int per_cu = 0;
        if (hipOccupancyMaxActiveBlocksPerMultiprocessor(&per_cu, (const void*)fwd_kernel, NTHREADS, LDS_BYTES) != hipSuccess || per_cu < 1) fprintf(stderr, "kernel_launch: occupancy query reports %d workgroups per CU\n", per_cu);
        (void)hipGetLastError();
        ready = 1;
    }
    if (ready < 0) return;
    (void)in_sizes;
    if (hipMemsetAsync((char*)d_ws + WS_CTL, 0, CTL_ZERO_BYTES, stream) != hipSuccess) return;
    Params p{};
    for (int i = 0; i < 39; ++i) p.in[i] = (const float*)d_in[i];
    p.out = (float*)d_out; p.ws = (unsigned char*)d_ws;
    hipLaunchKernelGGL(fwd_kernel, dim3(GRID), dim3(NTHREADS), LDS_BYTES, stream, p);
}
```

```cpp
#include <hip/hip_runtime.h>
#ifndef PRO_X
#define PRO_X 2048
#endif
#ifndef DEFER_L1
#define DEFER_L1 1
#endif
#include <hip/hip_bf16.h>
#include <cstdio>
#include <cstdint>
#include <cmath>

constexpr int D = 1024, NBATCH = 16, SEQ = 2048, CTXL = 256, LT = CTXL + SEQ  , R = NBATCH * LT  ;
constexpr int NP0 = 2816;
constexpr int NP1 = 2048;
constexpr int C_MQ = 0, C_MK = 512, C_MV = 1024, C_MO = 1536, C_AQ = 2048, C_AK = 2560, C_AV = 2688;
constexpr int C_U = 0, C_Z = 512, C_XS = 1024, C_B = 1536, C_C = 1792;
constexpr int NWAVES = 8, NTHREADS = 512, GRID = 256;
constexpr int ROWS_PER_WG = R / GRID  , ROWS_PER_WAVE = ROWS_PER_WG / NWAVES  ;
constexpr int NCLS = 24, MAXPOS = 43008  ;
constexpr float NORM_EPS = 1e-6f;

constexpr size_t MiB = 1u << 20;
constexpr size_t WS_CTL = 0, CTL_ZERO_BYTES = 64 * 1024;
constexpr size_t WS_MOD = 1 * MiB;
constexpr size_t WS_MODB = 256 * 1024;
constexpr size_t WS_WIN0 = 2 * MiB, WS_WOUT0 = 8 * MiB, WS_WIN1 = 10 * MiB  , WS_WOUT1 = 14 * MiB + 512 * 1024, WS_WGLU = 16 * MiB + 512 * 1024;
constexpr size_t WS_GU0 = 18 * MiB, WS_D0 = 50 * MiB, WS_GU1 = 66 * MiB, WS_D1 = 98 * MiB;
constexpr size_t WS_GATES = 114 * MiB;
constexpr size_t WS_ROUTE = 117 * MiB;
constexpr size_t WS_XR = 404 * MiB;
constexpr size_t WS_HB = 134 * MiB;
constexpr size_t WS_P = 206 * MiB;
constexpr size_t WS_Y0 = 404 * MiB, WS_Y1 = 440 * MiB;
constexpr size_t OUT_YS0 = 0, OUT_YS1 = 36 * MiB, OUT_YD0 = 72 * MiB  , WS_YD1 = 350 * MiB;
constexpr size_t WS_G = WS_GU0;
constexpr size_t WS_H2S = WS_P, WS_ACT = WS_P + 84 * MiB;
constexpr size_t WS_END = 494 * MiB;
constexpr size_t RT_CLS = 0, RT_WTS = 147456, RT_CNT = RT_WTS + 294912, RT_TOK = RT_CNT + 24576, RT_WPOS = RT_TOK + 172032;
constexpr int CW_BAR = 4096, CW_Q = 8192;
constexpr int CW_GC = 12288;
constexpr int RCAP = 36864;
constexpr size_t RT_TOK2 = 1 * MiB, RT_WPOS2 = RT_TOK2 + (size_t)24 * RCAP * 4;

constexpr int SCRATCH_BYTES = 155648;
constexpr int MISC_OFF = SCRATCH_BYTES;
constexpr int LDS_BYTES = SCRATCH_BYTES + 256;

#define GAS __attribute__((address_space(1)))
#define LAS __attribute__((address_space(3)))
typedef unsigned short bf16_t;
typedef short bf16x8 __attribute__((ext_vector_type(8)));
typedef short s16x4 __attribute__((ext_vector_type(4)));
typedef float f32x4 __attribute__((ext_vector_type(4)));
typedef float f32x16 __attribute__((ext_vector_type(16)));
typedef unsigned u32x4 __attribute__((ext_vector_type(4)));
typedef unsigned u32x2 __attribute__((ext_vector_type(2)));
typedef float f32x2_t __attribute__((ext_vector_type(2)));
typedef __bf16 bf16x2_t __attribute__((ext_vector_type(2)));
typedef GAS unsigned gu32;

__device__ __forceinline__ unsigned pk2(float lo, float hi) { f32x2_t v = {lo, hi}; bf16x2_t b = __builtin_convertvector(v, bf16x2_t); return __builtin_bit_cast(unsigned, b); }
__device__ __forceinline__ unsigned short f2bf(float f) { return (unsigned short)(pk2(f, 0.f) & 0xffffu); }
__device__ __forceinline__ float bflo(unsigned u) { return __uint_as_float(u << 16); }
__device__ __forceinline__ float bfhi(unsigned u) { return __uint_as_float(u & 0xffff0000u); }
__device__ __forceinline__ float bf2f(unsigned short u) { return __uint_as_float(((unsigned)u) << 16); }
template <int CTRL, int ROWMASK = 0xf> __device__ __forceinline__ float dppf(float v) { return __int_as_float(__builtin_amdgcn_update_dpp(0, __float_as_int(v), CTRL, ROWMASK, 0xf, false)); }
template <int M> __device__ __forceinline__ float xorl(float v) {
    if constexpr (M == 1) return dppf<0xB1>(v);
    else if constexpr (M == 2) return dppf<0x4E>(v);
    else if constexpr (M == 32) { const auto rr = __builtin_amdgcn_permlane32_swap(__float_as_uint(v), __float_as_uint(v), false, false);
        const unsigned a = rr[0], b = rr[1]; const unsigned own = __float_as_uint(v); return __uint_as_float(a == own ? b : a) ; }
    else return __int_as_float(__builtin_amdgcn_ds_swizzle(__float_as_int(v), 0x1F | (M << 10)));
}
__device__ __forceinline__ float rdlane(float v, int l) { return __int_as_float(__builtin_amdgcn_readlane(__float_as_int(v), l)); }
__device__ __forceinline__ float wave_sum(float v) {
    v += dppf<0xB1>(v); v += dppf<0x4E>(v); v += dppf<0x141>(v); v += dppf<0x140>(v);
    const float r0 = rdlane(v, 0), r1 = rdlane(v, 16), r2 = rdlane(v, 32), r3 = rdlane(v, 48);
    return (r0 + r1) + (r2 + r3);
}
__device__ __forceinline__ float lane_get(float v, int idx) { return __int_as_float(__builtin_amdgcn_ds_bpermute(idx << 2, __float_as_int(v))); }
__device__ __forceinline__ int lane_geti(int v, int idx) { return __builtin_amdgcn_ds_bpermute(idx << 2, v); }
__device__ __forceinline__ float sigmoidf_(float x) { return __builtin_amdgcn_rcpf(1.f + __expf(-x)); }
__device__ __forceinline__ float siluf_(float x) { return x * __builtin_amdgcn_rcpf(1.f + __expf(-x)); }
__device__ __forceinline__ int opaque_tid(int wave_s) { int l; asm volatile("v_mbcnt_lo_u32_b32 %0, -1, 0\n\tv_mbcnt_hi_u32_b32 %0, -1, %0" : "=v"(l)); return (wave_s << 6) | l; }
#define LDS_WAIT() asm volatile("s_waitcnt lgkmcnt(0)" ::: "memory")
#define VM_WAIT() asm volatile("s_waitcnt vmcnt(0)" ::: "memory")

__device__ __forceinline__ int wave_row0(int bid, int w) { return bid * ROWS_PER_WG + w * ROWS_PER_WAVE; }
__device__ __forceinline__ bool row_is_ctx(int r) { return (r % LT) < CTXL; }

#define XB_TMO      128
#define XB_XCNT(j)  (256  + 64 * (j))
#define XB_XSUB(j)  (1280 + 64 * (j))
#define XB_XGEN(j)  (2304 + 64 * (j))
#define XB_TOP      3328
#define XB_TOPGEN   3392
#define XCD_BAR_WORDS 3456
#define XB_SPIN_CAP (1u << 22)

__device__ __forceinline__ unsigned xb_ld(unsigned* p)              { return __hip_atomic_load(p, __ATOMIC_RELAXED, __HIP_MEMORY_SCOPE_AGENT); }
__device__ __forceinline__ unsigned xb_add(unsigned* p, unsigned v) { return __hip_atomic_fetch_add(p, v, __ATOMIC_RELAXED, __HIP_MEMORY_SCOPE_AGENT); }
__device__ __forceinline__ unsigned xb_xcc_id() { return (unsigned)__builtin_amdgcn_s_getreg((3 << 11) | 20) & 0xFu; }
#define XB_SPIN(cond, bar) do { unsigned _sp = 0; while (cond) { __builtin_amdgcn_s_sleep(1); \
    if ((++_sp & 255u) == 0u) { if (xb_ld(&(bar)[XB_TMO])) break; if (_sp > XB_SPIN_CAP) { atomicAdd(&(bar)[XB_TMO], 1u); break; } } } } while (0)

struct XcdBarrier { unsigned* bar; volatile LAS unsigned* st; };

__device__ __forceinline__ XcdBarrier xcd_barrier_post(unsigned* bar, volatile LAS unsigned* st, int tid) {
    XcdBarrier b; b.bar = bar; b.st = st;
    if (tid == 0) (void)xb_add(&bar[XB_XCNT(xb_xcc_id())], 1u);
    return b;
}
__device__ __forceinline__ void xcd_barrier_complete(unsigned* bar, unsigned x, unsigned& nloc, unsigned& nx) {
    const unsigned G = gridDim.x * gridDim.y * gridDim.z;
    unsigned sum, cnt, mine, sp = 0u;
    for (;;) {
        sum = 0u; cnt = 0u; mine = 0u;
#pragma unroll
        for (unsigned j = 0; j < 16; ++j) { const unsigned c = xb_ld(&bar[XB_XCNT(j)]); sum += c; cnt += (c > 0u) ? 1u : 0u; mine = (j == x) ? c : mine; }
        if (sum == G) break;
        __builtin_amdgcn_s_sleep(1);
        if ((++sp & 255u) == 0u) { if (xb_ld(&bar[XB_TMO])) break; if (sp > XB_SPIN_CAP) { atomicAdd(&bar[XB_TMO], 1u); break; } }
    }
    nloc = mine > 0u ? mine : 1u; nx = cnt > 0u ? cnt : 1u;
}
__device__ __forceinline__ void xcd_barrier(const XcdBarrier& b, int tid) {
    asm volatile("s_waitcnt vmcnt(0)" ::: "memory");
    __syncthreads();
    if (tid == 0) {
        unsigned* bar = b.bar; const unsigned bx = xb_xcc_id();
        __builtin_amdgcn_s_waitcnt(0);
        unsigned nloc = b.st[0], nx = b.st[1];
        if (nloc == 0u) { xcd_barrier_complete(bar, bx, nloc, nx); b.st[0] = nloc; b.st[1] = nx; }
        const unsigned old = xb_add(&bar[XB_XSUB(bx)], 1u);
        const unsigned gen = old / nloc;
        if (old + 1u == (gen + 1u) * nloc) {
            __builtin_amdgcn_fence(__ATOMIC_RELEASE, "agent");
            asm volatile("s_waitcnt vmcnt(0)" ::: "memory");
            const unsigned og = xb_add(&bar[XB_TOP], 1u);
            const unsigned tg = og / nx;
            if (og + 1u == (tg + 1u) * nx) xb_add(&bar[XB_TOPGEN], 1u);
            else XB_SPIN(xb_ld(&bar[XB_TOPGEN]) == tg, bar);
            __builtin_amdgcn_fence(__ATOMIC_ACQUIRE, "agent");
            xb_add(&bar[XB_XGEN(bx)], 1u);
            asm volatile("s_waitcnt vmcnt(0)" ::: "memory");
        } else {
            XB_SPIN(xb_ld(&bar[XB_XGEN(bx)]) == gen, bar);
            __builtin_amdgcn_fence(__ATOMIC_ACQUIRE, "agent");
            asm volatile("s_waitcnt vmcnt(0)" ::: "memory");
        }
    }
    __syncthreads();
}

struct Params { const float* in[39]; float* out; unsigned char* ws; };
enum { I_X = 0, I_C, I_CTX, I_CCTX, I_ADAW, I_ADAB, I_NMIX, I_NFFN, I_EVWIN, I_EVWOUT, I_MLGB, I_MLNORM, I_QNORM, I_KNORM, I_ODWIN, I_ODWOUT,
       I_S5ARE, I_S5AIM, I_S5LDT, I_S5BRE, I_S5BIM, I_S5CRE, I_S5CIM, I_S5D, I_GLUW, I_GLUB, I_CONVW, I_CONVB, I_DTB, I_ALOG, I_SSDD, I_SSDNORM,
       I_GRW, I_GRB, I_ERW, I_ERB, I_WG, I_WU, I_WD };

struct Frame {
    LAS unsigned char* lds; volatile LAS unsigned* MISC; gu32* ctl;
    int tid, lane, wave, vcu, G, bid, wave_s;
    const Params* p; unsigned char* ws;
};
__device__ __forceinline__ bf16_t* xr_row(const Frame& F, int r) { return (bf16_t*)(F.ws + WS_XR) + (size_t)r * D; }
__device__ __forceinline__ const float* xin_row(const Frame& F, int r) {
    const int b = r / LT, p = r % LT;
    return p < CTXL ? F.p->in[I_CTX] + ((size_t)(b * CTXL + p)) * D : F.p->in[I_X] + ((size_t)(b * SEQ + p - CTXL)) * D;
}
__device__ __forceinline__ int q_next(Frame& F, int q) {
    __syncthreads();
    if (F.tid == 0) F.MISC[16] = __hip_atomic_fetch_add((unsigned*)(F.ctl + CW_Q + 64 * q), 1u, __ATOMIC_RELAXED, __HIP_MEMORY_SCOPE_AGENT);
    __syncthreads();
    return (int)F.MISC[16];
}

__device__ __forceinline__ void tr_item(const float* src, int ldw, int k0, int c0, bf16_t* dst, size_t dp, int r0, int kd0, LAS float* scr, int lane) {
    f32x4 v[8];
#pragma unroll
    for (int i = 0; i < 8; ++i) { const int kk = (lane >> 3) + 8 * i; v[i] = *(const GAS f32x4*)(src + (size_t)(k0 + kk) * ldw + c0 + 4 * (lane & 7)); }
#pragma unroll
    for (int i = 0; i < 8; ++i) { const int kk = (lane >> 3) + 8 * i; LAS float* d = scr + kk * 33 + 4 * (lane & 7); d[0] = v[i].x; d[1] = v[i].y; d[2] = v[i].z; d[3] = v[i].w; }
    LDS_WAIT(); asm volatile("" ::: "memory");
    const int c = lane & 7;
#pragma unroll
    for (int j = 0; j < 4; ++j) { const int n = (lane >> 3) + 8 * j; const LAS float* s = scr + (8 * c) * 33 + n;
        u32x4 o; o.x = pk2(s[0 * 33], s[1 * 33]); o.y = pk2(s[2 * 33], s[3 * 33]); o.z = pk2(s[4 * 33], s[5 * 33]); o.w = pk2(s[6 * 33], s[7 * 33]);
        *(GAS u32x4*)(dst + (size_t)(r0 + n) * dp + kd0 + 8 * c) = o; }
    LDS_WAIT(); asm volatile("" ::: "memory");
}
constexpr int TRL0 = 16 * 89 + 512 + 16 * 768, TRL1 = 16 * 65 + 512 + 8 * 16 + 16 * 768;
__device__ __forceinline__ void tr_moe_item(Frame& F, int l, int r, LAS float* scr) {
    const Params& P = *F.p; constexpr int IM = 768;
    const int e = r / IM, q = r % IM;
    if (q < 512) {
        const int up = q >> 8, qq = q & 255, kb = qq / 16, nb = qq % 16, n0 = nb * 32, blk = n0 >> 7, within = n0 & 127;
        const float* src = P.in[up ? I_WU : I_WG] + ((size_t)(l * 16 + e)) * 1024 * 512;
        bf16_t* dst = (bf16_t*)(F.ws + (l ? WS_GU1 : WS_GU0)) + (size_t)e * 1024 * 1024;
        tr_item(src, 512, kb * 64, n0, dst, 1024, blk * 256 + up * 128 + within, kb * 64, scr, F.lane);
    } else {
        const int qq = q - 512, kb = qq / 32, nb = qq % 32;
        const float* src = P.in[I_WD] + ((size_t)(l * 16 + e)) * 512 * 1024;
        tr_item(src, 1024, kb * 64, nb * 32, (bf16_t*)(F.ws + (l ? WS_D1 : WS_D0)) + (size_t)e * 1024 * 512, 512, nb * 32, kb * 64, scr, F.lane);
    }
}
template <int LIST> __device__ __forceinline__ void tr_list_range(Frame& F, int lo, int hi, int slot, int nslots) {
    const Params& P = *F.p;
    LAS float* scr = (LAS float*)(F.lds + F.wave * 16384);
    for (int it = lo + slot; it < hi; it += nslots) {
        int r = it;
        if (LIST == 0) {
            constexpr int I0 = 16 * 89, I1 = 512;
            if (r < I0) { const int kb = r / 89, nb = r % 89, n0 = nb * 32; tr_item(P.in[I_EVWIN], 2832, kb * 64, nb == 88 ? 2048 : n0 + (n0 >= 2048 ? 16 : 0), (bf16_t*)(F.ws + WS_WIN0), 1024, n0, kb * 64, scr, F.lane); continue; } r -= I0;
            if (r < I1) { const int kb = r / 32, nb = r % 32; tr_item(P.in[I_EVWOUT], 1024, kb * 64, nb * 32, (bf16_t*)(F.ws + WS_WOUT0), 1024, nb * 32, kb * 64, scr, F.lane); continue; } r -= I1;
            tr_moe_item(F, 0, r, scr);
        } else {
            constexpr int I2 = 16 * 65, I3 = 512, I4 = 8 * 16;
            if (r < I2) { const int kb = r / 65, nb = r % 65; tr_item(P.in[I_ODWIN], 2064, kb * 64, nb == 64 ? 2032 : nb * 32, (bf16_t*)(F.ws + WS_WIN1), 1024, nb * 32, kb * 64, scr, F.lane); continue; } r -= I2;
            if (r < I3) { const int kb = r / 32, nb = r % 32; tr_item(P.in[I_ODWOUT], 1024, kb * 64, nb * 32, (bf16_t*)(F.ws + WS_WOUT1), 1024, nb * 32, kb * 64, scr, F.lane); continue; } r -= I3;
            if (r < I4) { const int kb = r / 16, nb = r % 16; tr_item(P.in[I_GLUW], 512, kb * 64, nb * 32, (bf16_t*)(F.ws + WS_WGLU), 512, nb * 32, kb * 64, scr, F.lane); continue; } r -= I4;
            tr_moe_item(F, 1, r, scr);
        }
    }
}
__device__ __forceinline__ void p0_prologue(Frame& F) {
    const Params& P = *F.p;
    if (F.bid < 192) {
        const int l = F.bid / 96, cb = F.bid % 96;
        LAS float* sc = (LAS float*)F.lds;
        LAS float* red = (LAS float*)(F.lds + 17 * 1024 * 4);
        {
#pragma unroll 1
            for (int h = 0; h < 2; ++h) {
                float cv[17];
#pragma unroll
                for (int u = 0; u < 17; ++u) { const int i = F.tid + (17 * h + u) * NTHREADS; const int m = i >> 10, k = i & 1023; cv[u] = m < 16 ? P.in[I_C][m * 1024 + k] : P.in[I_CCTX][k]; }
#pragma unroll
                for (int u = 0; u < 17; ++u) sc[F.tid + (17 * h + u) * NTHREADS] = siluf_(cv[u]);
            }
        }
        __syncthreads();
        const int kq = F.tid >> 6, col = F.tid & 63;
        float acc[17];
#pragma unroll
        for (int m = 0; m < 17; ++m) acc[m] = 0.f;
        const float* w = P.in[I_ADAW] + (size_t)l * 1024 * 6144 + cb * 64 + col;
#pragma unroll 1
        for (int k0 = kq; k0 < 1024; k0 += 128) {
            float wv[16];
#pragma unroll
            for (int u = 0; u < 16; ++u) wv[u] = w[(size_t)(k0 + 8 * u) * 6144];
#pragma unroll
            for (int u = 0; u < 16; ++u) {
#pragma unroll
                for (int m = 0; m < 17; ++m) acc[m] += sc[m * 1024 + k0 + 8 * u] * wv[u];
                if ((u & 1) == 1) __builtin_amdgcn_sched_barrier(0); }
        }
#pragma unroll
        for (int m = 0; m < 17; ++m) red[(kq * 17 + m) * 64 + col] = acc[m];
        __syncthreads();
        for (int i = F.tid; i < 17 * 64; i += NTHREADS) { const int m = i >> 6, c2 = i & 63; float s = 0.f;
#pragma unroll
            for (int q = 0; q < 8; ++q) s += red[(q * 17 + m) * 64 + c2];
            const float mv = s + P.in[I_ADAB][l * 6144 + cb * 64 + c2];
            ((float*)(F.ws + WS_MOD))[((size_t)l * 17 + m) * 6144 + cb * 64 + c2] = mv; ((bf16_t*)(F.ws + WS_MODB))[((size_t)l * 17 + m) * 6144 + cb * 64 + c2] = f2bf(mv); }
        __syncthreads();
    }
    {
        u32x4* z0 = (u32x4*)(F.ws + WS_WIN0 + (size_t)2848 * 2048); u32x4* z1 = (u32x4*)(F.ws + WS_WIN1 + (size_t)2080 * 2048);
        const int n16 = 224 * 2048 / 16; const u32x4 zz = (u32x4){0u, 0u, 0u, 0u};
        for (int i = F.bid * NTHREADS + F.tid; i < n16; i += F.G * NTHREADS) { z0[i] = zz; z1[i] = zz; }
    }
    if (F.bid >= 192) tr_list_range<0>(F, 0, PRO_X, (F.bid - 192) * NWAVES + F.wave, 64 * NWAVES);
    tr_list_range<0>(F, PRO_X, TRL0, F.vcu * NWAVES + F.wave, F.G * NWAVES);
    if (!DEFER_L1) tr_list_range<1>(F, 0, TRL1, F.vcu * NWAVES + F.wave, F.G * NWAVES);
}

#ifndef NPD
#define NPD 3
#endif
#ifndef NPD0
#define NPD0 6
#endif
template <int MODE> __device__ __forceinline__ void norm_phase(Frame& F) {
    const Params& P = *F.p;
    constexpr int NS = (MODE == 0) ? 0 : (MODE == 2 ? 16 : 20);
    constexpr int layer = (MODE >= 2) ? 1 : 0;
    constexpr bool ROUTER = (MODE == 1 || MODE == 3);
    LAS f32x4* Wsm = (LAS f32x4*)F.lds;
    LAS int* cnt = (LAS int*)(F.lds + 4 * NS * 64 * 16);
    LAS f32x4* ABm = (LAS f32x4*)(F.lds + 4 * NS * 64 * 16 + 256);
    if constexpr (NS > 0) {
        LAS float* Wf = (LAS float*)F.lds;
        constexpr int NQ = NS / 4, NLD = 1024 * NQ / NTHREADS;
        f32x4 vv[NLD];
#pragma unroll
        for (int u = 0; u < NLD; ++u) { const int f = F.tid + u * NTHREADS; const int qd = f >> 10, k = f & 1023;
            if (MODE == 2) vv[u] = *(const f32x4*)(P.in[I_ODWIN] + (size_t)k * 2064 + 2048 + 4 * qd);
            else vv[u] = (qd == 0) ? *(const f32x4*)(P.in[I_GRW] + (size_t)layer * 4096 + k * 4) : *(const f32x4*)(P.in[I_ERW] + (size_t)layer * 16384 + k * 16 + 4 * (qd - 1)); }
#pragma unroll
        for (int u = 0; u < NLD; ++u) { const int f = F.tid + u * NTHREADS; const int qd = f >> 10, k = f & 1023;
            const int j = k >> 8, ln = (k & 255) >> 2, e = k & 3;
#pragma unroll
            for (int c = 0; c < 4; ++c) Wf[((j * NS + 4 * qd + c) * 64 + ln) * 4 + e] = vv[u][c]; }
    }
    if (F.tid < 32) cnt[F.tid] = 0;
    LAS int* lcls = (LAS int*)(F.lds + 98560); LAS float* lw = (LAS float*)(F.lds + 98560 + 1024); LAS int* cbase = (LAS int*)(F.lds + 98560 + 4096); LAS int* posr = (LAS int*)(F.lds + 98560 + 8192);
    if (ROUTER && F.tid < ROWS_PER_WG) lcls[F.tid] = -1;
    constexpr bool DEAL = (MODE == 2 || MODE == 3);
    const int rw0 = F.bid * ROWS_PER_WG;
    const int m_first = DEAL ? 16 : (((rw0 % LT) < CTXL) ? 16 : rw0 / LT);
    {
        const float* gain_ = P.in[(MODE == 1 || MODE == 3) ? I_NFFN : I_NMIX] + ((MODE >= 2) ? 1 : 0) * 1024;
        const float* mod_ = (const float*)(F.ws + WS_MOD) + (size_t)((MODE >= 2) ? 1 : 0) * 17 * 6144;
        constexpr int SH_ = (MODE == 1 || MODE == 3) ? 3072 : 0, SC_ = (MODE == 1 || MODE == 3) ? 4096 : 1024;
        const int rl = rw0 + ROWS_PER_WG - 1; const int m_last = DEAL ? (F.bid >> 4) : (((rl % LT) < CTXL) ? 16 : rl / LT);
        { const int slot = F.tid >> 8, i4 = F.tid & 255; const int m = slot ? m_last : m_first;
          const f32x4 g = ((const f32x4*)gain_)[i4], s2 = ((const f32x4*)(mod_ + m * 6144 + SC_))[i4], b2 = ((const f32x4*)(mod_ + m * 6144 + SH_))[i4];
          ABm[(slot * 2 + 0) * 256 + i4] = g * (s2 + 1.0f); ABm[(slot * 2 + 1) * 256 + i4] = b2; }
    }
    __syncthreads();
    const float* gain = P.in[ROUTER ? I_NFFN : I_NMIX] + layer * 1024;
    const float* mod = (const float*)(F.ws + WS_MOD) + (size_t)layer * 17 * 6144;
    constexpr int SH = ROUTER ? 3072 : 0, SC = ROUTER ? 4096 : 1024;
    constexpr int NE0 = ROUTER ? 4 : 0;
    bf16_t* HB = (bf16_t*)(F.ws + WS_HB);
    int cur = -1; f32x4 Av[4], Bv[4];
    const int r0 = wave_row0(F.bid, F.wave);
    const int rA = DEAL ? (F.bid >> 4) * LT + 16 * (F.bid & 15) + 2 * F.wave : r0;
    const int rB = DEAL ? (F.bid >> 4) * LT + CTXL + 128 * (F.bid & 15) + 16 * F.wave : r0 + 2;
    auto rowof = [&](int i) -> int { return i < 2 ? rA + i : rB + i - 2; };
    constexpr int PD = (MODE == 0) ? NPD0 : NPD;
    f32x4 nx[PD][4]; u32x2 nb[PD][4];
    auto ldrow = [&](int r, f32x4 (&a)[4], u32x2 (&bq)[4]) {
        if (MODE == 0) { const float* src = xin_row(F, r);
#pragma unroll
            for (int j = 0; j < 4; ++j) a[j] = ((const GAS f32x4*)src)[64 * j + F.lane]; }
        else { const bf16_t* src = xr_row(F, r);
#pragma unroll
            for (int j = 0; j < 4; ++j) bq[j] = ((const GAS u32x2*)src)[64 * j + F.lane]; } };
#pragma unroll
    for (int q = 0; q < PD; ++q) ldrow(rowof(q), nx[q], nb[q]);
    auto rowbody = [&](const int q, const int ri, const bool pre) {
        const int r = rowof(ri); const int b = r / LT; const bool isctx = (r % LT) < CTXL;
        f32x4 v[4];
#pragma unroll
        for (int j = 0; j < 4; ++j) { if (MODE == 0) v[j] = nx[q][j]; else v[j] = (f32x4){bflo(nb[q][j].x), bfhi(nb[q][j].x), bflo(nb[q][j].y), bfhi(nb[q][j].y)}; }
        if (pre) ldrow(rowof(ri + PD), nx[q], nb[q]);
        if (MODE == 3 && isctx) return;
        const int m = isctx ? 16 : b;
        if (m != cur) { cur = m; const int slot = (m == m_first) ? 0 : 1;
#pragma unroll
            for (int j = 0; j < 4; ++j) { Av[j] = ABm[(slot * 2 + 0) * 256 + 64 * j + F.lane]; Bv[j] = ABm[(slot * 2 + 1) * 256 + 64 * j + F.lane]; } }
        float ss = 0.f;
#pragma unroll
        for (int j = 0; j < 4; ++j) ss += (v[j].x * v[j].x + v[j].y * v[j].y) + (v[j].z * v[j].z + v[j].w * v[j].w);
        const float rstd = rsqrtf(wave_sum(ss) * (1.f / D) + NORM_EPS);
#pragma unroll
        for (int j = 0; j < 4; ++j) v[j] = v[j] * rstd * Av[j] + Bv[j];
        GAS u32x2* o8 = (GAS u32x2*)(HB + (size_t)r * D) + F.lane;
#pragma unroll
        for (int j = 0; j < 4; ++j) { u32x2 w; w.x = pk2(v[j].x, v[j].y); w.y = pk2(v[j].z, v[j].w); o8[64 * j] = w; }
        if constexpr (NS > 0) {
        auto coldot = [&](int n) -> float { f32x2_t a2 = {0.f, 0.f};
#pragma unroll
            for (int j = 0; j < 4; ++j) { const f32x4 w = Wsm[(j * NS + n) * 64 + F.lane];
                a2 = __builtin_elementwise_fma((f32x2_t){v[j].x, v[j].y}, (f32x2_t){w.x, w.y}, a2); a2 = __builtin_elementwise_fma((f32x2_t){v[j].z, v[j].w}, (f32x2_t){w.z, w.w}, a2); }
            return a2.x + a2.y; };
        auto reduce4 = [&](float (&p)[4]) {
            const bool b3 = F.lane & 8, b2 = F.lane & 4;
            float t2[2];
#pragma unroll
            for (int i = 0; i < 2; ++i) { const float keep = b3 ? p[i + 2] : p[i], send = b3 ? p[i] : p[i + 2]; t2[i] = keep + dppf<0x140>(send); }
            float e; { const float keep = b2 ? t2[1] : t2[0], send = b2 ? t2[0] : t2[1]; e = keep + dppf<0x141>(send); }
            e += dppf<0xB1>(e); e += dppf<0x4E>(e);
            e += xorl<16>(e); e += xorl<32>(e);
#pragma unroll
            for (int i = 0; i < 4; ++i) p[i] = rdlane(e, 4 * i);
        };
        if constexpr (!ROUTER) {
        if (isctx) {
        float a16[16];
#pragma unroll
        for (int g4 = 0; g4 < NS / 4; ++g4) {
#pragma unroll
            for (int q = 0; q < 4; ++q) a16[4 * g4 + q] = coldot(4 * g4 + q);
            asm volatile("" ::: "memory");
        }
        float e16;
        {
            const bool b5 = F.lane & 32, b4 = F.lane & 16, b3 = F.lane & 8, b2 = F.lane & 4;
            float t8[8], t4[4], t2[2];
#pragma unroll
            for (int i = 0; i < 8; ++i) { const float keep = b5 ? a16[i + 8] : a16[i], send = b5 ? a16[i] : a16[i + 8]; t8[i] = keep + xorl<32>(send); }
#pragma unroll
            for (int i = 0; i < 4; ++i) { const float keep = b4 ? t8[i + 4] : t8[i], send = b4 ? t8[i] : t8[i + 4]; t4[i] = keep + xorl<16>(send); }
#pragma unroll
            for (int i = 0; i < 2; ++i) { const float keep = b3 ? t4[i + 2] : t4[i], send = b3 ? t4[i] : t4[i + 2]; t2[i] = keep + xorl<8>(send); }
            { const float keep = b2 ? t2[1] : t2[0], send = b2 ? t2[0] : t2[1]; e16 = keep + xorl<4>(send); }
            e16 += xorl<2>(e16); e16 += xorl<1>(e16);
        }
            if ((F.lane & 3) == 0) ((float*)(F.ws + WS_GATES))[(size_t)r * 16 + (F.lane >> 2)] = e16;
        }
        } else {
            float grp[4];
#pragma unroll
            for (int n = 0; n < 4; ++n) grp[n] = coldot(n);
            reduce4(grp);
            const float* grb = P.in[I_GRB] + layer * 4; const float* erb = P.in[I_ERB] + layer * 16;
            float gl[4]; int gi = 0; float gm = -1e30f;
#pragma unroll
            for (int n = 0; n < 4; ++n) { gl[n] = grp[n] + grb[n]; if (gl[n] > gm) { gm = gl[n]; gi = n; } }
            float gs = 0.f;
#pragma unroll
            for (int n = 0; n < 4; ++n) gs += __expf(gl[n] - gm);
            const float gp = __builtin_amdgcn_rcpf(gs);
            float el[4];
#pragma unroll
            for (int n = 0; n < 4; ++n) el[n] = 0.f;
            {
                const int gis = __builtin_amdgcn_readfirstlane(gi);
                if (gis == 0) { _Pragma("unroll") for (int n = 0; n < 4; ++n) el[n] = coldot(4 + n); }
                else if (gis == 1) { _Pragma("unroll") for (int n = 0; n < 4; ++n) el[n] = coldot(8 + n); }
                else if (gis == 2) { _Pragma("unroll") for (int n = 0; n < 4; ++n) el[n] = coldot(12 + n); }
                else { _Pragma("unroll") for (int n = 0; n < 4; ++n) el[n] = coldot(16 + n); }
            }
            reduce4(el);
#pragma unroll
            for (int n = 0; n < 4; ++n) el[n] += erb[4 * gi + n];
            int i0 = 0; float v0 = el[0];
#pragma unroll
            for (int n = 1; n < 4; ++n) if (el[n] > v0) { v0 = el[n]; i0 = n; }
            int i1 = -1; float v1 = -1e30f;
#pragma unroll
            for (int n = 0; n < 4; ++n) if (n != i0 && el[n] > v1) { v1 = el[n]; i1 = n; }
            const float e1 = __expf(v1 - v0); const float w0 = gp * __builtin_amdgcn_rcpf(1.f + e1), w1 = w0 * e1;
            const int ea = i0 < i1 ? i0 : i1, eb = i0 < i1 ? i1 : i0; const float wa = i0 < i1 ? w0 : w1, wb = i0 < i1 ? w1 : w0;
            const int pidx = (ea == 0) ? (eb - 1) : (ea == 1 ? eb + 1 : 5);
            const int cls = gi * 6 + pidx;
            if (F.lane == 0) { const int li = F.wave * ROWS_PER_WAVE + ri;
                lcls[li] = cls; lw[2 * li] = wa; lw[2 * li + 1] = wb;
                atomicAdd((int*)&cnt[cls], 1);
            }
        }
        }
    };
#pragma unroll 1
    for (int rb = 0; rb + PD < ROWS_PER_WAVE; rb += PD) {
#pragma unroll
        for (int q = 0; q < PD; ++q) rowbody(q, rb + q, true);
    }
#pragma unroll
    for (int q = 0; q < PD; ++q) rowbody(q, ROWS_PER_WAVE - PD + q, false);
    if constexpr (ROUTER) {
        __syncthreads();
        if (F.tid < NCLS) { const int n = cnt[F.tid]; int off = 0;
            if (n > 0) off = (int)__hip_atomic_fetch_add((unsigned*)(F.ctl + CW_GC + 32 * layer + F.tid), (unsigned)n, __ATOMIC_RELAXED, __HIP_MEMORY_SCOPE_AGENT);
            cbase[F.tid] = F.tid * RCAP + off; }
        __syncthreads();
        if (F.wave == 0) {
            int run = 0;
            for (int q = 0; q < 3; ++q) {
                const int i = q * 64 + F.lane; const int cls = (i < ROWS_PER_WG) ? lcls[i] : -1;
                int mypos = -1;
                for (int c = 0; c < NCLS; ++c) {
                    const unsigned long long mask = __ballot(cls == c);
                    const int rank = __popcll(mask & ((1ull << F.lane) - 1ull));
                    const int runc = __builtin_amdgcn_readlane(run, c);
                    if (cls == c) mypos = cbase[c] + runc + rank;
                    if (F.lane == c) run += __popcll(mask);
                }
                if (i < ROWS_PER_WG) posr[i] = mypos;
            }
        }
        __syncthreads();
        int* tok2 = (int*)(F.ws + WS_ROUTE + RT_TOK2); float* wpos2 = (float*)(F.ws + WS_ROUTE + RT_WPOS2);
        for (int i = F.tid; i < ROWS_PER_WG; i += NTHREADS) { const int pos = posr[i];
            if (pos >= 0) { const int w = i / ROWS_PER_WAVE, idx = i % ROWS_PER_WAVE;
                const int rA_ = DEAL ? (F.bid >> 4) * LT + 16 * (F.bid & 15) + 2 * w : wave_row0(F.bid, w), rB_ = DEAL ? (F.bid >> 4) * LT + CTXL + 128 * (F.bid & 15) + 16 * w : wave_row0(F.bid, w) + 2;
                const int r = idx < 2 ? rA_ + idx : rB_ + idx - 2;
                tok2[pos] = r; wpos2[2 * (size_t)pos] = lw[2 * i]; wpos2[2 * (size_t)pos + 1] = lw[2 * i + 1]; } }
    }
}

struct MoeTab { LAS int* base; LAS int* tot; LAS int* mine; LAS int* ntile; };
constexpr int MOE_TAB_OFF = 131072;
__device__ __forceinline__ MoeTab moe_tables2(Frame& F, LAS unsigned char* at, int layer);
__device__ __forceinline__ MoeTab moe_tables_view(LAS unsigned char* at) { MoeTab T; T.base = (LAS int*)at; T.tot = T.base + 32; T.mine = T.tot + 32; T.ntile = T.mine + 32; return T; }
__device__ __forceinline__ MoeTab moe_tables(Frame& F, LAS unsigned char* at, bool with_mine) {
    MoeTab T; T.base = (LAS int*)at; T.tot = T.base + 32; T.mine = T.tot + 32; T.ntile = T.mine + 32;
    const int* cnt = (const int*)(F.ws + WS_ROUTE + RT_CNT);
    LAS int* part = T.ntile + 32;
    __syncthreads();
    { const int c = F.tid & 31, pt = F.tid >> 5; int t = 0, m = 0;
      if (c < NCLS) {
#pragma unroll
          for (int i = 0; i < 16; ++i) { const int w = pt * 16 + i; const int v = cnt[w * NCLS + c]; t += v; m += (w < F.bid) ? v : 0; } }
      part[(pt * 2 + 0) * 32 + c] = t; part[(pt * 2 + 1) * 32 + c] = m; }
    __syncthreads();
    if (F.tid < NCLS) { int t = 0, m = 0; for (int pt = 0; pt < 16; ++pt) { t += part[(pt * 2 + 0) * 32 + F.tid]; m += part[(pt * 2 + 1) * 32 + F.tid]; } T.tot[F.tid] = t; T.mine[F.tid] = m; }
    __syncthreads();
    if (F.tid == 0) { int pos = 0; for (int c = 0; c < NCLS; ++c) { T.base[c] = pos; pos += ((T.tot[c] + 255) >> 8) << 8; } T.ntile[0] = pos >> 8; }
    __syncthreads();
    (void)with_mine;
    return T;
}
__device__ __forceinline__ MoeTab moe_tables2(Frame& F, LAS unsigned char* at, int layer) {
    MoeTab T = moe_tables_view(at);
    __syncthreads();
    if (F.tid < NCLS) T.tot[F.tid] = (int)__hip_atomic_load((unsigned*)(F.ctl + CW_GC + 32 * layer + F.tid), __ATOMIC_RELAXED, __HIP_MEMORY_SCOPE_AGENT);
    __syncthreads();
    if (F.tid == 0) { int t = 0; for (int c = 0; c < NCLS; ++c) { T.base[c] = t; t += (T.tot[c] + 255) >> 8; } T.ntile[0] = t; }
    __syncthreads();
    return T;
}
__device__ __forceinline__ void cls_experts(int cls, int& ea, int& eb) {
    const int g = cls / 6, pi = cls % 6; int a, b;
    if (pi < 3) { a = 0; b = pi + 1; } else if (pi < 5) { a = 1; b = pi - 1; } else { a = 2; b = 3; }
    ea = g * 4 + a; eb = g * 4 + b;
}
template <int LAYER> __device__ __forceinline__ int route_row(int bid, int i) {
    const int w = i / ROWS_PER_WAVE, idx = i % ROWS_PER_WAVE;
    if (LAYER == 0) return wave_row0(bid, w) + idx;
    const int b = bid >> 4, j = bid & 15;
    return idx < 2 ? b * LT + 16 * j + 2 * w + idx : b * LT + CTXL + 128 * j + 16 * w + idx - 2;
}
template <int LAYER> __device__ __forceinline__ void route_phase(Frame& F) {
    MoeTab T = moe_tables(F, F.lds + MOE_TAB_OFF, true);
    LAS int* posr = (LAS int*)(F.lds + 8192);
    const int* clsg = (const int*)(F.ws + WS_ROUTE + RT_CLS);
    int* tok = (int*)(F.ws + WS_ROUTE + RT_TOK); float* wpos = (float*)(F.ws + WS_ROUTE + RT_WPOS); const float* wts = (const float*)(F.ws + WS_ROUTE + RT_WTS);
    if (F.wave == 0) {
        int run = 0;
        for (int q = 0; q < 3; ++q) {
            const int i = q * 64 + F.lane; int cls = -1;
            if (i < ROWS_PER_WG) { const int r = route_row<LAYER>(F.bid, i); if (!(LAYER == 1 && row_is_ctx(r))) cls = clsg[r]; }
            int mypos = -1;
            for (int c = 0; c < NCLS; ++c) {
                const unsigned long long mask = __ballot(cls == c);
                const int rank = __popcll(mask & ((1ull << F.lane) - 1ull));
                const int runc = __builtin_amdgcn_readlane(run, c);
                if (cls == c) mypos = T.base[c] + T.mine[c] + runc + rank;
                if (F.lane == c) run += __popcll(mask);
            }
            if (i < ROWS_PER_WG) posr[i] = mypos;
        }
    }
    __syncthreads();
    for (int i = F.tid; i < ROWS_PER_WG; i += NTHREADS) { const int pos = posr[i];
        if (pos >= 0) { const int r = route_row<LAYER>(F.bid, i); tok[pos] = r; wpos[2 * (size_t)pos] = wts[2 * (size_t)r]; wpos[2 * (size_t)pos + 1] = wts[2 * (size_t)r + 1]; } }
    if (F.bid < NCLS) {
        const int c = F.bid, lo = T.base[c] + T.tot[c], hi = T.base[c] + (((T.tot[c] + 255) >> 8) << 8);
        for (int p = lo + F.tid; p < hi; p += NTHREADS) { tok[p] = -1; wpos[2 * (size_t)p] = 0.f; wpos[2 * (size_t)p + 1] = 0.f; }
    }
}
#ifndef EPISEL
#define EPISEL 0
#endif
namespace pg8 {
constexpr int BM = 256, BK = 64, HALF = 128, HTB = HALF * BK * 2, STAGE_BYTES = 8 * HTB;
__host__ __device__ __forceinline__ int lds_byte(int r, int c) { const int st = (r >> 4) * 2 + (c >> 5), rr = r & 15, cc = c & 31, ob = rr * 64 + cc * 2; return st * 1024 + (ob ^ (((ob >> 9) & 1) << 5)); }
__host__ __device__ __forceinline__ void stage_rc(int b, int& R_, int& C_) { const int st = b / 1024, sb = b % 1024, swz = sb ^ (((sb >> 9) & 1) << 5); R_ = (st >> 1) * 16 + swz / 64; C_ = (st & 1) * 32 + (swz % 64) / 2; }
__host__ __device__ __forceinline__ int perm32(int rho) { const int n = rho >> 4, i = rho & 15; return 8 * (i >> 2) + 4 * n + (i & 3); }

struct Unit { const char* a; const char* b; int bdelta; int pm, pn, aux; const int* rows; int nv; };
struct Gemm { int pitchA, pitchB, K; };

template <class Epi, class Sched, bool ALIGN_EPI, bool GATHER = false>
__device__ __forceinline__ void gemm_phase(LAS unsigned char* lds, const Gemm g, const Sched& S, const Epi& E, int wave_s) {
    const int tid = opaque_tid(wave_s), wid = __builtin_amdgcn_readfirstlane(tid >> 6), lane = tid & 63, wr = wid >> 2, wc = wid & 3, fr = lane & 15, fq = lane >> 4;
    const int K = g.K, nt = K / BK;
    unsigned voffA[2], voffB[2]; int RA[2], CA[2];
#pragma unroll
    for (int i = 0; i < 2; ++i) { int R_, C_; stage_rc(tid * 16 + i * 8192, R_, C_); const int Rb = Epi::PERM ? ((R_ & ~31) + perm32(R_ & 31)) : R_; RA[i] = R_; CA[i] = C_;
        voffA[i] = (unsigned)(R_ * g.pitchA + C_) * 2u; voffB[i] = (unsigned)(Rb * g.pitchB + C_) * 2u; }
    unsigned gC[2][2], gN[2][2];
    auto gload = [&](const Unit& u, unsigned (&go)[2][2]) {
#pragma unroll
        for (int h = 0; h < 2; ++h)
#pragma unroll
            for (int i = 0; i < 2; ++i) { const int rv = u.rows[h * HALF + RA[i]]; const int r = (h * HALF + RA[i] < u.nv) ? rv : 0; go[h][i] = (unsigned)(r * g.pitchA + CA[i]) * 2u; } };
    const size_t kstep = (size_t)(BK * 2);
    const size_t hstepA = (size_t)HALF * g.pitchA * 2, hstepB = (size_t)HALF * g.pitchB * 2;
    const unsigned ldsw = (unsigned)wid * 1024u;
    const int aoff = lds_byte(wr * 64 + fr, fq * 8), boff = lds_byte(wc * 32 + fr, fq * 8);
#define PG8_SA(b, h) (((b) * 2 + (h)) * HTB)
#define PG8_SB(b, h) ((4 + (b) * 2 + (h)) * HTB)
#define PG8_STAGE(bufoff, gbase, voff) do { _Pragma("unroll") for (int _i = 0; _i < 2; ++_i) \
        __builtin_amdgcn_global_load_lds((const unsigned*)((const char*)(gbase) + (voff)[_i]), (LAS unsigned*)(lds + (bufoff) + ldsw + _i * 8192), 16, 0, 0); } while (0)
#define PG8_STAGE_A(bufoff, gbase, h, NX) do { if constexpr (GATHER) { _Pragma("unroll") for (int _i = 0; _i < 2; ++_i) { const unsigned _o = (NX) ? gN[h][_i] : gC[h][_i]; \
        __builtin_amdgcn_global_load_lds((const unsigned*)((const char*)(gbase) + _o), (LAS unsigned*)(lds + (bufoff) + ldsw + _i * 8192), 16, 0, 0); } } \
    else { PG8_STAGE(bufoff, (const char*)(gbase) + (h) * hstepA, voffA); } } while (0)
#define PG8_LDA(dst, b, h) do { _Pragma("unroll") for (int m = 0; m < 4; ++m) _Pragma("unroll") for (int k = 0; k < 2; ++k) dst[m][k] = *(const LAS bf16x8*)(lds + PG8_SA(b, h) + aoff + m * 2048 + k * 1024); } while (0)
#define PG8_LDB(dst, b, h) do { _Pragma("unroll") for (int n = 0; n < 2; ++n) _Pragma("unroll") for (int k = 0; k < 2; ++k) dst[n][k] = *(const LAS bf16x8*)(lds + PG8_SB(b, h) + boff + n * 2048 + k * 1024); } while (0)
#define PG8_MMA(ai, bj, At, Bt) do { __builtin_amdgcn_s_setprio(1); _Pragma("unroll") for (int m = 0; m < 4; ++m) _Pragma("unroll") for (int n = 0; n < 2; ++n) _Pragma("unroll") for (int k = 0; k < 2; ++k) \
        acc[ai][bj][m][n] = __builtin_amdgcn_mfma_f32_16x16x32_bf16(Bt[n][k], At[m][k], acc[ai][bj][m][n], 0, 0, 0); __builtin_amdgcn_s_setprio(0); } while (0)
#define PG8_WAIT_V(n) asm volatile("s_waitcnt vmcnt(" #n ")" ::: "memory")
#define PG8_WAIT_L(n) asm volatile("s_waitcnt lgkmcnt(" #n ")" ::: "memory")
#define PG8_BAR __builtin_amdgcn_s_barrier()
#define PG8_SCHED __builtin_amdgcn_sched_barrier(0)
    Unit cur, nxt; int ui = 0;
    if (!S.next(0, cur)) return;
    f32x4 acc[2][2][4][2];
#pragma unroll
    for (int a = 0; a < 2; ++a)
#pragma unroll
        for (int b = 0; b < 2; ++b)
#pragma unroll
            for (int m = 0; m < 4; ++m)
#pragma unroll
                for (int n = 0; n < 2; ++n) acc[a][b][m][n] = (f32x4){0.f, 0.f, 0.f, 0.f};
    bf16x8 At[4][2], B0[2][2], B1[2][2];
    const char* cA = cur.a; const char* cB = cur.b;
    if constexpr (GATHER) gload(cur, gC);
    PG8_STAGE(PG8_SB(0, 0), cB, voffB); PG8_STAGE(PG8_SB(0, 1), cB + hstepB, voffB); PG8_STAGE_A(PG8_SA(0, 0), cA, 0, false); PG8_STAGE_A(PG8_SA(0, 1), cA, 1, false);
    if (wr == 1) PG8_BAR;
    PG8_WAIT_V(2); PG8_BAR;
    PG8_STAGE(PG8_SB(1, 0), cB + kstep, voffB); PG8_STAGE_A(PG8_SA(1, 0), cA + kstep, 0, false); PG8_STAGE(PG8_SB(1, 1), cB + hstepB + kstep, voffB);
    PG8_WAIT_V(6); PG8_BAR;
    for (;;) {
        const bool has_next = S.next(ui + 1, nxt);
        const char* nA = has_next ? nxt.a : cA; const char* nB = has_next ? nxt.b : cB;
        if constexpr (GATHER) { if (has_next) gload(nxt, gN); else { _Pragma("unroll") for (int h = 0; h < 2; ++h) _Pragma("unroll") for (int i = 0; i < 2; ++i) gN[h][i] = gC[h][i]; } }
        const int bdelta = cur.bdelta;
        for (int t = 0; t < nt; t += 2) {
            const bool last = (t == nt - 2);
            const char* a1 = cA + (size_t)(t + 1) * kstep;
            const char* a2 = last ? nA : cA + (size_t)(t + 2) * kstep;
            const char* b2 = last ? nB : cB + (size_t)(t + 2) * kstep + ((2 * (t + 2) >= nt) ? bdelta : 0);
            const char* a3 = a2 + kstep; const char* b3 = b2 + kstep;
            PG8_LDB(B0, 0, 0); PG8_LDB(B1, 0, 1); PG8_SCHED; PG8_LDA(At, 0, 0); PG8_STAGE_A(PG8_SA(1, 1), a1, 1, false);
            PG8_WAIT_V(8); PG8_WAIT_L(0); PG8_BAR; PG8_MMA(0, 0, At, B0); PG8_MMA(0, 1, At, B1); PG8_BAR; PG8_SCHED;
            PG8_LDA(At, 0, 1); PG8_STAGE(PG8_SB(0, 0), b2, voffB); PG8_STAGE(PG8_SB(0, 1), b2 + hstepB, voffB); PG8_STAGE_A(PG8_SA(0, 0), a2, 0, last);
            PG8_WAIT_V(8); PG8_WAIT_L(0); PG8_BAR; PG8_MMA(1, 0, At, B0); PG8_MMA(1, 1, At, B1); PG8_BAR; PG8_SCHED;
            PG8_LDB(B0, 1, 0); PG8_LDB(B1, 1, 1); PG8_SCHED; PG8_LDA(At, 1, 0); PG8_STAGE_A(PG8_SA(0, 1), a2, 1, last);
            PG8_WAIT_V(8); PG8_WAIT_L(0); PG8_BAR; PG8_MMA(0, 0, At, B0); PG8_MMA(0, 1, At, B1); PG8_BAR; PG8_SCHED;
            PG8_LDA(At, 1, 1); PG8_STAGE(PG8_SB(1, 0), b3, voffB); PG8_STAGE(PG8_SB(1, 1), b3 + hstepB, voffB); PG8_STAGE_A(PG8_SA(1, 0), a3, 0, last);
            PG8_WAIT_V(8); PG8_WAIT_L(0); PG8_BAR; PG8_MMA(1, 0, At, B0); PG8_MMA(1, 1, At, B1); PG8_BAR; PG8_SCHED;
        }
        if constexpr (ALIGN_EPI) { if (wr == 0) PG8_BAR; }
#ifdef EPITIME
        unsigned long long te0 = 0; if constexpr (Epi::TIMED) te0 = __builtin_amdgcn_s_memrealtime();
#endif
        E(acc, cur, wr, wc, fr, fq);
#ifdef EPITIME
        if constexpr (Epi::TIMED) { asm volatile("s_waitcnt vmcnt(0)" ::: "memory"); const unsigned long long te1 = __builtin_amdgcn_s_memrealtime();
            if (wid == 0 && lane == 0) { volatile LAS unsigned* tm = (volatile LAS unsigned*)(lds + 155648 + 4 * 24); tm[0] = tm[0] + (unsigned)(te1 - te0); } }
#endif
        if (!has_next) break;
#pragma unroll
        for (int a = 0; a < 2; ++a)
#pragma unroll
            for (int b = 0; b < 2; ++b)
#pragma unroll
                for (int m = 0; m < 4; ++m)
#pragma unroll
                    for (int n = 0; n < 2; ++n) acc[a][b][m][n] = (f32x4){0.f, 0.f, 0.f, 0.f};
        cur = nxt; cA = nA; cB = nB; ++ui;
        if constexpr (GATHER) { _Pragma("unroll") for (int h = 0; h < 2; ++h) _Pragma("unroll") for (int i = 0; i < 2; ++i) gC[h][i] = gN[h][i]; }
        if constexpr (ALIGN_EPI) { if (wr == 1) PG8_BAR; }
    }
    PG8_WAIT_V(0);
    if constexpr (!ALIGN_EPI) { if (wr == 0) PG8_BAR; }
    PG8_BAR;
#undef PG8_SA
#undef PG8_SB
#undef PG8_STAGE
#undef PG8_STAGE_A
#undef PG8_LDA
#undef PG8_LDB
#undef PG8_MMA
#undef PG8_WAIT_V
#undef PG8_WAIT_L
#undef PG8_BAR
#undef PG8_SCHED
}

__device__ __forceinline__ bool order_next(int i, int G, int c, int nM, int nN, int& im, int& pn) {
    const int nwg = nM * nN; const long L = (long)i * G + c; if (L >= nwg) return false;
    int wgid = (int)L; { const int q = nwg / 8, r = nwg % 8, xcd = wgid % 8, off = wgid / 8; wgid = (xcd < r ? xcd * (q + 1) : r * (q + 1) + (xcd - r) * q) + off; }
    const int WGM = 8, nig = WGM * nN, gid = wgid / nig, fm = gid * WGM, gsz = (nM - fm) < WGM ? (nM - fm) : WGM;
    im = fm + ((wgid % nig) % gsz); pn = (wgid % nig) / gsz; return true;
}
template <bool LATENT> struct DenseSched {
    const char* A; const char* B; int nN, G, c; size_t strideA, strideB;
    __device__ __forceinline__ bool next(int i, Unit& u) const {
        int im, pn; if (!order_next(i, G, c, LATENT ? 128 : 144, nN, im, pn)) return false;
        const int tile = LATENT ? (9 * (im >> 3) + 1 + (im & 7)) : im;
        u.a = A + (size_t)tile * strideA; u.b = B + (size_t)pn * strideB; u.bdelta = 0; u.pm = tile; u.pn = pn; u.aux = 0; u.rows = nullptr; u.nv = 256; return true;
    }
};
struct InProj1Sched {
    const char* A; const char* B; int G, c; size_t strideA, strideB;
    __device__ __forceinline__ bool next(int i, Unit& u) const {
        const long L = (long)i * G + c; int tile, pn;
        if (L < 144 * 8) { if (!order_next(i, G, c, 144, 8, tile, pn)) return false; }
        else { const int q = (int)(L - 144 * 8); if (q >= 128) return false; tile = 9 * (q >> 3) + 1 + (q & 7); pn = 8; }
        u.a = A + (size_t)tile * strideA; u.b = B + (size_t)pn * strideB; u.bdelta = 0; u.pm = tile; u.pn = pn; u.aux = 0; u.rows = nullptr; u.nv = 256; return true;
    }
};
struct MoeSched {
    const char* A; const char* B; int nN, G, c, nT; const LAS int* base; const LAS int* tot; bool down; const int* tok;
    __device__ __forceinline__ bool next(int i, Unit& u) const {
        int tile, un; if (!order_next(i, G, c, nT, nN, tile, un)) return false;
        int cls = 0;
#pragma unroll 1
        for (int q = 1; q < NCLS; ++q) if (base[q] <= tile) cls = q;
        int ea, eb; cls_experts(cls, ea, eb);
        const int tin = tile - base[cls]; const int left = tot[cls] - tin * 256;
        u.pm = tile; u.pn = un; u.rows = tok + (size_t)cls * RCAP + tin * 256; u.nv = left < 256 ? left : 256;
        u.a = down ? A + (size_t)tile * (256 * 1024 * 2) : A;
        if (!down) { const int e = (un < 4) ? ea : eb, blk = un & 3; u.b = B + (size_t)e * (1024 * 1024 * 2) + (size_t)blk * (256 * 1024 * 2); u.bdelta = 0; u.aux = un; }
        else { u.b = B + (size_t)ea * (1024 * 512 * 2) + (size_t)un * (256 * 512 * 2); u.bdelta = (eb - ea) * (1024 * 512 * 2) - 8 * 128; u.aux = 0; }
        return true;
    }
};

struct EpiStoreBf16 { static constexpr bool TIMED = (EPISEL == 1);
    static constexpr bool PERM = true;
    bf16_t* O; int ldc; int gate_pn; float* gates; int gate_fq0;
    __device__ __forceinline__ void operator()(const f32x4 (&acc)[2][2][4][2], const Unit& u, int wr, int wc, int fr, int fq) const {
        const int row0 = u.pm * BM + wr * 64 + fr, col0 = u.pn * BM + wc * 32 + 8 * fq;
        if (u.pn == gate_pn) {
            if (wc == 0 && (fq >> 1) == (gate_fq0 >> 1)) {
#pragma unroll
                for (int ai = 0; ai < 2; ++ai)
#pragma unroll
                    for (int m = 0; m < 4; ++m) { float* gp = gates + (size_t)(row0 + ai * HALF + m * 16) * 16 + 8 * (fq & 1);
                        *(f32x4*)gp = acc[ai][0][m][0]; *(f32x4*)(gp + 4) = acc[ai][0][m][1]; } }
            return;
        }
#pragma unroll
        for (int ai = 0; ai < 2; ++ai)
#pragma unroll
            for (int m = 0; m < 4; ++m) { bf16_t* rowp = O + (size_t)(row0 + ai * HALF + m * 16) * ldc + col0;
#pragma unroll
                for (int bj = 0; bj < 2; ++bj) { const f32x4 v0 = acc[ai][bj][m][0], v1 = acc[ai][bj][m][1];
                    u32x4 w; w.x = pk2(v0[0], v0[1]); w.y = pk2(v0[2], v0[3]); w.z = pk2(v1[0], v1[1]); w.w = pk2(v1[2], v1[3]);
                    *(u32x4*)(rowp + bj * HALF) = w; } }
    }
};
template <bool FROM_INPUTS> struct EpiResid { static constexpr bool TIMED = (EPISEL == (FROM_INPUTS ? 2 : 3));
    static constexpr bool PERM = true;
    const float* xin; const float* ctxin; bf16_t* xr; const float* mod  ;
    __device__ __forceinline__ void operator()(const f32x4 (&acc)[2][2][4][2], const Unit& u, int wr, int wc, int fr, int fq) const {
        const int b = u.pm / 9, t9 = u.pm % 9; const bool isctx = t9 == 0;
        const size_t rowoff = isctx ? (size_t)b * CTXL : (size_t)b * SEQ + (size_t)(t9 - 1) * 256;
        const float* src = (isctx ? ctxin : xin) + rowoff * D;
        bf16_t* dst = xr + (size_t)u.pm * BM * D;
        const float* gv = mod + (isctx ? 16 : b) * 6144;
        const int col0 = u.pn * BM + wc * 32 + 8 * fq;
        f32x4 g4[2][2];
#pragma unroll
        for (int bj = 0; bj < 2; ++bj)
#pragma unroll
            for (int n = 0; n < 2; ++n) g4[bj][n] = *(const f32x4*)(gv + col0 + bj * HALF + n * 4);
        constexpr int MB = FROM_INPUTS ? 2 : 4;
#pragma unroll
        for (int ai = 0; ai < 2; ++ai)
#pragma unroll
          for (int m0 = 0; m0 < 4; m0 += MB) {
            f32x4 lf[MB][2][2]; u32x4 lq[MB][2];
#pragma unroll
            for (int mm = 0; mm < MB; ++mm) { const size_t off = (size_t)(ai * HALF + wr * 64 + (m0 + mm) * 16 + fr) * D + col0;
#pragma unroll
                for (int bj = 0; bj < 2; ++bj) {
                    if (FROM_INPUTS) { lf[mm][bj][0] = *(const f32x4*)(src + off + bj * HALF); lf[mm][bj][1] = *(const f32x4*)(src + off + bj * HALF + 4); }
                    else lq[mm][bj] = *(const u32x4*)(dst + off + bj * HALF); } }
            __builtin_amdgcn_sched_barrier(0);
#pragma unroll
            for (int mm = 0; mm < MB; ++mm) { const int m = m0 + mm; const size_t off = (size_t)(ai * HALF + wr * 64 + m * 16 + fr) * D + col0;
#pragma unroll
                for (int bj = 0; bj < 2; ++bj) { f32x4 s0, s1;
                    if (FROM_INPUTS) { s0 = lf[mm][bj][0]; s1 = lf[mm][bj][1]; }
                    else { const u32x4 q = lq[mm][bj]; s0 = (f32x4){bflo(q.x), bfhi(q.x), bflo(q.y), bfhi(q.y)}; s1 = (f32x4){bflo(q.z), bfhi(q.z), bflo(q.w), bfhi(q.w)}; }
                    s0 = s0 + g4[bj][0] * acc[ai][bj][m][0]; s1 = s1 + g4[bj][1] * acc[ai][bj][m][1];
                    u32x4 w; w.x = pk2(s0[0], s0[1]); w.y = pk2(s0[2], s0[3]); w.z = pk2(s1[0], s1[1]); w.w = pk2(s1[2], s1[3]);
                    *(u32x4*)(dst + off + bj * HALF) = w; } }
            __builtin_amdgcn_sched_barrier(0);
          }
    }
};
struct EpiGlu { static constexpr bool TIMED = (EPISEL == 7);
    static constexpr bool PERM = true;
    const bf16_t* G; bf16_t* O; const float* bias;
    __device__ __forceinline__ void operator()(const f32x4 (&acc)[2][2][4][2], const Unit& u, int wr, int wc, int fr, int fq) const {
        const int row0 = u.pm * BM + wr * 64 + fr, col0 = u.pn * BM + wc * 32 + 8 * fq;
#pragma unroll
        for (int bj = 0; bj < 2; ++bj) { const f32x4 b0 = *(const f32x4*)(bias + col0 + bj * HALF), b1 = *(const f32x4*)(bias + col0 + bj * HALF + 4);
            u32x4 gq[2][4];
#pragma unroll
            for (int ai = 0; ai < 2; ++ai)
#pragma unroll
                for (int m = 0; m < 4; ++m) gq[ai][m] = *(const u32x4*)(G + (size_t)(row0 + ai * HALF + m * 16) * 512 + col0 + bj * HALF);
            __builtin_amdgcn_sched_barrier(0);
#pragma unroll
            for (int ai = 0; ai < 2; ++ai)
#pragma unroll
                for (int m = 0; m < 4; ++m) { const int row = row0 + ai * HALF + m * 16; const u32x4 g = gq[ai][m];
                    const f32x4 v0 = acc[ai][bj][m][0] + b0, v1 = acc[ai][bj][m][1] + b1;
                    u32x4 w;
                    w.x = pk2(bflo(g.x) * sigmoidf_(v0[0]), bfhi(g.x) * sigmoidf_(v0[1])); w.y = pk2(bflo(g.y) * sigmoidf_(v0[2]), bfhi(g.y) * sigmoidf_(v0[3]));
                    w.z = pk2(bflo(g.z) * sigmoidf_(v1[0]), bfhi(g.z) * sigmoidf_(v1[1])); w.w = pk2(bflo(g.w) * sigmoidf_(v1[2]), bfhi(g.w) * sigmoidf_(v1[3]));
                    *(u32x4*)(O + (size_t)row * D + col0 + bj * HALF) = w; }
            __builtin_amdgcn_sched_barrier(0); }
    }
};
struct EpiSwiGlu { static constexpr bool TIMED = (EPISEL == 4);
    static constexpr bool PERM = true;
    bf16_t* ACT; const float* wpos; const int* tok;
    __device__ __forceinline__ void operator()(const f32x4 (&acc)[2][2][4][2], const Unit& u, int wr, int wc, int fr, int fq) const {
        const int slot = u.aux >> 2, blk = u.aux & 3;
        const int row0 = u.pm * BM + wr * 64 + fr, col0 = slot * 512 + blk * 128 + wc * 32 + 8 * fq;
        float wv[2][4];
#pragma unroll
        for (int ai = 0; ai < 2; ++ai)
#pragma unroll
            for (int m = 0; m < 4; ++m) wv[ai][m] = wpos[2 * ((size_t)(u.rows - tok) + (size_t)(wr * 64 + fr + ai * HALF + m * 16)) + slot];
        __builtin_amdgcn_sched_barrier(0);
#pragma unroll
        for (int ai = 0; ai < 2; ++ai)
#pragma unroll
            for (int m = 0; m < 4; ++m) { const int row = row0 + ai * HALF + m * 16; const float w = wv[ai][m];
                const f32x4 g0 = acc[ai][0][m][0], g1 = acc[ai][0][m][1], u0 = acc[ai][1][m][0], u1 = acc[ai][1][m][1];
                u32x4 o;
                o.x = pk2(w * siluf_(g0[0]) * u0[0], w * siluf_(g0[1]) * u0[1]); o.y = pk2(w * siluf_(g0[2]) * u0[2], w * siluf_(g0[3]) * u0[3]);
                o.z = pk2(w * siluf_(g1[0]) * u1[0], w * siluf_(g1[1]) * u1[1]); o.w = pk2(w * siluf_(g1[2]) * u1[2], w * siluf_(g1[3]) * u1[3]);
                *(u32x4*)(ACT + (size_t)row * D + col0) = o; }
    }
};
template <bool FINAL> struct EpiDown {
    static constexpr bool PERM = true; static constexpr bool TIMED = (EPISEL == (FINAL ? 6 : 5));
    const int* tok; float* outp; bf16_t* xr; const bf16_t* mod  ;
    __device__ __forceinline__ void operator()(const f32x4 (&acc)[2][2][4][2], const Unit& u, int wr, int wc, int fr, int fq) const {
        const int col0 = u.pn * BM + wc * 32 + 8 * fq;
        int rr[2][4];
#pragma unroll
        for (int ai = 0; ai < 2; ++ai)
#pragma unroll
            for (int m = 0; m < 4; ++m) { const int li = ai * HALF + wr * 64 + m * 16 + fr; const int rv = u.rows[li]; rr[ai][m] = li < u.nv ? rv : -1; }
        __builtin_amdgcn_sched_barrier(0);
#pragma unroll
        for (int ai = 0; ai < 2; ++ai)
#pragma unroll
          for (int m0 = 0; m0 < 4; m0 += 2) {
            u32x4 q[2][2], gq[2][2];
#pragma unroll
            for (int mm = 0; mm < 2; ++mm) { const int r = rr[ai][m0 + mm]; const int rc = r < 0 ? 0 : r;
                const int b = rc / LT, p = rc % LT; const bool isctx = p < CTXL;
                const bf16_t* xp = xr + (size_t)rc * D + col0; const bf16_t* gv = mod + (isctx ? 16 : b) * 6144 + col0;
#pragma unroll
                for (int bj = 0; bj < 2; ++bj) { q[mm][bj] = *(const u32x4*)(xp + bj * HALF); gq[mm][bj] = *(const u32x4*)(gv + bj * HALF); } }
            __builtin_amdgcn_sched_barrier(0);
#pragma unroll
            for (int mm = 0; mm < 2; ++mm) { const int m = m0 + mm; const int r = rr[ai][m]; const int rc = r < 0 ? 0 : r;
                const int b = rc / LT, p = rc % LT; const bool isctx = p < CTXL;
                bf16_t* xp = xr + (size_t)rc * D + col0;
                float* op = outp + ((size_t)(b * SEQ + (isctx ? 0 : p - CTXL))) * D + col0;
#pragma unroll
                for (int bj = 0; bj < 2; ++bj) { const u32x4 qq = q[mm][bj], gg = gq[mm][bj];
                    const f32x4 g0 = (f32x4){bflo(gg.x), bfhi(gg.x), bflo(gg.y), bfhi(gg.y)}, g1 = (f32x4){bflo(gg.z), bfhi(gg.z), bflo(gg.w), bfhi(gg.w)};
                    const f32x4 s0 = (f32x4){bflo(qq.x), bfhi(qq.x), bflo(qq.y), bfhi(qq.y)} + g0 * acc[ai][bj][m][0], s1 = (f32x4){bflo(qq.z), bfhi(qq.z), bflo(qq.w), bfhi(qq.w)} + g1 * acc[ai][bj][m][1];
                    if (r >= 0) {
                        if (FINAL) { *(f32x4*)(op + bj * HALF) = s0; *(f32x4*)(op + bj * HALF + 4) = s1; }
                        else { u32x4 w; w.x = pk2(s0[0], s0[1]); w.y = pk2(s0[2], s0[3]); w.z = pk2(s1[0], s1[1]); w.w = pk2(s1[2], s1[3]); *(u32x4*)(xp + bj * HALF) = w; } } } }
            __builtin_amdgcn_sched_barrier(0);
          }
    }
};
}
namespace attn_body {
constexpr int DH = 64, PQ = NP0, PO = D;
constexpr int NW = 8, QBLK = 32, QB = QBLK * NW, KVBLK = 64;
__device__ __forceinline__ int crow(int r, int hi) { return (r & 3) + 8 * (r >> 2) + 4 * hi; }
#define SBAR() __builtin_amdgcn_sched_barrier(0)
constexpr int NSLOT = 3, SLOTB = 8192;
constexpr int LDS_K = 0, LDS_V = NSLOT * SLOTB, LDS_WS = 2 * NSLOT * SLOTB, LDS_OST = LDS_WS + NW * 64 * 4, LDS_BYTES_A = LDS_OST + NW * 4096;
constexpr float C2 = 0.125f * 1.4426950408889634f;
__device__ __forceinline__ void glds16(const void* gsrc, unsigned lds_dst) { unsigned keep;
    asm volatile("s_mov_b32 %0, m0\n\ts_mov_b32 m0, %2\n\ts_nop 0\n\tglobal_load_lds_dwordx4 %1, off\n\ts_mov_b32 m0, %0" : "=&s"(keep) : "v"(gsrc), "s"(lds_dst) : "memory"); }
__device__ __forceinline__ float max3f(float a, float b, float c) { float r; asm("v_max3_f32 %0, %1, %2, %3" : "=v"(r) : "v"(a), "v"(b), "v"(c)); return r; }
__device__ __forceinline__ float max2f(float a, float b) { float r; asm("v_max_f32_e32 %0, %1, %2" : "=v"(r) : "v"(a), "v"(b)); return r; }
__device__ __forceinline__ float fadd_s(float a, float b) { float r; asm("v_add_f32_e32 %0, %1, %2" : "=v"(r) : "v"(a), "v"(b)); return r; }
__device__ __forceinline__ float fsub_s(float a, float b) { float r; asm("v_sub_f32_e32 %0, %1, %2" : "=v"(r) : "v"(a), "v"(b)); return r; }
__device__ __forceinline__ unsigned cvtpk_s(float lo, float hi) { return pk2(lo, hi); }
#define WAIT_BAR(N) asm volatile("s_waitcnt vmcnt(" #N ") lgkmcnt(0)\n\ts_barrier" ::: "memory")

__device__ __forceinline__ void qkt(f32x16& p0, f32x16& p1, const char* Kslot, const bf16x8* qr, const f32x16& negm, int r32, int hi) {
    const char* kb = Kslot + hi * 1024 + r32 * 16;
#pragma unroll
    for (int d0 = 0; d0 < 4; ++d0) {
        const bf16x8 b0 = *reinterpret_cast<const bf16x8*>(kb + d0 * 2048);
        const bf16x8 b1 = *reinterpret_cast<const bf16x8*>(kb + d0 * 2048 + 512);
        if (d0 == 0) { p0 = __builtin_amdgcn_mfma_f32_32x32x16_bf16(b0, qr[0], negm, 0, 0, 0); p1 = __builtin_amdgcn_mfma_f32_32x32x16_bf16(b1, qr[0], negm, 0, 0, 0); }
        else { p0 = __builtin_amdgcn_mfma_f32_32x32x16_bf16(b0, qr[d0], p0, 0, 0, 0); p1 = __builtin_amdgcn_mfma_f32_32x32x16_bf16(b1, qr[d0], p1, 0, 0, 0); } }
}
typedef __attribute__((address_space(3))) const char* lds_cptr;
typedef short v4i16_t __attribute__((ext_vector_type(4)));
__device__ __forceinline__ void kload8(bf16x8* kf, lds_cptr kp) {
    kf[0] = *(const LAS bf16x8*)(kp);        kf[1] = *(const LAS bf16x8*)(kp + 512);
    kf[2] = *(const LAS bf16x8*)(kp + 2048); kf[3] = *(const LAS bf16x8*)(kp + 2560);
    kf[4] = *(const LAS bf16x8*)(kp + 4096); kf[5] = *(const LAS bf16x8*)(kp + 4608);
    kf[6] = *(const LAS bf16x8*)(kp + 6144); kf[7] = *(const LAS bf16x8*)(kp + 6656);
}
__device__ __forceinline__ void kload2(bf16x8* kf, lds_cptr kp, int j) { kf[2 * j] = *(const LAS bf16x8*)(kp + j * 2048); kf[2 * j + 1] = *(const LAS bf16x8*)(kp + j * 2048 + 512); }
__device__ __forceinline__ s16x4 vtr(lds_cptr p) { return __builtin_bit_cast(s16x4, __builtin_amdgcn_ds_read_tr16_b64_v4i16((LAS v4i16_t*)p)); }
__device__ __forceinline__ float rowmax(const f32x16& p0, const f32x16& p1) {
    float a = max3f(p0[0], p0[1], p1[0]), b = max3f(p0[2], p0[3], p1[1]); a = max3f(a, p1[2], p1[3]);
#pragma unroll
    for (int r = 4; r < 16; r += 4) { a = max3f(a, p0[r], p0[r + 1]); b = max3f(b, p0[r + 2], p0[r + 3]); a = max3f(a, p1[r], p1[r + 1]); b = max3f(b, p1[r + 2], p1[r + 3]); }
    const float m = max2f(a, b);
    auto rr = __builtin_amdgcn_permlane32_swap(__float_as_uint(m), __float_as_uint(m), false, false);
    return max2f(__uint_as_float(rr[0]), __uint_as_float(rr[1]));
}
__device__ __forceinline__ void pv(f32x16* o, int vb, bf16x8 pa0, bf16x8 pa1, bf16x8 pa2, bf16x8 pa3) {
#pragma unroll
    for (int d0 = 0; d0 < 2; ++d0) { s16x4 lo[4], hi[4];
#pragma unroll
        for (int ks = 0; ks < 4; ++ks) {
            asm volatile("ds_read_b64_tr_b16 %0,%1 offset:%c2" : "=&v"(lo[ks]) : "v"(vb), "i"(d0 * 4096 + ks * 1024) : "memory");
            asm volatile("ds_read_b64_tr_b16 %0,%1 offset:%c2" : "=&v"(hi[ks]) : "v"(vb), "i"(d0 * 4096 + ks * 1024 + 512) : "memory"); }
        asm volatile("s_waitcnt lgkmcnt(0)" ::: "memory"); SBAR();
#define PK(k) (bf16x8){lo[k][0], lo[k][1], lo[k][2], lo[k][3], hi[k][0], hi[k][1], hi[k][2], hi[k][3]}
        o[d0] = __builtin_amdgcn_mfma_f32_32x32x16_bf16(pa0, PK(0), o[d0], 0, 0, 0);
        o[d0] = __builtin_amdgcn_mfma_f32_32x32x16_bf16(pa1, PK(1), o[d0], 0, 0, 0);
        o[d0] = __builtin_amdgcn_mfma_f32_32x32x16_bf16(pa2, PK(2), o[d0], 0, 0, 0);
        o[d0] = __builtin_amdgcn_mfma_f32_32x32x16_bf16(pa3, PK(3), o[d0], 0, 0, 0);
#undef PK
    }
}
__device__ __forceinline__ void rope_cs(float pos, int i, float& c, float& s) {
    const float inv = __builtin_amdgcn_exp2f(-(float)i * 0.83048202372184058696f);
    float rev = pos * inv * 0.15915494309189533577f; rev = rev - floorf(rev);
    c = __builtin_amdgcn_cosf(rev); s = __builtin_amdgcn_sinf(rev);
}

template <int THRL> __device__ __forceinline__ void attn_unit(int b, int h, int qb, const bf16_t* Pbuf, bf16_t* O, const float* qgain, char* shm, int wave_s) {
    const int tid = opaque_tid(wave_s), lane = tid & 63, r32 = lane & 31, hi = lane >> 5; const int wid = __builtin_amdgcn_readfirstlane(tid >> 6);
    const long rowbase = (long)b * LT; const int q0 = qb * QB; const int kvh = h >> 2;
    const bf16_t* Qw = Pbuf + (rowbase + q0 + wid * QBLK) * PQ + C_AQ + h * DH;
    const bf16_t* Kh = Pbuf + rowbase * PQ + C_AK + kvh * DH; const bf16_t* Vh = Pbuf + rowbase * PQ + C_AV + kvh * DH;
    const unsigned lds0 = (unsigned)(uintptr_t)shm;
    float* wsf = (float*)(shm + LDS_WS) + wid * 64;
    const bf16_t* ksrc = Kh + (long)lane * PQ + wid * 8;
    const bf16_t* vsrc = Vh + (long)(16 * (wid & 3) + (lane >> 2)) * PQ + (wid >> 2) * 32 + (lane & 3) * 8;
    const unsigned kdst = lds0 + LDS_K + wid * 1024, vdst = lds0 + LDS_V + wid * 1024;
#define DMA_K(t, slot) glds16(ksrc + (long)(t) * KVBLK * PQ, (unsigned)__builtin_amdgcn_readfirstlane(kdst + (slot)))
#define DMA_V(t, slot) glds16(vsrc + (long)(t) * KVBLK * PQ, (unsigned)__builtin_amdgcn_readfirstlane(vdst + (slot)))
    const int vb0 = (int)(lds0 + LDS_V) + ((lane >> 4) & 1) * 32 + (lane & 3) * 8 + (4 * hi + ((lane & 15) >> 2)) * 64;
    const char* Kbase = shm + LDS_K; bf16x8 kf[8];
    const lds_cptr shm3 = (lds_cptr)shm; const lds_cptr kp0 = shm3 + LDS_K + hi * 1024 + r32 * 16; const lds_cptr vp0 = shm3 + LDS_V + ((lane >> 4) & 1) * 32 + (lane & 3) * 8 + (4 * hi + ((lane & 15) >> 2)) * 64;
    const int NT = (qb == 0) ? (CTXL / KVBLK) : (LT / KVBLK);
    DMA_K(0, 0); DMA_V(0, 0); DMA_K(1, SLOTB);
    bf16x8 qr[4];
    {
        u32x4 raw[4];
#pragma unroll
        for (int d0 = 0; d0 < 4; ++d0) raw[d0] = *reinterpret_cast<const u32x4*>(&Qw[(long)r32 * PQ + d0 * 16 + hi * 8]);
        float qf[4][8]; float ss = 0.f;
#pragma unroll
        for (int d0 = 0; d0 < 4; ++d0) {
            qf[d0][0] = bflo(raw[d0].x); qf[d0][1] = bfhi(raw[d0].x); qf[d0][2] = bflo(raw[d0].y); qf[d0][3] = bfhi(raw[d0].y);
            qf[d0][4] = bflo(raw[d0].z); qf[d0][5] = bfhi(raw[d0].z); qf[d0][6] = bflo(raw[d0].w); qf[d0][7] = bfhi(raw[d0].w);
#pragma unroll
            for (int j = 0; j < 8; ++j) ss += qf[d0][j] * qf[d0][j]; }
        ss += xorl<32>(ss);
        const float rstd = rsqrtf(ss * (1.f / 64.f) + NORM_EPS);
#pragma unroll
        for (int d0 = 0; d0 < 4; ++d0)
#pragma unroll
            for (int j = 0; j < 8; ++j) qf[d0][j] *= rstd * qgain[d0 * 16 + hi * 8 + j];
        if (qb > 0) {
            const int t = q0 - CTXL + wid * QBLK + r32; const float prow = (float)(t >> 6), pcol = (float)(t & 63);
#pragma unroll
            for (int j = 0; j < 8; ++j) { float c, s;
                rope_cs(prow, hi * 8 + j, c, s); { const float x1 = qf[0][j], x2 = qf[1][j]; qf[0][j] = x1 * c - x2 * s; qf[1][j] = x2 * c + x1 * s; }
                rope_cs(pcol, hi * 8 + j, c, s); { const float x1 = qf[2][j], x2 = qf[3][j]; qf[2][j] = x1 * c - x2 * s; qf[3][j] = x2 * c + x1 * s; } }
        }
#pragma unroll
        for (int d0 = 0; d0 < 4; ++d0) { u32x4 w; w.x = pk2(qf[d0][0] * C2, qf[d0][1] * C2); w.y = pk2(qf[d0][2] * C2, qf[d0][3] * C2); w.z = pk2(qf[d0][4] * C2, qf[d0][5] * C2); w.w = pk2(qf[d0][6] * C2, qf[d0][7] * C2);
            qr[d0] = __builtin_bit_cast(bf16x8, w); }
    }
    float mhat = 0.f, l_reg = 0.f; f32x16 o[2]; o[0] = f32x16{}; o[1] = f32x16{}; f32x16 negm = f32x16{}; asm volatile("" : "+v"(negm));
    bool resc = false;
#define START(P0, P1) do { const float rm = rowmax(P0, P1); resc = false; \
    { const float dl = rm; mhat = fadd_s(mhat, dl); \
      _Pragma("unroll") for (int r = 0; r < 16; ++r) { P0[r] = fsub_s(P0[r], dl); P1[r] = fsub_s(P1[r], dl); } \
      _Pragma("unroll") for (int r = 0; r < 16; ++r) negm[r] = -mhat; asm volatile("" : "+v"(negm)); } \
    _Pragma("unroll") for (int r = 0; r < 16; ++r) P0[r] = __builtin_amdgcn_exp2f(P0[r]); } while (0)
#define RESC() do { if (resc) { asm volatile("s_waitcnt lgkmcnt(0)" ::: "memory"); \
      _Pragma("unroll") for (int d_ = 0; d_ < 2; ++d_) _Pragma("unroll") for (int r = 0; r < 16; ++r) o[d_][r] *= wsf[crow(r, hi)]; } } while (0)
    f32x16 pA0, pA1, pB0, pB1;
    int sl_prev = 0, sl_cur = 0, sl_next = SLOTB;
#define ROT() do { sl_prev = sl_cur; sl_cur = sl_next; sl_next = (sl_next == (NSLOT - 1) * SLOTB) ? 0 : sl_next + SLOTB; } while (0)
    DMA_K(2, 2 * SLOTB);
    WAIT_BAR(3);
    qkt(pA0, pA1, Kbase, qr, negm, r32, hi); asm volatile("s_nop 15\n\ts_nop 7" : "+v"(pA0), "+v"(pA1));
    START(pA0, pA1);
    _Pragma("unroll") for (int r = 0; r < 16; ++r) pA1[r] = __builtin_amdgcn_exp2f(pA1[r]);
    WAIT_BAR(0);
    DMA_K(3, 0); DMA_V(1, SLOTB);
    ROT();
    kload8(kf, kp0 + sl_cur);
    WAIT_BAR(2);
    s16x4 vlo[8], vhi[8]; u32x4 pw0, pw1, pw2, pw3;
#define PKW(P, B) cvtpk_s(P[B], P[B + 1])
#define PAF(k) __builtin_bit_cast(bf16x8, pw##k)
#define VFR(i) (bf16x8){vlo[i][0], vlo[i][1], vlo[i][2], vlo[i][3], vhi[i][0], vhi[i][1], vhi[i][2], vhi[i][3]}
#define PIN(x) asm volatile("" : "+v"(x))
#define MX3(a, b, c) __builtin_fmaxf(__builtin_fmaxf((a), (b)), (c))
#define GAPA(MF, A0, A1, A2, A3, W0, W1, PW) do { MF; sacc += A0; sacc += A1; sacc += A2; sacc += A3; PIN(sacc); W0; W1; PIN(PW); SBAR(); } while (0)
#define EX(v) __builtin_amdgcn_exp2f(v)
#define GAPB(MF, X, B) do { MF; X[B] = EX(X[B]); X[B + 1] = EX(X[B + 1]); X[B + 2] = EX(X[B + 2]); X[B + 3] = EX(X[B + 3]); PIN(X); SBAR(); } while (0)
#define VRD(i) do { vlo[i] = vtr(vp_ + (((i) >> 2) * 4096 + ((i) & 3) * 1024)); vhi[i] = vtr(vp_ + (((i) >> 2) * 4096 + ((i) & 3) * 1024 + 512)); } while (0)
#define KRD(G_, j) do { if (G_) { kload2(kf, kp0 + sl_next, j); SBAR(); } } while (0)
#define STEP(C0, C1, P0, P1, t, GK, GV, GL) do { SBAR(); \
    const lds_cptr vp_ = vp0 + sl_prev; \
    VRD(0); SBAR(); float sacc = (P0[0] + P0[1]); \
    GAPA(C0 = __builtin_amdgcn_mfma_f32_32x32x16_bf16(kf[0], qr[0], negm, 0, 0, 0), P0[2], P0[3], P0[4], P0[5],     pw0[0] = PKW(P0, 0), pw0[1] = PKW(P0, 2), pw0); \
    VRD(4); SBAR(); GAPA(C1 = __builtin_amdgcn_mfma_f32_32x32x16_bf16(kf[1], qr[0], negm, 0, 0, 0), P0[6], P0[7], P0[8], P0[9],     pw0[2] = PKW(P0, 4), pw0[3] = PKW(P0, 6), pw0); \
    VRD(1); SBAR(); GAPA(C0 = __builtin_amdgcn_mfma_f32_32x32x16_bf16(kf[2], qr[1], C0, 0, 0, 0),   P0[10], P0[11], P0[12], P0[13], pw1[0] = PKW(P0, 8), pw1[1] = PKW(P0, 10), pw1); \
    VRD(5); SBAR(); GAPA(C1 = __builtin_amdgcn_mfma_f32_32x32x16_bf16(kf[3], qr[1], C1, 0, 0, 0),   P0[14], P0[15], P1[0], P1[1],   pw1[2] = PKW(P0, 12), pw1[3] = PKW(P0, 14), pw1); \
    VRD(2); SBAR(); GAPA(C0 = __builtin_amdgcn_mfma_f32_32x32x16_bf16(kf[4], qr[2], C0, 0, 0, 0),   P1[2], P1[3], P1[4], P1[5],     pw2[0] = PKW(P1, 0), pw2[1] = PKW(P1, 2), pw2); \
    VRD(6); SBAR(); GAPA(C1 = __builtin_amdgcn_mfma_f32_32x32x16_bf16(kf[5], qr[2], C1, 0, 0, 0),   P1[6], P1[7], P1[8], P1[9],     pw2[2] = PKW(P1, 4), pw2[3] = PKW(P1, 6), pw2); \
    VRD(3); SBAR(); GAPA(C0 = __builtin_amdgcn_mfma_f32_32x32x16_bf16(kf[6], qr[3], C0, 0, 0, 0),   P1[10], P1[11], P1[12], P1[13], pw3[0] = PKW(P1, 8), pw3[1] = PKW(P1, 10), pw3); \
    VRD(7); SBAR(); GAPA(C1 = __builtin_amdgcn_mfma_f32_32x32x16_bf16(kf[7], qr[3], C1, 0, 0, 0),   P1[14], P1[15], 0.f, 0.f,       pw3[2] = PKW(P1, 12), pw3[3] = PKW(P1, 14), pw3); \
    l_reg += sacc; \
    if (GK) { DMA_K((t) + 3, sl_cur); } if (GV) { DMA_V((t) + 1, sl_next); } \
    { float a = MX3(C0[0], C0[1], C1[0]), b_ = MX3(C0[2], C0[3], C1[1]); a = MX3(a, C1[2], C1[3]); \
      _Pragma("unroll") for (int r = 4; r < 16; r += 4) { a = MX3(a, C0[r], C0[r + 1]); b_ = MX3(b_, C0[r + 2], C0[r + 3]); a = MX3(a, C1[r], C1[r + 1]); b_ = MX3(b_, C1[r + 2], C1[r + 3]); } \
      float rm = __builtin_fmaxf(a, b_); { auto rr = __builtin_amdgcn_permlane32_swap(__float_as_uint(rm), __float_as_uint(rm), false, false); rm = __builtin_fmaxf(__uint_as_float(rr[0]), __uint_as_float(rr[1])); } \
      resc = false; \
      if (__builtin_expect(__any(rm > (float)THRL), 0)) { const float dl = __builtin_fmaxf(rm, 0.f); mhat += dl; \
        _Pragma("unroll") for (int r = 0; r < 16; ++r) { C0[r] -= dl; C1[r] -= dl; } \
        _Pragma("unroll") for (int r = 0; r < 16; ++r) negm[r] = -mhat; asm volatile("" : "+v"(negm)); \
        const float f = __builtin_amdgcn_exp2f(-dl); l_reg *= f; if (hi == 0) wsf[r32] = f; resc = true; } } \
    SBAR(); \
    GAPB(o[0] = __builtin_amdgcn_mfma_f32_32x32x16_bf16(PAF(0), VFR(0), o[0], 0, 0, 0), C0, 0); \
    GAPB(o[1] = __builtin_amdgcn_mfma_f32_32x32x16_bf16(PAF(0), VFR(4), o[1], 0, 0, 0), C0, 4); \
    KRD(GL, 0); GAPB(o[0] = __builtin_amdgcn_mfma_f32_32x32x16_bf16(PAF(1), VFR(1), o[0], 0, 0, 0), C0, 8); \
    KRD(GL, 1); GAPB(o[1] = __builtin_amdgcn_mfma_f32_32x32x16_bf16(PAF(1), VFR(5), o[1], 0, 0, 0), C0, 12); \
    KRD(GL, 2); GAPB(o[0] = __builtin_amdgcn_mfma_f32_32x32x16_bf16(PAF(2), VFR(2), o[0], 0, 0, 0), C1, 0); \
    KRD(GL, 3); GAPB(o[1] = __builtin_amdgcn_mfma_f32_32x32x16_bf16(PAF(2), VFR(6), o[1], 0, 0, 0), C1, 4); \
    GAPB(o[0] = __builtin_amdgcn_mfma_f32_32x32x16_bf16(PAF(3), VFR(3), o[0], 0, 0, 0), C1, 8); \
    GAPB(o[1] = __builtin_amdgcn_mfma_f32_32x32x16_bf16(PAF(3), VFR(7), o[1], 0, 0, 0), C1, 12); \
    } while (0)
    int t = 1;
    for (; t + 5 < NT; t += 2) {
        STEP(pB0, pB1, pA0, pA1, t, true, true, true);     WAIT_BAR(2); RESC(); ROT();
        STEP(pA0, pA1, pB0, pB1, t + 1, true, true, true); WAIT_BAR(2); RESC(); ROT();
    }
#define ENDW(tt) do { if ((tt) + 3 < NT) { WAIT_BAR(2); } else if ((tt) + 2 < NT) { WAIT_BAR(1); } else { WAIT_BAR(0); } } while (0)
    for (; t + 1 < NT; t += 2) {
        STEP(pB0, pB1, pA0, pA1, t, (t + 3 < NT), (t + 1 < NT), (t + 1 < NT));         ENDW(t);     RESC(); ROT();
        STEP(pA0, pA1, pB0, pB1, t + 1, (t + 4 < NT), (t + 2 < NT), (t + 2 < NT));     ENDW(t + 1); RESC(); ROT();
    }
    STEP(pB0, pB1, pA0, pA1, NT - 1, false, false, false); RESC();
    { float sacc = pB0[0] + pB0[1]; _Pragma("unroll") for (int r = 2; r < 16; ++r) sacc += pB0[r]; _Pragma("unroll") for (int r = 0; r < 16; ++r) sacc += pB1[r]; l_reg += sacc;
      pw0 = (u32x4){PKW(pB0, 0), PKW(pB0, 2), PKW(pB0, 4), PKW(pB0, 6)}; pw1 = (u32x4){PKW(pB0, 8), PKW(pB0, 10), PKW(pB0, 12), PKW(pB0, 14)}; pw2 = (u32x4){PKW(pB1, 0), PKW(pB1, 2), PKW(pB1, 4), PKW(pB1, 6)}; pw3 = (u32x4){PKW(pB1, 8), PKW(pB1, 10), PKW(pB1, 12), PKW(pB1, 14)};
      SBAR(); pv(o, vb0 + sl_cur, PAF(0), PAF(1), PAF(2), PAF(3)); }
#undef PKW
#undef PAF
#undef VFR
#undef PIN
#undef MX3
#undef GAPA
#undef GAPB
#undef EX
#undef VRD
#undef KRD
#undef STEP
#undef ENDW
    { auto rr = __builtin_amdgcn_permlane32_swap(__float_as_uint(l_reg), __float_as_uint(l_reg), false, false); l_reg = __uint_as_float(rr[0]) + __uint_as_float(rr[1]); }
    if (hi == 0) wsf[32 + r32] = l_reg; asm volatile("s_waitcnt lgkmcnt(0)" ::: "memory");
    float rli[16];
#pragma unroll
    for (int r = 0; r < 16; ++r) rli[r] = __builtin_amdgcn_rcpf(wsf[32 + crow(r, hi)]);
    bf16_t* Ow = O + (rowbase + q0 + wid * QBLK) * PO + 512 + h * DH;
    { bf16_t* stg = (bf16_t*)(shm + LDS_OST) + wid * 2048;
#pragma unroll
      for (int r = 0; r < 16; ++r) { const int orow = crow(r, hi);
#pragma unroll
          for (int d0 = 0; d0 < 2; ++d0) stg[orow * 64 + d0 * 32 + r32] = f2bf(o[d0][r] * rli[r]); }
      asm volatile("s_waitcnt lgkmcnt(0)" ::: "memory");
#pragma unroll
      for (int i = 0; i < 4; ++i) { const int row = i * 8 + (lane >> 3), ch = lane & 7; const u32x4 v = *(const u32x4*)(stg + row * 64 + ch * 8); *(u32x4*)(Ow + (long)row * PO + ch * 8) = v; } }
    asm volatile("s_waitcnt lgkmcnt(0)\n\ts_barrier" ::: "memory");
#undef DMA_K
#undef DMA_V
#undef START
#undef RESC
#undef ROT
}
#undef SBAR
#undef WAIT_BAR
}

__device__ __forceinline__ void knorm_phase(Frame& F) {
    bf16_t* Pb = (bf16_t*)(F.ws + WS_P); const float* kg = F.p->in[I_KNORM];
    const int kvh = F.lane >> 5, half = (F.lane >> 4) & 1, i = F.lane & 15, d1 = half * 32 + i, d2 = d1 + 16;
    const float g1 = kg[d1], g2 = kg[d2];
    const int r0 = wave_row0(F.bid, F.wave);
#pragma unroll 1
    for (int ri3 = 0; ri3 < ROWS_PER_WAVE; ri3 += 6) {
        float x1[6], x2[6];
#pragma unroll
        for (int q = 0; q < 6; ++q) { const bf16_t* kp = Pb + (size_t)(r0 + ri3 + q) * NP0 + C_AK + kvh * 64; x1[q] = bf2f(kp[d1]); x2[q] = bf2f(kp[d2]); }
#pragma unroll
        for (int q = 0; q < 6; ++q) {
            const int r = r0 + ri3 + q, p = r % LT;
            bf16_t* kp = Pb + (size_t)r * NP0 + C_AK + kvh * 64;
            float a1 = x1[q], a2 = x2[q];
            float ss = a1 * a1 + a2 * a2;
            ss += dppf<0xB1>(ss); ss += dppf<0x4E>(ss); ss += dppf<0x141>(ss); ss += dppf<0x140>(ss); ss += xorl<16>(ss);
            const float rstd = rsqrtf(ss * (1.f / 64.f) + NORM_EPS);
            a1 *= rstd * g1; a2 *= rstd * g2;
            if (p >= CTXL) { const int t = p - CTXL; const float pos = half ? (float)(t & 63) : (float)(t >> 6); float c, s; attn_body::rope_cs(pos, i, c, s);
                const float y1 = a1 * c - a2 * s, y2 = a2 * c + a1 * s; a1 = y1; a2 = y2; }
            kp[d1] = f2bf(a1); kp[d2] = f2bf(a2);
        }
    }
}
namespace mix {
typedef LAS unsigned char* lptr;
__device__ __forceinline__ bf16x8 frag(const LAS unsigned char* base, int pitch, int row0, int k0, int lane) {
    return *(const LAS bf16x8*)(base + (row0 + (lane & 15)) * pitch + (k0 + 8 * (lane >> 4)) * 2);
}
#define MFMA16(a, b, c) __builtin_amdgcn_mfma_f32_16x16x32_bf16(a, b, c, 0, 0, 0)
__device__ __forceinline__ float log1p_fast(float e) { const float a = __logf(1.f + e), b = e * (1.f + e * (-0.5f + e * 0.33333334f)); return e < 0.01f ? b : a; }
__device__ __forceinline__ float log_sigmoid(float x) { return fminf(x, 0.f) - log1p_fast(__expf(-fabsf(x))); }
__device__ __forceinline__ float softplus(float x) { return fmaxf(x, 0.f) + log1p_fast(__expf(-fabsf(x))); }
template <int CTRL> __device__ __forceinline__ float dpp_old(float oldv, float v) { return __int_as_float(__builtin_amdgcn_update_dpp(__float_as_int(oldv), __float_as_int(v), CTRL, 0xf, 0xf, false)); }
__device__ __forceinline__ float scan_add(float v, int lane) {
    v += dpp_old<0x111>(0.f, v); v += dpp_old<0x112>(0.f, v); v += dpp_old<0x114>(0.f, v); v += dpp_old<0x118>(0.f, v);
    const float t0 = rdlane(v, 15), t1 = rdlane(v, 31), t2 = rdlane(v, 47);
    float off = (lane >= 16) ? t0 : 0.f; off += (lane >= 32) ? t1 : 0.f; off += (lane >= 48) ? t2 : 0.f;
    return v + off;
}
__device__ __forceinline__ float scan_max(float v, int lane) {
    const float ninf = -INFINITY;
    v = fmaxf(v, dpp_old<0x111>(ninf, v)); v = fmaxf(v, dpp_old<0x112>(ninf, v)); v = fmaxf(v, dpp_old<0x114>(ninf, v)); v = fmaxf(v, dpp_old<0x118>(ninf, v));
    const float t0 = rdlane(v, 15), t1 = rdlane(v, 31), t2 = rdlane(v, 47);
    float off = (lane >= 16) ? t0 : ninf; off = fmaxf(off, (lane >= 32) ? t1 : ninf); off = fmaxf(off, (lane >= 48) ? t2 : ninf);
    return fmaxf(v, off);
}
__device__ __forceinline__ void unpack8(const u32x4 r, float* f) { f[0] = bflo(r.x); f[1] = bfhi(r.x); f[2] = bflo(r.y); f[3] = bfhi(r.y); f[4] = bflo(r.z); f[5] = bfhi(r.z); f[6] = bflo(r.w); f[7] = bfhi(r.w); }

typedef short v4i16_t __attribute__((ext_vector_type(4)));
__device__ __forceinline__ bf16x8 trfrag(const LAS unsigned char* base, int pitch, int k0, int c0, int lane) {
    const int g = lane >> 4, i = lane & 15, q = i >> 2, pp = i & 3;
    const LAS unsigned char* a0 = base + (k0 + 8 * g + q) * pitch + (c0 + 4 * pp) * 2;
    const v4i16_t lo = __builtin_amdgcn_ds_read_tr16_b64_v4i16((LAS v4i16_t*)a0);
    const v4i16_t hi = __builtin_amdgcn_ds_read_tr16_b64_v4i16((LAS v4i16_t*)(a0 + 4 * pitch));
    return (bf16x8){lo[0], lo[1], lo[2], lo[3], hi[0], hi[1], hi[2], hi[3]};
}
__device__ __forceinline__ void mlstm_unit(Frame& F, int b, int hd, int dir) {
    const int tid = F.tid, lane = F.lane, w = F.wave, l15 = lane & 15, l4 = lane >> 4;
    const bf16_t* Pb = (const bf16_t*)(F.ws + WS_P); const float* GT = (const float*)(F.ws + WS_GATES);
    bf16_t* Y = (bf16_t*)(F.ws + (dir ? WS_Y1 : WS_Y0));
    lptr L = F.lds;
    constexpr int PQK = 272, PT = 144;
    lptr Qs = L, Ks = L + 17408, Kw = L + 34816, Vs = L + 52224, Sw = L + 69632, Cb = L + 78848;
    LAS float* fl = (LAS float*)(L + 113664);
    LAS float *rj = fl, *cs = fl + 64, *gg = fl + 128, *eneg = fl + 192, *wend = fl + 256, *denp = fl + 320  , *nq = fl + 448, *n0 = fl + 512  , *scl = fl + 640, *npart = fl + 704  ;
    const float gbi = F.p->in[I_MLGB][dir * 8 + hd], gbf = F.p->in[I_MLGB][dir * 8 + 4 + hd];
    for (int i = tid; i < 34816 / 4; i += NTHREADS) ((LAS unsigned*)Cb)[i] = 0u;
    if (tid < 128) n0[tid] = 0.f;
    f32x4 accC[8];
#pragma unroll
    for (int i = 0; i < 8; ++i) accC[i] = (f32x4){0.f, 0.f, 0.f, 0.f};
    float m0 = 0.f;
    const size_t rowb = (size_t)b * LT;
    const float kscale = 0.08838834764831845f;
    const int sg = dir ? -1 : 1;
    const int pr = tid >> 4, pc = tid & 15;
    u32x4 nq_[2], nk_[2], nv_[2]; float ngi = 0.f, ngf = 0.f;
    {
        const int p0 = dir ? 255 : 0;
#pragma unroll
        for (int i = 0; i < 2; ++i) { const bf16_t* rp = Pb + (rowb + (size_t)(p0 + sg * (pr + 32 * i))) * NP0 + hd * 128 + 8 * pc;
            nq_[i] = *(const u32x4*)(rp + C_MQ); nk_[i] = *(const u32x4*)(rp + C_MK); nv_[i] = *(const u32x4*)(rp + C_MV); }
        if (w == 0) { const size_t nrow = rowb + (size_t)(p0 + sg * lane); ngi = GT[nrow * 16 + dir * 8 + hd]; ngf = GT[nrow * 16 + dir * 8 + 4 + hd]; }
    }
    for (int c = 0; c < 36; ++c) {
        const int p0 = dir ? (c < 4 ? 255 - 64 * c : 2559 - 64 * c) : 64 * c;
        if (w == 0) {
            const float li = ngi + gbi;
            const float lf = log_sigmoid(ngf + gbf);
            const float bb = scan_add(lf, lane);
            const float csv = li - bb;
            const float pm = scan_max(csv, lane);
            const float inter = bb + m0;
            const float mj = fmaxf(inter, bb + pm);
            const float bend = rdlane(bb, 63), pmend = rdlane(pm, 63);
            const float mnew = fmaxf(bend + m0, pmend + bend);
            rj[lane] = bb - mj; cs[lane] = csv; gg[lane] = __expf(inter - mj); eneg[lane] = __expf(-mj);
            wend[lane] = __expf(csv + bend - mnew);
            if (lane == 0) scl[0] = __expf(bend + m0 - mnew);
            m0 = mnew;
        }
        __syncthreads();
#pragma unroll
        for (int i = 0; i < 2; ++i) {
            const int row = pr + 32 * i; const float we = wend[row];
            *(LAS u32x4*)(Qs + row * PQK + pc * 16) = nq_[i]; *(LAS u32x4*)(Vs + row * PQK + pc * 16) = nv_[i];
            float kf[8]; unpack8(nk_[i], kf);
#pragma unroll
            for (int e = 0; e < 8; ++e) kf[e] *= kscale;
            u32x4 ka; ka.x = pk2(kf[0], kf[1]); ka.y = pk2(kf[2], kf[3]); ka.z = pk2(kf[4], kf[5]); ka.w = pk2(kf[6], kf[7]);
            *(LAS u32x4*)(Ks + row * PQK + pc * 16) = ka;
            u32x4 kb; kb.x = pk2(kf[0] * we, kf[1] * we); kb.y = pk2(kf[2] * we, kf[3] * we); kb.z = pk2(kf[4] * we, kf[5] * we); kb.w = pk2(kf[6] * we, kf[7] * we);
            *(LAS u32x4*)(Kw + row * PQK + pc * 16) = kb;
        }
        {
            const int cn = (c < 35) ? c + 1 : c; const int pn0 = dir ? (cn < 4 ? 255 - 64 * cn : 2559 - 64 * cn) : 64 * cn;
#pragma unroll
            for (int i = 0; i < 2; ++i) { const bf16_t* rp = Pb + (rowb + (size_t)(pn0 + sg * (pr + 32 * i))) * NP0 + hd * 128 + 8 * pc;
                nq_[i] = *(const u32x4*)(rp + C_MQ); nk_[i] = *(const u32x4*)(rp + C_MK); nv_[i] = *(const u32x4*)(rp + C_MV); }
            if (w == 0) { const size_t nrow = rowb + (size_t)(pn0 + sg * lane); ngi = GT[nrow * 16 + dir * 8 + hd]; ngf = GT[nrow * 16 + dir * 8 + 4 + hd]; }
        }
        __syncthreads();
        {
            const int jt = w >> 1, sh = w & 1; float rsum = 0.f;
            const int j = 16 * jt + l15; const float rjj = rj[j];
#pragma unroll
            for (int si = 0; si < 2; ++si) {
                const int st = 2 * sh + si; const int s0 = 16 * st + 4 * l4;
                u32x2 o; o.x = 0u; o.y = 0u;
                if (st <= jt) {
                    f32x4 a = (f32x4){0.f, 0.f, 0.f, 0.f};
#pragma unroll
                    for (int ks = 0; ks < 4; ++ks) a = MFMA16(frag(Ks, PQK, 16 * st, 32 * ks, lane), frag(Qs, PQK, 16 * jt, 32 * ks, lane), a);
                    float vv[4]; const f32x4 c4 = *(const LAS f32x4*)(cs + s0);
#pragma unroll
                    for (int r = 0; r < 4; ++r) { const int s = s0 + r; vv[r] = (s <= j) ? a[r] * __expf(rjj + c4[r]) : 0.f; rsum += vv[r]; }
                    o.x = pk2(vv[0], vv[1]); o.y = pk2(vv[2], vv[3]);
                }
                *(LAS u32x2*)(Sw + j * PT + s0 * 2) = o;
            }
            rsum += xorl<16>(rsum); rsum += xorl<32>(rsum);
            if (l4 == 0) denp[sh * 64 + j] = rsum;
            const int jq = tid >> 3, kp = tid & 7; float a = 0.f;
            const u32x4 qa = *(const LAS u32x4*)(Qs + jq * PQK + kp * 32), qb = *(const LAS u32x4*)(Qs + jq * PQK + kp * 32 + 16);
            float qf[16]; unpack8(qa, qf); unpack8(qb, qf + 8);
#pragma unroll
            for (int e = 0; e < 16; ++e) a += qf[e] * n0[16 * kp + e];
            a += xorl<1>(a); a += xorl<2>(a); a += xorl<4>(a);
            if (kp == 0) nq[jq] = a;
        }
        __syncthreads();
        {
            const int jt = w & 3, vh = w >> 2, j = 16 * jt + l15;
            bf16x8 bS[2], bQ[4];
#pragma unroll
            for (int ks = 0; ks < 2; ++ks) bS[ks] = frag(Sw, PT, 16 * jt, 32 * ks, lane);
#pragma unroll
            for (int ks = 0; ks < 4; ++ks) bQ[ks] = frag(Qs, PQK, 16 * jt, 32 * ks, lane);
            const float g = gg[j], den = denp[j] + denp[64 + j] + g * nq[j];
            const float sc = __builtin_amdgcn_rcpf(fmaxf(fabsf(den), eneg[j]));
            bf16_t* yrow = Y + (rowb + (size_t)(p0 + sg * j)) * 512 + hd * 128;
            bf16x8 fv[2][2], fc[2][4];
#pragma unroll
            for (int ks = 0; ks < 2; ++ks) fv[0][ks] = trfrag(Vs, PQK, 32 * ks, 16 * (4 * vh), lane);
#pragma unroll
            for (int ks = 0; ks < 4; ++ks) fc[0][ks] = frag(Cb, PQK, 16 * (4 * vh), 32 * ks, lane);
#pragma unroll
            for (int vi = 0; vi < 4; ++vi) {
                const int vt = 4 * vh + vi;
                if (vi < 3) {
#pragma unroll
                    for (int ks = 0; ks < 2; ++ks) fv[(vi + 1) & 1][ks] = trfrag(Vs, PQK, 32 * ks, 16 * (vt + 1), lane);
#pragma unroll
                    for (int ks = 0; ks < 4; ++ks) fc[(vi + 1) & 1][ks] = frag(Cb, PQK, 16 * (vt + 1), 32 * ks, lane); }
                __builtin_amdgcn_sched_barrier(0);
                f32x4 a1 = (f32x4){0.f, 0.f, 0.f, 0.f}, a2 = (f32x4){0.f, 0.f, 0.f, 0.f};
#pragma unroll
                for (int ks = 0; ks < 2; ++ks) a1 = MFMA16(fv[vi & 1][ks], bS[ks], a1);
#pragma unroll
                for (int ks = 0; ks < 4; ++ks) a2 = MFMA16(fc[vi & 1][ks], bQ[ks], a2);
                __builtin_amdgcn_sched_barrier(0);
                u32x2 o; o.x = pk2((a1[0] + g * a2[0]) * sc, (a1[1] + g * a2[1]) * sc); o.y = pk2((a1[2] + g * a2[2]) * sc, (a1[3] + g * a2[3]) * sc);
                *(u32x2*)(yrow + 16 * vt + 4 * l4) = o;
            }
        }
        const float decay = scl[0];
        {
            bf16x8 bV[2];
#pragma unroll
            for (int ks = 0; ks < 2; ++ks) bV[ks] = trfrag(Vs, PQK, 32 * ks, 16 * w, lane);
            bf16x8 fk[2][2];
#pragma unroll
            for (int ks = 0; ks < 2; ++ks) fk[0][ks] = trfrag(Kw, PQK, 32 * ks, 0, lane);
#pragma unroll
            for (int kt = 0; kt < 8; ++kt) {
                if (kt < 7) {
#pragma unroll
                    for (int ks = 0; ks < 2; ++ks) fk[(kt + 1) & 1][ks] = trfrag(Kw, PQK, 32 * ks, 16 * (kt + 1), lane); }
                __builtin_amdgcn_sched_barrier(0);
                f32x4 a = accC[kt] * decay;
#pragma unroll
                for (int ks = 0; ks < 2; ++ks) a = MFMA16(fk[kt & 1][ks], bV[ks], a);
                accC[kt] = a;
                __builtin_amdgcn_sched_barrier(0);
            }
            float s0_ = 0.f, s1_ = 0.f;
#pragma unroll
            for (int r = 0; r < 8; ++r) { const unsigned u = *(const LAS unsigned*)(Kw + (8 * w + r) * PQK + lane * 4); s0_ += bflo(u); s1_ += bfhi(u); }
            npart[w * 128 + 2 * lane] = s0_; npart[w * 128 + 2 * lane + 1] = s1_;
        }
        __syncthreads();
#pragma unroll
        for (int kt = 0; kt < 8; ++kt) { u32x2 o; o.x = pk2(accC[kt][0], accC[kt][1]); o.y = pk2(accC[kt][2], accC[kt][3]);
            *(LAS u32x2*)(Cb + (16 * w + l15) * PQK + (16 * kt + 4 * l4) * 2) = o; }
        if (tid < 128) { float a = 0.f;
#pragma unroll
            for (int q = 0; q < 8; ++q) a += npart[q * 128 + tid];
            n0[tid] = decay * n0[tid] + a; }
    }
    __syncthreads();
}

__device__ __forceinline__ void ssd_unit(Frame& F, int b, int hd, int dir) {
    const int tid = F.tid, lane = F.lane, w = F.wave, l15 = lane & 15, l4 = lane >> 4;
    const bf16_t* XB = (const bf16_t*)(F.ws + WS_HB); const float* GT = (const float*)(F.ws + WS_GATES);
    bf16_t* Y = dir ? (bf16_t*)(F.ws + WS_YD1) : (bf16_t*)((unsigned char*)F.p->out + OUT_YD0);
    lptr L = F.lds;
    constexpr int PP = 272, PX = 144;
    lptr Cm = L, BmW = L + 34816, Xr = L + 69632, Xs = L + 88064, Hb = L + 106496;
    LAS float* fl = (LAS float*)(L + 123904);
    LAS float *dtl = fl, *acsl = fl + 128;
    const int grp = hd >> 2;
    const float dtb = F.p->in[I_DTB][dir * 8 + hd], aneg = -__expf(F.p->in[I_ALOG][dir * 8 + hd]), dsk = F.p->in[I_SSDD][hd];
    for (int i = tid; i < 17408 / 4; i += NTHREADS) ((LAS unsigned*)Hb)[i] = 0u;
    f32x4 hacc[4];
#pragma unroll
    for (int i = 0; i < 4; ++i) hacc[i] = (f32x4){0.f, 0.f, 0.f, 0.f};
    const size_t rowb = (size_t)b * LT;
    const int sg = dir ? -1 : 1;
    const int rc = tid >> 4, cc = tid & 15, rx = tid >> 3, cx = tid & 7;
    u32x4 nC[4], nB[4], nX[2]; float ng[2];
    {
        const int p0 = dir ? 255 : 0;
#pragma unroll
        for (int i = 0; i < 4; ++i) { const bf16_t* rp = XB + (rowb + (size_t)(p0 + sg * (rc + 32 * i))) * D; nB[i] = *(const u32x4*)(rp + 512 + grp * 128 + 8 * cc); nC[i] = *(const u32x4*)(rp + 768 + grp * 128 + 8 * cc); }
#pragma unroll
        for (int i = 0; i < 2; ++i) { const bf16_t* rp = XB + (rowb + (size_t)(p0 + sg * (rx + 64 * i))) * D; nX[i] = *(const u32x4*)(rp + hd * 64 + 8 * cx); }
#pragma unroll
        for (int h2 = 0; h2 < 2; ++h2) ng[h2] = GT[(rowb + (size_t)(p0 + sg * (lane + 64 * h2))) * 16 + dir * 8 + hd];
    }
    __syncthreads();
    for (int c = 0; c < 18; ++c) {
        const int p0 = dir ? (c < 2 ? 255 - 128 * c : 2559 - 128 * c) : 128 * c;
        float dt2[2], acs2[2], de2[2];
        {
            float da[2];
#pragma unroll
            for (int h2 = 0; h2 < 2; ++h2) { dt2[h2] = softplus(ng[h2] + dtb); da[h2] = dt2[h2] * aneg; }
            acs2[0] = scan_add(da[0], lane); const float tot0 = rdlane(acs2[0], 63);
            acs2[1] = scan_add(da[1], lane) + tot0; const float aend = rdlane(acs2[1], 63);
            de2[0] = __expf(aend - acs2[0]) * dt2[0]; de2[1] = __expf(aend - acs2[1]) * dt2[1];
            if (w == 0) { dtl[lane] = dt2[0]; dtl[64 + lane] = dt2[1]; acsl[lane] = acs2[0]; acsl[64 + lane] = acs2[1]; }
        }
#pragma unroll
        for (int i = 0; i < 4; ++i) { *(LAS u32x4*)(BmW + (rc + 32 * i) * PP + cc * 16) = nB[i]; *(LAS u32x4*)(Cm + (rc + 32 * i) * PP + cc * 16) = nC[i]; }
#pragma unroll
        for (int i = 0; i < 2; ++i) {
            *(LAS u32x4*)(Xr + (rx + 64 * i) * PX + cx * 16) = nX[i];
            const float de = lane_get(i ? de2[1] : de2[0], rx);
            float xf[8]; unpack8(nX[i], xf);
            u32x4 o; o.x = pk2(xf[0] * de, xf[1] * de); o.y = pk2(xf[2] * de, xf[3] * de); o.z = pk2(xf[4] * de, xf[5] * de); o.w = pk2(xf[6] * de, xf[7] * de);
            *(LAS u32x4*)(Xs + (rx + 64 * i) * PX + cx * 16) = o;
        }
        {
            const int cn = (c < 17) ? c + 1 : c; const int pn0 = dir ? (cn < 2 ? 255 - 128 * cn : 2559 - 128 * cn) : 128 * cn;
#pragma unroll
            for (int i = 0; i < 4; ++i) { const bf16_t* rp = XB + (rowb + (size_t)(pn0 + sg * (rc + 32 * i))) * D; nB[i] = *(const u32x4*)(rp + 512 + grp * 128 + 8 * cc); nC[i] = *(const u32x4*)(rp + 768 + grp * 128 + 8 * cc); }
#pragma unroll
            for (int i = 0; i < 2; ++i) { const bf16_t* rp = XB + (rowb + (size_t)(pn0 + sg * (rx + 64 * i))) * D; nX[i] = *(const u32x4*)(rp + hd * 64 + 8 * cx); }
#pragma unroll
            for (int h2 = 0; h2 < 2; ++h2) ng[h2] = GT[(rowb + (size_t)(pn0 + sg * (lane + 64 * h2))) * 16 + dir * 8 + hd];
        }
        __syncthreads();
        f32x4 cb[8];
        {
            bf16x8 bC[4];
#pragma unroll
            for (int ks = 0; ks < 4; ++ks) bC[ks] = frag(Cm, PP, 16 * w, 32 * ks, lane);
            bf16x8 fa[2][4];
#pragma unroll
            for (int ks = 0; ks < 4; ++ks) fa[0][ks] = frag(BmW, PP, 0, 32 * ks, lane);
#pragma unroll
            for (int st = 0; st < 8; ++st) { cb[st] = (f32x4){0.f, 0.f, 0.f, 0.f};
                if (st <= w) {
                    if (st < 7 && st + 1 <= w) {
#pragma unroll
                        for (int ks = 0; ks < 4; ++ks) fa[(st + 1) & 1][ks] = frag(BmW, PP, 16 * (st + 1), 32 * ks, lane); }
                    __builtin_amdgcn_sched_barrier(0);
#pragma unroll
                    for (int ks = 0; ks < 4; ++ks) cb[st] = MFMA16(fa[st & 1][ks], bC[ks], cb[st]);
                    __builtin_amdgcn_sched_barrier(0); } }
        }
        {
            const int pt = w >> 1, nh = w & 1; const float cdec = __expf(acsl[127]);
            bf16x8 bX[4];
#pragma unroll
            for (int ks = 0; ks < 4; ++ks) bX[ks] = trfrag(Xs, PX, 32 * ks, 16 * pt, lane);
            bf16x8 fb[2][4];
#pragma unroll
            for (int ks = 0; ks < 4; ++ks) fb[0][ks] = trfrag(BmW, PP, 32 * ks, 16 * (4 * nh), lane);
#pragma unroll
            for (int ni = 0; ni < 4; ++ni) { f32x4 a = hacc[ni] * cdec;
                if (ni < 3) {
#pragma unroll
                    for (int ks = 0; ks < 4; ++ks) fb[(ni + 1) & 1][ks] = trfrag(BmW, PP, 32 * ks, 16 * (4 * nh + ni + 1), lane); }
                __builtin_amdgcn_sched_barrier(0);
#pragma unroll
                for (int ks = 0; ks < 4; ++ks) a = MFMA16(fb[ni & 1][ks], bX[ks], a);
                __builtin_amdgcn_sched_barrier(0);
                hacc[ni] = a; }
        }
        __syncthreads();
        {
            const int l = 16 * w + l15; const float al = acsl[l];
            f32x4 a4[8], d4[8];
#pragma unroll
            for (int st = 0; st < 8; ++st) { a4[st] = *(const LAS f32x4*)(acsl + 16 * st + 4 * l4); d4[st] = *(const LAS f32x4*)(dtl + 16 * st + 4 * l4); }
#pragma unroll
            for (int st = 0; st < 8; ++st) { const int s0 = 16 * st + 4 * l4; float vv[4];
#pragma unroll
                for (int r = 0; r < 4; ++r) { const int s = s0 + r; vv[r] = (s <= l) ? cb[st][r] * __expf(al - a4[st][r]) * d4[st][r] : 0.f; }
                u32x2 o; o.x = pk2(vv[0], vv[1]); o.y = pk2(vv[2], vv[3]);
                *(LAS u32x2*)(BmW + l * PP + s0 * 2) = o; }
        }
        __syncthreads();
        {
            const int l = 16 * w + l15; const float ea = __expf(acsl[l]);
            bf16x8 bW[4], bC[4];
#pragma unroll
            for (int ks = 0; ks < 4; ++ks) { bW[ks] = frag(BmW, PP, 16 * w, 32 * ks, lane); bC[ks] = frag(Cm, PP, 16 * w, 32 * ks, lane); }
            bf16_t* yrow = Y + (rowb + (size_t)(p0 + sg * l)) * 512 + hd * 64;
            bf16x8 fx[2][4], fh[2][4];
#pragma unroll
            for (int ks = 0; ks < 4; ++ks) { fx[0][ks] = trfrag(Xr, PX, 32 * ks, 0, lane); fh[0][ks] = frag(Hb, PP, 0, 32 * ks, lane); }
#pragma unroll
            for (int pt = 0; pt < 4; ++pt) {
                f32x4 a1 = (f32x4){0.f, 0.f, 0.f, 0.f}, a2 = (f32x4){0.f, 0.f, 0.f, 0.f};
                if (pt < 3) {
#pragma unroll
                    for (int ks = 0; ks < 4; ++ks) { fx[(pt + 1) & 1][ks] = trfrag(Xr, PX, 32 * ks, 16 * (pt + 1), lane); fh[(pt + 1) & 1][ks] = frag(Hb, PP, 16 * (pt + 1), 32 * ks, lane); } }
                __builtin_amdgcn_sched_barrier(0);
#pragma unroll
                for (int ks = 0; ks < 4; ++ks) { a1 = MFMA16(fx[pt & 1][ks], bW[ks], a1); a2 = MFMA16(fh[pt & 1][ks], bC[ks], a2); }
                __builtin_amdgcn_sched_barrier(0);
                float o4[4];
#pragma unroll
                for (int r = 0; r < 4; ++r) o4[r] = a1[r] + ea * a2[r];
                if (dir == 0) { const u32x2 xq = *(const LAS u32x2*)(Xr + l * PX + (16 * pt + 4 * l4) * 2);
                    o4[0] += dsk * bflo(xq.x); o4[1] += dsk * bfhi(xq.x); o4[2] += dsk * bflo(xq.y); o4[3] += dsk * bfhi(xq.y); }
                u32x2 o; o.x = pk2(o4[0], o4[1]); o.y = pk2(o4[2], o4[3]);
                *(u32x2*)(yrow + 16 * pt + 4 * l4) = o;
            }
        }
        __syncthreads();
        {
            const int pt = w >> 1, nh = w & 1;
#pragma unroll
            for (int ni = 0; ni < 4; ++ni) { u32x2 o; o.x = pk2(hacc[ni][0], hacc[ni][1]); o.y = pk2(hacc[ni][2], hacc[ni][3]);
                *(LAS u32x2*)(Hb + (16 * pt + l15) * PP + (16 * (4 * nh + ni) + 4 * l4) * 2) = o; }
        }
    }
    __syncthreads();
}

__device__ __forceinline__ void s5_unit(Frame& F, int b, int dir, int gq) {
    const int lane = F.lane, w = F.wave, nn = lane & 31, hi = lane >> 5, l15 = lane & 15, l4 = lane >> 4;
    const Params& P = *F.p;
    const bf16_t* Pb = (const bf16_t*)(F.ws + WS_P);
    bf16_t* Y = (bf16_t*)((unsigned char*)F.p->out + (dir ? OUT_YS1 : OUT_YS0));
    const int G = gq * 8 + w, dg = dir * 32 + G;
    lptr Hs = F.lds + w * 8704; constexpr int PH = 272;
    float abr[2], abi[2];
    bf16x8 bfr[4], cfr[4];
    {
        const float dt = __expf(P.in[I_S5LDT][dg]);
        float zr[2], zi[2];
#pragma unroll
        for (int s = 0; s < 2; ++s) {
            const int n = nn + 32 * s; const float are = P.in[I_S5ARE][dg * 64 + n], aim = P.in[I_S5AIM][dg * 64 + n];
            const float mag = __expf(dt * are); float rev = dt * aim * 0.15915494309189533577f; rev = rev - floorf(rev);
            abr[s] = mag * __builtin_amdgcn_cosf(rev); abi[s] = mag * __builtin_amdgcn_sinf(rev);
            const float den = are * are + aim * aim;
            zr[s] = ((abr[s] - 1.f) * are + abi[s] * aim) / den; zi[s] = (abi[s] * are - (abr[s] - 1.f) * aim) / den;
        }
#pragma unroll
        for (int ct = 0; ct < 4; ++ct) {
            const int s = ct & 1, n = nn + 32 * s; const bool im = ct >= 2;
            const float* br = P.in[I_S5BRE] + ((size_t)dg * 64 + n) * 16 + 8 * hi; const float* bi = P.in[I_S5BIM] + ((size_t)dg * 64 + n) * 16 + 8 * hi;
            float v[8];
#pragma unroll
            for (int j = 0; j < 8; ++j) v[j] = im ? (zr[s] * bi[j] + zi[s] * br[j]) : (zr[s] * br[j] - zi[s] * bi[j]);
            u32x4 o; o.x = pk2(v[0], v[1]); o.y = pk2(v[2], v[3]); o.z = pk2(v[4], v[5]); o.w = pk2(v[6], v[7]);
            bfr[ct] = __builtin_bit_cast(bf16x8, o);
        }
#pragma unroll
        for (int ks = 0; ks < 4; ++ks) {
            const int n0 = (32 * ks + 8 * l4) >> 1;
            const float* cre = P.in[I_S5CRE] + ((size_t)dg * 16 + l15) * 64 + n0; const float* cim = P.in[I_S5CIM] + ((size_t)dg * 16 + l15) * 64 + n0;
            float v[8];
#pragma unroll
            for (int j = 0; j < 4; ++j) { v[2 * j] = cre[j]; v[2 * j + 1] = -cim[j]; }
            u32x4 o; o.x = pk2(v[0], v[1]); o.y = pk2(v[2], v[3]); o.z = pk2(v[4], v[5]); o.w = pk2(v[6], v[7]);
            cfr[ks] = __builtin_bit_cast(bf16x8, o);
        }
    }
    float pwr[2][8], pwi[2][8];
#pragma unroll
    for (int s = 0; s < 2; ++s) { float pr = abr[s], pi = abi[s];
#pragma unroll
        for (int r = 0; r < 8; ++r) { pwr[s][r] = pr; pwi[s][r] = pi; const float tr = pr * abr[s] - pi * abi[s], ti = pr * abi[s] + pi * abr[s]; pr = tr; pi = ti; } }
    float sr[2] = {0.f, 0.f}, si[2] = {0.f, 0.f};
    const size_t rowb = (size_t)b * LT;
    const int rho = nn, tau_a = 16 * ((rho >> 2) & 1) + (rho & 3) + 4 * (rho >> 3);
    u32x4 unext = *(const u32x4*)(Pb + (rowb + (size_t)((dir ? 255 : 0) + (dir ? -1 : 1) * tau_a)) * NP1 + C_U + G * 16 + 8 * hi);
    for (int blk = 0; blk < 72; ++blk) {
        const int i0 = 32 * blk; const int p0 = dir ? (i0 < 256 ? 255 - i0 : 2559 - i0) : i0; const int sg = dir ? -1 : 1;
        const u32x4 ua = unext;
        { const int i1 = (blk < 71) ? 32 * (blk + 1) : i0; const int p1 = dir ? (i1 < 256 ? 255 - i1 : 2559 - i1) : i1;
          unext = *(const u32x4*)(Pb + (rowb + (size_t)(p1 + sg * tau_a)) * NP1 + C_U + G * 16 + 8 * hi); }
        const bf16x8 af = __builtin_bit_cast(bf16x8, ua);
        f32x16 acc[4];
#pragma unroll
        for (int ct = 0; ct < 4; ++ct) { f32x16 z = f32x16{}; acc[ct] = __builtin_amdgcn_mfma_f32_32x32x16_bf16(af, bfr[ct], z, 0, 0, 0);
            asm volatile("s_nop 15\n\ts_nop 15" : "+v"(acc[ct]));
        }
#pragma unroll
        for (int s = 0; s < 2; ++s) {
            float xr = hi ? 0.f : sr[s], xi = hi ? 0.f : si[s];
#pragma unroll
            for (int r = 0; r < 16; ++r) { const float nr = abr[s] * xr - abi[s] * xi + acc[s][r], ni = abr[s] * xi + abi[s] * xr + acc[2 + s][r]; xr = nr; xi = ni; acc[s][r] = nr; acc[2 + s][r] = ni; }
            float cr = lane_get(xr, nn), ci = lane_get(xi, nn);
            if (!hi) { cr = 0.f; ci = 0.f; }
#pragma unroll
            for (int r = 0; r < 8; ++r) { acc[s][r] += pwr[s][r] * cr - pwi[s][r] * ci; acc[2 + s][r] += pwr[s][r] * ci + pwi[s][r] * cr; }
            { const float tr = pwr[s][7] * cr - pwi[s][7] * ci, ti = pwr[s][7] * ci + pwi[s][7] * cr; cr = tr; ci = ti; }
#pragma unroll
            for (int r = 0; r < 8; ++r) { acc[s][8 + r] += pwr[s][r] * cr - pwi[s][r] * ci; acc[2 + s][8 + r] += pwr[s][r] * ci + pwi[s][r] * cr; }
            sr[s] = lane_get(acc[s][15], nn + 32); si[s] = lane_get(acc[2 + s][15], nn + 32);
        }
#pragma unroll
        for (int r = 0; r < 16; ++r) {
            const int tau = 16 * hi + r; lptr hp = Hs + tau * PH;
            *(LAS unsigned*)(hp + nn * 4) = pk2(acc[0][r], acc[2][r]); *(LAS unsigned*)(hp + (32 + nn) * 4) = pk2(acc[1][r], acc[3][r]);
        }
        LDS_WAIT();
#pragma unroll
        for (int tt = 0; tt < 2; ++tt) {
            f32x4 a = (f32x4){0.f, 0.f, 0.f, 0.f};
#pragma unroll
            for (int ks = 0; ks < 4; ++ks) a = MFMA16(cfr[ks], frag(Hs, PH, 16 * tt, 32 * ks, lane), a);
            const int tau = 16 * tt + l15;
            u32x2 o; o.x = pk2(a[0], a[1]); o.y = pk2(a[2], a[3]);
            *(u32x2*)(Y + (rowb + (size_t)(p0 + sg * tau)) * 512 + G * 16 + 4 * l4) = o;
        }
        LDS_WAIT();
    }
}
#undef MFMA16
}
__device__ __forceinline__ void finalize0_phase(Frame& F) {
    const bf16_t* Y0 = (const bf16_t*)(F.ws + WS_Y0); const bf16_t* Y1 = (const bf16_t*)(F.ws + WS_Y1); const bf16_t* Pb = (const bf16_t*)(F.ws + WS_P);
    bf16_t* MIX = (bf16_t*)(F.ws + WS_HB); const float* gn = F.p->in[I_MLNORM] + 8 * F.lane;
    float g[8];
#pragma unroll
    for (int e = 0; e < 8; ++e) g[e] = gn[e];
    const int r0 = wave_row0(F.bid, F.wave);
#pragma unroll 1
    for (int ri3 = 0; ri3 < ROWS_PER_WAVE; ri3 += 6) {
        u32x4 a[6], b[6], o[6];
#pragma unroll
        for (int q = 0; q < 6; ++q) { const size_t r = r0 + ri3 + q;
            a[q] = *(const u32x4*)(Y0 + r * 512 + 8 * F.lane); b[q] = *(const u32x4*)(Y1 + r * 512 + 8 * F.lane); o[q] = *(const u32x4*)(Pb + r * NP0 + C_MO + 8 * F.lane); }
#pragma unroll
        for (int q = 0; q < 6; ++q) { const size_t r = r0 + ri3 + q;
            float x[8], y[8], og[8]; mix::unpack8(a[q], x); mix::unpack8(b[q], y); mix::unpack8(o[q], og);
            float ss = 0.f;
#pragma unroll
            for (int e = 0; e < 8; ++e) { x[e] += y[e]; ss += x[e] * x[e]; }
            ss += dppf<0xB1>(ss); ss += dppf<0x4E>(ss); ss += dppf<0x141>(ss); ss += dppf<0x140>(ss);
            const float rstd = rsqrtf(ss * (1.f / 128.f) + NORM_EPS);
#pragma unroll
            for (int e = 0; e < 8; ++e) x[e] = x[e] * rstd * g[e] * sigmoidf_(og[e]);
            u32x4 w; w.x = pk2(x[0], x[1]); w.y = pk2(x[2], x[3]); w.z = pk2(x[4], x[5]); w.w = pk2(x[6], x[7]);
            *(u32x4*)(MIX + r * D + 8 * F.lane) = w; }
    }
}
__device__ __forceinline__ float gelu_tanh(float x) { const float a = 0.7978845608028654f * (x + 0.044715f * x * x * x); const float t = 1.f - 2.f * __builtin_amdgcn_rcpf(1.f + __expf(2.f * a)); return 0.5f * x * (1.f + t); }
__device__ __forceinline__ void finalize1_phase(Frame& F) {
    const bf16_t* S0 = (const bf16_t*)((const unsigned char*)F.p->out + OUT_YS0); const bf16_t* S1 = (const bf16_t*)((const unsigned char*)F.p->out + OUT_YS1);
    const bf16_t* D0 = (const bf16_t*)((const unsigned char*)F.p->out + OUT_YD0); const bf16_t* D1 = (const bf16_t*)(F.ws + WS_YD1); const bf16_t* Pb = (const bf16_t*)(F.ws + WS_P);
    bf16_t* MIX = (bf16_t*)(F.ws + WS_HB); bf16_t* Gb = (bf16_t*)(F.ws + WS_G);
    float sd[8], gn[8];
#pragma unroll
    for (int e = 0; e < 8; ++e) { sd[e] = F.p->in[I_S5D][8 * F.lane + e]; gn[e] = F.p->in[I_SSDNORM][8 * F.lane + e]; }
    const int r0 = (F.bid >> 4) * LT + CTXL + 128 * (F.bid & 15) + 16 * F.wave;
#pragma unroll 1
    for (int ri3 = 0; ri3 < 16; ri3 += 4) {
        u32x4 a[4], b[4], u[4], c[4], d[4], z[4];
#pragma unroll
        for (int q = 0; q < 4; ++q) { const size_t r = r0 + ri3 + q;
            a[q] = *(const u32x4*)(S0 + r * 512 + 8 * F.lane); b[q] = *(const u32x4*)(S1 + r * 512 + 8 * F.lane); u[q] = *(const u32x4*)(Pb + r * NP1 + C_U + 8 * F.lane);
            c[q] = *(const u32x4*)(D0 + r * 512 + 8 * F.lane); d[q] = *(const u32x4*)(D1 + r * 512 + 8 * F.lane); z[q] = *(const u32x4*)(Pb + r * NP1 + C_Z + 8 * F.lane); }
#pragma unroll
        for (int q = 0; q < 4; ++q) { const size_t r = r0 + ri3 + q;
            {
                float x[8], y[8], uu[8]; mix::unpack8(a[q], x); mix::unpack8(b[q], y); mix::unpack8(u[q], uu);
#pragma unroll
                for (int e = 0; e < 8; ++e) x[e] = gelu_tanh(x[e] + y[e] + sd[e] * uu[e]);
                u32x4 w; w.x = pk2(x[0], x[1]); w.y = pk2(x[2], x[3]); w.z = pk2(x[4], x[5]); w.w = pk2(x[6], x[7]);
                *(u32x4*)(Gb + r * 512 + 8 * F.lane) = w;
            }
            {
                float x[8], y[8], zz[8]; mix::unpack8(c[q], x); mix::unpack8(d[q], y); mix::unpack8(z[q], zz);
                float ss = 0.f;
#pragma unroll
                for (int e = 0; e < 8; ++e) { x[e] = (x[e] + y[e]) * siluf_(zz[e]); ss += x[e] * x[e]; }
                const float rstd = rsqrtf(wave_sum(ss) * (1.f / 512.f) + NORM_EPS);
#pragma unroll
                for (int e = 0; e < 8; ++e) x[e] = x[e] * rstd * gn[e];
                u32x4 w; w.x = pk2(x[0], x[1]); w.y = pk2(x[2], x[3]); w.z = pk2(x[4], x[5]); w.w = pk2(x[6], x[7]);
                *(u32x4*)(MIX + r * D + 512 + 8 * F.lane) = w;
            }
        }
    }
}

__device__ __forceinline__ void conv_phase(Frame& F) {
    const bf16_t* Pb = (const bf16_t*)(F.ws + WS_P); bf16_t* XB = (bf16_t*)(F.ws + WS_HB);
    const int c0 = 16 * F.lane;
    float w0[16], w1[16], w2[16], bb[16];
#pragma unroll
    for (int e = 0; e < 16; ++e) { w0[e] = F.p->in[I_CONVW][c0 + e]; w1[e] = F.p->in[I_CONVW][1024 + c0 + e]; w2[e] = F.p->in[I_CONVW][2048 + c0 + e]; bb[e] = F.p->in[I_CONVB][c0 + e]; }
    const int r0 = wave_row0(F.bid, F.wave);
    const u32x4 z4 = (u32x4){0u, 0u, 0u, 0u};
    auto ld = [&](int r, u32x4& a, u32x4& b2) { const bf16_t* p = Pb + (size_t)r * NP1 + C_XS + c0; a = *(const u32x4*)p; b2 = *(const u32x4*)(p + 8); };
    u32x4 pa, pb, ca, cb2, na, nb;
    ld(r0 > 0 ? r0 - 1 : 0, pa, pb);
    ld(r0, ca, cb2);
#pragma unroll 1
    for (int ri = 0; ri < ROWS_PER_WAVE; ++ri) {
        const int r = r0 + ri, p = r % LT;
        ld(r + 1 < R ? r + 1 : R - 1, na, nb);
        const bool okm = (p != 0) && (p != CTXL), okp = (p != CTXL - 1) && (p != LT - 1);
        float xm[16], x0[16], xp[16];
        mix::unpack8(okm ? pa : z4, xm); mix::unpack8(okm ? pb : z4, xm + 8); mix::unpack8(ca, x0); mix::unpack8(cb2, x0 + 8); mix::unpack8(okp ? na : z4, xp); mix::unpack8(okp ? nb : z4, xp + 8);
        float y[16];
#pragma unroll
        for (int e = 0; e < 16; ++e) y[e] = siluf_(w0[e] * xm[e] + w1[e] * x0[e] + w2[e] * xp[e] + bb[e]);
        u32x4 o0, o1; o0.x = pk2(y[0], y[1]); o0.y = pk2(y[2], y[3]); o0.z = pk2(y[4], y[5]); o0.w = pk2(y[6], y[7]);
        o1.x = pk2(y[8], y[9]); o1.y = pk2(y[10], y[11]); o1.z = pk2(y[12], y[13]); o1.w = pk2(y[14], y[15]);
        bf16_t* q = XB + (size_t)r * D + c0; *(u32x4*)q = o0; *(u32x4*)(q + 8) = o1;
        pa = ca; pb = cb2; ca = na; cb2 = nb;
    }
}

__device__ __forceinline__ void stagger_start(int bid, int G, int N, int span_us) {
    const int rem = N % G; if (span_us <= 0 || rem == 0 || bid < rem) return;
    const unsigned long long ticks = (unsigned long long)(bid - rem) * (unsigned)(span_us * 100) / (unsigned)(G - rem);
    const unsigned long long t_end = __builtin_amdgcn_s_memrealtime() + ticks;
    while (__builtin_amdgcn_s_memrealtime() < t_end) __builtin_amdgcn_s_sleep(8);
}
#ifndef STG6
#define STG6 0
#endif
#ifndef STG10
#define STG10 0
#endif
#ifndef STG20
#define STG20 0
#endif
#ifndef STG9
#define STG9 0
#endif
#ifndef STG19
#define STG19 0
#endif
#ifndef STG2
#define STG2 0
#endif
#ifndef DEFER_L1
#define DEFER_L1 1
#endif
#ifndef ONLY
#define ONLY -1
#endif
#ifndef REP
#define REP -1
#endif
#ifndef DUMP
#define DUMP -1
#endif
#ifndef DUMPSRC
#define DUMPSRC 0
#endif
#define PORD(k) ((k) <= 12 ? (k) : ((k) == 21 ? 13 : (k) + 1))
#define LIVE(k) (DUMP < 0 || PORD(k) <= PORD(DUMP))
#ifndef REPSEL
#define REPSEL 0
#endif
__global__ void __launch_bounds__(NTHREADS, 2) fwd_kernel(Params prm) {
    extern __shared__ __attribute__((aligned(16))) unsigned char lds[];
    Frame F;
    F.lds = (LAS unsigned char*)lds; F.MISC = (volatile LAS unsigned*)(F.lds + MISC_OFF);
    F.tid = threadIdx.x; F.lane = F.tid & 63; F.wave = __builtin_amdgcn_readfirstlane(F.tid >> 6); F.wave_s = F.wave;
    F.G = gridDim.x; F.bid = blockIdx.x; F.vcu = (F.G % 8 == 0) ? (F.bid % 8) * (F.G / 8) + F.bid / 8 : F.bid;
    F.p = &prm; F.ws = prm.ws; F.ctl = (gu32*)(prm.ws + WS_CTL);
    if (F.tid < 64) F.MISC[F.tid] = 0u;
    __syncthreads();
    XcdBarrier bar = xcd_barrier_post((unsigned*)(F.ctl + CW_BAR), F.MISC + 8, F.tid);
#define GRID_BAR() xcd_barrier(bar, opaque_tid(F.wave_s))
#ifdef TMASK
    unsigned long long tp_t0 = 0, tp_acc = 0;
#define TP_BEGIN(k) do { if (((TMASK) >> (k)) & 1) tp_t0 = __builtin_amdgcn_s_memrealtime(); } while (0)
#define TP_END(k) do { if (((TMASK) >> (k)) & 1) tp_acc += __builtin_amdgcn_s_memrealtime() - tp_t0; } while (0)
#else
#define TP_BEGIN(k) do {} while (0)
#define TP_END(k) do {} while (0)
#endif
#ifndef UBLK
#define UBLK 0
#endif
    bool ut_done4 = false;
#if defined(TMASK) && defined(USEL)
#define UT_BEGIN(k) do { if (USEL == (k) && F.bid == UBLK) tp_t0 = __builtin_amdgcn_s_memrealtime(); } while (0)
#define UT_END(k) do { if (USEL == (k) && F.bid == UBLK) tp_acc += __builtin_amdgcn_s_memrealtime() - tp_t0; } while (0)
#else
#define UT_BEGIN(k) do {} while (0)
#define UT_END(k) do {} while (0)
#endif
#define PH() do { F.tid = opaque_tid(F.wave_s); F.lane = F.tid & 63; F.wave = F.wave_s; } while (0)
    const char* ws = (const char*)prm.ws;
    const float* mod0 = (const float*)(ws + WS_MOD); const float* mod1 = mod0 + 17 * 6144;


    TP_BEGIN(0); if (LIVE(0) && (ONLY < 0 || ONLY == 0)) { for (int rep = 0; rep < ((REP == 0) ? 2 : 1); ++rep) { if (rep) GRID_BAR(); PH();
    p0_prologue(F); } }
    GRID_BAR(); TP_END(0);
    TP_BEGIN(1); if (LIVE(1) && (ONLY < 0 || ONLY == 1)) { for (int rep = 0; rep < ((REP == 1) ? 2 : 1); ++rep) { if (rep) GRID_BAR(); PH();
    norm_phase<0>(F); } }
    GRID_BAR(); TP_END(1);
    TP_BEGIN(2); if (LIVE(2) && (ONLY < 0 || ONLY == 2)) { for (int rep = 0; rep < ((REP == 2) ? 2 : 1); ++rep) { if (rep) GRID_BAR(); PH();
    {
        pg8::Gemm g{D, D, D}; pg8::DenseSched<false> S{ws + WS_HB, ws + WS_WIN0, NP0 / 256 + 1, F.G, F.bid, (size_t)256 * D * 2, (size_t)256 * D * 2};
        pg8::EpiStoreBf16 E{(bf16_t*)(prm.ws + WS_P), NP0, NP0 / 256, (float*)(prm.ws + WS_GATES), 0};
        pg8::gemm_phase<pg8::EpiStoreBf16, pg8::DenseSched<false>, true>(F.lds, g, S, E, F.wave_s);
    }
    } }
    GRID_BAR(); TP_END(2);
    TP_BEGIN(3); if (LIVE(3) && (ONLY < 0 || ONLY == 3)) { for (int rep = 0; rep < ((REP == 3) ? 2 : 1); ++rep) { if (rep) GRID_BAR(); PH();
    knorm_phase(F); } }
    GRID_BAR(); TP_END(3);
    TP_BEGIN(4); if (LIVE(4) && (ONLY < 0 || ONLY == 4 || ONLY == 40 || ONLY == 41)) { for (int rep = 0; rep < ((REP == 4) ? 2 : 1); ++rep) { if (rep) GRID_BAR(); PH();
    {
        if (ONLY != 41 && !(rep == 1 && REPSEL == 2) && F.bid < 128) {
            UT_BEGIN(3); const int u = F.bid;
            mix::mlstm_unit(F, u >> 3, (u >> 1) & 3, u & 1); UT_END(3);
        }
        if (ONLY != 40 && !(rep == 1 && REPSEL == 1)) for (;;) {
            const int a = q_next(F, 1 + 4 * rep);
            if (a >= 1152) break;
            int b, h, qb;
            if (a < 1024) { qb = 1 + (a & 7); b = a >> 6; h = ((a >> 5) & 1) * 4 + ((a >> 3) & 3); } else { const int a2 = a - 1024; b = a2 >> 3; h = a2 & 7; qb = 0; }
            const bool tm_ = (a < 1024) && (F.bid == UBLK) && !ut_done4; if (tm_) { UT_BEGIN(4); }
            attn_body::attn_unit<8>(b, h, qb, (const bf16_t*)(prm.ws + WS_P), (bf16_t*)(prm.ws + WS_HB), prm.in[I_QNORM], (char*)lds, F.wave_s);
            if (tm_) { UT_END(4); ut_done4 = true; }
        }
    }
    } }
    GRID_BAR(); TP_END(4);
    TP_BEGIN(5); if (LIVE(5) && (ONLY < 0 || ONLY == 5)) { for (int rep = 0; rep < ((REP == 5) ? 2 : 1); ++rep) { if (rep) GRID_BAR(); PH();
    finalize0_phase(F); } }
    GRID_BAR(); TP_END(5);
    TP_BEGIN(6); if (LIVE(6) && (ONLY < 0 || ONLY == 6)) { for (int rep = 0; rep < ((REP == 6) ? 2 : 1); ++rep) { if (rep) GRID_BAR(); PH();
    {
        pg8::Gemm g{D, D, D}; pg8::DenseSched<false> S{ws + WS_HB, ws + WS_WOUT0, 4, F.G, F.bid, (size_t)256 * D * 2, (size_t)256 * D * 2};
        stagger_start(F.bid, F.G, 144 * 4, STG6);
        pg8::EpiResid<true> E{prm.in[I_X], prm.in[I_CTX], (bf16_t*)(prm.ws + WS_XR), mod0 + 2048};
        pg8::gemm_phase<pg8::EpiResid<true>, pg8::DenseSched<false>, true>(F.lds, g, S, E, F.wave_s);
        if (DEFER_L1 && F.bid >= 64) { PH(); tr_list_range<1>(F, 0, TRL1 / 2, (F.bid - 64) * NWAVES + F.wave, 192 * NWAVES); }
    }
    } }
    GRID_BAR(); TP_END(6);
    TP_BEGIN(7); if (LIVE(7) && (ONLY < 0 || ONLY == 7)) { for (int rep = 0; rep < ((REP == 7) ? 2 : 1); ++rep) { if (rep) GRID_BAR(); PH();
    norm_phase<1>(F); } }
    GRID_BAR(); TP_END(7);
    TP_BEGIN(9); if (LIVE(9) && (ONLY < 0 || ONLY == 9)) { for (int rep = 0; rep < ((REP == 9) ? 2 : 1); ++rep) { if (rep) GRID_BAR(); PH();
    {
        MoeTab T = moe_tables2(F, F.lds + MOE_TAB_OFF, 0);
        pg8::Gemm g{D, D, D}; pg8::MoeSched S{ws + WS_HB, ws + WS_GU0, 8, F.G, F.bid, T.ntile[0], T.base, T.tot, false, (const int*)(ws + WS_ROUTE + RT_TOK2)};
        stagger_start(F.bid, F.G, T.ntile[0] * 8, STG9);
        pg8::EpiSwiGlu E{(bf16_t*)(prm.ws + WS_ACT), (const float*)(ws + WS_ROUTE + RT_WPOS2), (const int*)(ws + WS_ROUTE + RT_TOK2)};
        pg8::gemm_phase<pg8::EpiSwiGlu, pg8::MoeSched, true, true>(F.lds, g, S, E, F.wave_s);
    }
    } }
    GRID_BAR(); TP_END(9);
    TP_BEGIN(10); if (LIVE(10) && (ONLY < 0 || ONLY == 10)) { for (int rep = 0; rep < ((REP == 10) ? 2 : 1); ++rep) { if (rep) GRID_BAR(); PH();
    {
        MoeTab T = moe_tables_view(F.lds + MOE_TAB_OFF);
        pg8::Gemm g{D, 512, D}; pg8::MoeSched S{ws + WS_ACT, ws + WS_D0, 4, F.G, F.bid, T.ntile[0], T.base, T.tot, true, (const int*)(ws + WS_ROUTE + RT_TOK2)};
        stagger_start(F.bid, F.G, T.ntile[0] * 4, STG10);
        pg8::EpiDown<false> E{(const int*)(ws + WS_ROUTE + RT_TOK2), prm.out, (bf16_t*)(prm.ws + WS_XR), (const bf16_t*)(ws + WS_MODB) + 5120};
        pg8::gemm_phase<pg8::EpiDown<false>, pg8::MoeSched, true>(F.lds, g, S, E, F.wave_s);
        {
            const int nu = 4 * T.ntile[0]; int third = nu - 2 * F.G; third = third < 0 ? 0 : (third > F.G - 32 ? F.G - 32 : third);
            if (DEFER_L1 && F.bid >= third) { PH(); tr_list_range<1>(F, TRL1 / 2, TRL1, (F.bid - third) * NWAVES + F.wave, (F.G - third) * NWAVES); }
        }
    }
    } }
    GRID_BAR(); TP_END(10);
    TP_BEGIN(11); if (LIVE(11) && (ONLY < 0 || ONLY == 11)) { for (int rep = 0; rep < ((REP == 11) ? 2 : 1); ++rep) { if (rep) GRID_BAR(); PH();
    norm_phase<2>(F); } }
    GRID_BAR(); TP_END(11);
    TP_BEGIN(12); if (LIVE(12) && (ONLY < 0 || ONLY == 12)) { for (int rep = 0; rep < ((REP == 12) ? 2 : 1); ++rep) { if (rep) GRID_BAR(); PH();
    {
        pg8::Gemm g{D, D, D}; pg8::InProj1Sched S{ws + WS_HB, ws + WS_WIN1, F.G, F.bid, (size_t)256 * D * 2, (size_t)256 * D * 2};
        pg8::EpiStoreBf16 E{(bf16_t*)(prm.ws + WS_P), NP1, NP1 / 256, (float*)(prm.ws + WS_GATES), 2};
        pg8::gemm_phase<pg8::EpiStoreBf16, pg8::InProj1Sched, true>(F.lds, g, S, E, F.wave_s);
    }
    } }
    GRID_BAR(); TP_END(12);
    TP_BEGIN(21); if (LIVE(21) && (ONLY < 0 || ONLY == 21)) { for (int rep = 0; rep < ((REP == 21) ? 2 : 1); ++rep) { if (rep) GRID_BAR(); PH();
    conv_phase(F); } }
    GRID_BAR(); TP_END(21);
    TP_BEGIN(13); if (LIVE(13) && (ONLY < 0 || ONLY == 13 || ONLY == 130 || ONLY == 131)) { for (int rep = 0; rep < ((REP == 13) ? 2 : 1); ++rep) { if (rep) GRID_BAR(); PH();
    {
        if (ONLY != 131 && !(rep == 1 && REPSEL == 2) && F.bid < 128) {
            UT_BEGIN(1); const int u = F.bid;
            mix::s5_unit(F, u >> 3, (u >> 2) & 1, u & 3); UT_END(1);
        }
        if (ONLY != 130 && !(rep == 1 && REPSEL == 1)) for (int it = 0;; ++it) {
            const int a = q_next(F, 3 + 4 * rep);
            if (a >= 256) break;
            if (it == 0) UT_BEGIN(2);
            mix::ssd_unit(F, a >> 4, (a >> 1) & 7, a & 1);
            if (it == 0) UT_END(2);
        }
    }
    } }
    GRID_BAR(); TP_END(13);
    TP_BEGIN(14); if (LIVE(14) && (ONLY < 0 || ONLY == 14)) { for (int rep = 0; rep < ((REP == 14) ? 2 : 1); ++rep) { if (rep) GRID_BAR(); PH();
    finalize1_phase(F); } }
    GRID_BAR(); TP_END(14);
    TP_BEGIN(15); if (LIVE(15) && (ONLY < 0 || ONLY == 15)) { for (int rep = 0; rep < ((REP == 15) ? 2 : 1); ++rep) { if (rep) GRID_BAR(); PH();
    {
        pg8::Gemm g{512, 512, 512}; pg8::DenseSched<true> S{ws + WS_G, ws + WS_WGLU, 2, F.G, F.bid, (size_t)256 * 512 * 2, (size_t)256 * 512 * 2};
        pg8::EpiGlu E{(const bf16_t*)(ws + WS_G), (bf16_t*)(prm.ws + WS_HB), prm.in[I_GLUB]};
        pg8::gemm_phase<pg8::EpiGlu, pg8::DenseSched<true>, true>(F.lds, g, S, E, F.wave_s);
    }
    } }
    GRID_BAR(); TP_END(15);
    TP_BEGIN(16); if (LIVE(16) && (ONLY < 0 || ONLY == 16)) { for (int rep = 0; rep < ((REP == 16) ? 2 : 1); ++rep) { if (rep) GRID_BAR(); PH();
    {
        pg8::Gemm g{D, D, D}; pg8::DenseSched<true> S{ws + WS_HB, ws + WS_WOUT1, 4, F.G, F.bid, (size_t)256 * D * 2, (size_t)256 * D * 2};
        pg8::EpiResid<false> E{prm.in[I_X], prm.in[I_CTX], (bf16_t*)(prm.ws + WS_XR), mod1 + 2048};
        pg8::gemm_phase<pg8::EpiResid<false>, pg8::DenseSched<true>, true>(F.lds, g, S, E, F.wave_s);
    }
    } }
    GRID_BAR(); TP_END(16);
    TP_BEGIN(17); if (LIVE(17) && (ONLY < 0 || ONLY == 17)) { for (int rep = 0; rep < ((REP == 17) ? 2 : 1); ++rep) { if (rep) GRID_BAR(); PH();
    norm_phase<3>(F); } }
    GRID_BAR(); TP_END(17);
    TP_BEGIN(19); if (LIVE(19) && (ONLY < 0 || ONLY == 19)) { for (int rep = 0; rep < ((REP == 19) ? 2 : 1); ++rep) { if (rep) GRID_BAR(); PH();
    {
        MoeTab T = moe_tables2(F, F.lds + MOE_TAB_OFF, 1);
        pg8::Gemm g{D, D, D}; pg8::MoeSched S{ws + WS_HB, ws + WS_GU1, 8, F.G, F.bid, T.ntile[0], T.base, T.tot, false, (const int*)(ws + WS_ROUTE + RT_TOK2)};
        stagger_start(F.bid, F.G, T.ntile[0] * 8, STG19);
        pg8::EpiSwiGlu E{(bf16_t*)(prm.ws + WS_ACT), (const float*)(ws + WS_ROUTE + RT_WPOS2), (const int*)(ws + WS_ROUTE + RT_TOK2)};
        pg8::gemm_phase<pg8::EpiSwiGlu, pg8::MoeSched, true, true>(F.lds, g, S, E, F.wave_s);
    }
    } }
    GRID_BAR(); TP_END(19);
    TP_BEGIN(20); if (LIVE(20) && (ONLY < 0 || ONLY == 20)) { for (int rep = 0; rep < ((REP == 20) ? 2 : 1); ++rep) { if (rep) GRID_BAR(); PH();
    {
        MoeTab T = moe_tables_view(F.lds + MOE_TAB_OFF);
        pg8::Gemm g{D, 512, D}; pg8::MoeSched S{ws + WS_ACT, ws + WS_D1, 4, F.G, F.bid, T.ntile[0], T.base, T.tot, true, (const int*)(ws + WS_ROUTE + RT_TOK2)};
        stagger_start(F.bid, F.G, T.ntile[0] * 4, STG20);
        pg8::EpiDown<true> E{(const int*)(ws + WS_ROUTE + RT_TOK2), prm.out, (bf16_t*)(prm.ws + WS_XR), (const bf16_t*)(ws + WS_MODB) + 17 * 6144 + 5120};
        pg8::gemm_phase<pg8::EpiDown<true>, pg8::MoeSched, true>(F.lds, g, S, E, F.wave_s);
    }
} }
    GRID_BAR(); TP_END(20);
#ifdef EXTRA_BARS
    for (int i = 0; i < EXTRA_BARS; ++i) GRID_BAR();
#endif
#ifdef FINALHASH
    {
        PH();
        for (size_t i = (size_t)F.bid * NTHREADS + F.tid; i < (size_t)NBATCH * SEQ * D / 4; i += (size_t)GRID * NTHREADS) {
            const u32x4 w = ((const u32x4*)prm.out)[i];
            auto hsh = [](unsigned v) -> float { return (float)(((v * 2654435761u) >> 12) & 0xFFFFu) * (1.f / 65536.f); };
            ((f32x4*)prm.out)[i] = (f32x4){hsh(w.x), hsh(w.y), hsh(w.z), hsh(w.w)};
        }
    }
#endif
    if (DUMP >= 0) {
        PH();
#ifdef DUMPCOPY
        {
            const u32x4* src = (const u32x4*)((const unsigned char*)prm.out + (DUMPCOPY ? OUT_YS1 : OUT_YS0)); u32x4* dst = (u32x4*)(prm.ws + WS_G);
            for (size_t i = (size_t)F.bid * NTHREADS + F.tid; i < (size_t)R * 512 * 2 / 16; i += (size_t)GRID * NTHREADS) dst[i] = src[i];
            GRID_BAR(); PH();
        }
#endif
        const bf16_t* sb = (const bf16_t*)(prm.ws + (DUMPSRC == 0 ? WS_XR : (DUMPSRC == 1 ? WS_HB : (DUMPSRC == 2 ? WS_P : WS_G))));
        constexpr int spitch = (DUMPSRC == 2) ? NP1 : ((DUMPSRC == 3) ? 512 : D);
        for (size_t i = (size_t)F.bid * NTHREADS + F.tid; i < (size_t)NBATCH * SEQ * D / 4; i += (size_t)GRID * NTHREADS) {
            const size_t e = i * 4; const int col = (int)(e % D); const size_t tr = e / D; const int b = (int)(tr / SEQ), t = (int)(tr % SEQ);
            const size_t r = (size_t)b * LT + CTXL + t;
            const int c2 = (DUMPSRC == 3) ? (col & 511) : col;
            if (DUMPSRC == 5) { const u32x2 w = *(const u32x2*)((const bf16_t*)(prm.ws + WS_ACT) + e); ((f32x4*)prm.out)[i] = (f32x4){bflo(w.x), bfhi(w.x), bflo(w.y), bfhi(w.y)}; continue; }
            if (DUMPSRC == 7) { const int* cg = (const int*)(prm.ws + WS_ROUTE + RT_CNT); f32x4 o = {0.f, 0.f, 0.f, 0.f};
                if (i < 1536) o = (f32x4){(float)cg[4 * i], (float)cg[4 * i + 1], (float)cg[4 * i + 2], (float)cg[4 * i + 3]};
                ((f32x4*)prm.out)[i] = o; continue; }
            if (DUMPSRC == 8) { f32x4 o = {0.f, 0.f, 0.f, 0.f}; const int* clsg = (const int*)(prm.ws + WS_ROUTE + RT_CLS); const float* wts = (const float*)(prm.ws + WS_ROUTE + RT_WTS);
                auto hs8 = [](unsigned v) -> float { return (float)(((v * 2654435761u) >> 12) & 0xFFFFu) * (1.f / 65536.f); };
                if (col == 0) o = (f32x4){hs8((unsigned)clsg[r]), hs8(__float_as_uint(wts[2 * r])), hs8(__float_as_uint(wts[2 * r + 1])), 0.f};
                ((f32x4*)prm.out)[i] = o; continue; }
            if (DUMPSRC == 6) { f32x4 o = {0.f, 0.f, 0.f, 0.f}; const int idx = b * SEQ + t;
                const int* clsg = (const int*)(prm.ws + WS_ROUTE + RT_CLS); const float* wts = (const float*)(prm.ws + WS_ROUTE + RT_WTS);
                const int* tok = (const int*)(prm.ws + WS_ROUTE + RT_TOK); const float* wpos = (const float*)(prm.ws + WS_ROUTE + RT_WPOS);
                if (col == 0) o = (f32x4){(float)clsg[r], wts[2 * r], wts[2 * r + 1], (float)tok[idx]};
                else if (col == 4) o = (f32x4){0.f, wpos[2 * (size_t)idx], wpos[2 * (size_t)idx + 1], 0.f};
                ((f32x4*)prm.out)[i] = o; continue; }
            const u32x2 w = *(const u32x2*)(sb + r * spitch + c2);
#ifdef DUMPHASH
            { auto hsh = [](unsigned v) -> float { return (float)(((v * 2654435761u) >> 12) & 0xFFFFu) * (1.f / 65536.f); };
              ((f32x4*)prm.out)[i] = (f32x4){hsh(w.x & 0xffffu), hsh(w.x >> 16), hsh(w.y & 0xffffu), hsh(w.y >> 16)}; continue; }
#endif
            ((f32x4*)prm.out)[i] = (f32x4){bflo(w.x), bfhi(w.x), bflo(w.y), bfhi(w.y)};
        }
    }
#ifdef BWTEST
    {
        GRID_BAR();
        const unsigned long long tb0 = __builtin_amdgcn_s_memrealtime();
        PH();
        const f32x4* src = (const f32x4*)prm.in[I_X]; f32x4* dst = (f32x4*)(prm.ws + WS_P);
        const size_t n4 = (size_t)NBATCH * SEQ * D / 4; const size_t stride = (size_t)GRID * NTHREADS;
        for (size_t i = (size_t)F.bid * NTHREADS + F.tid; i < n4; i += stride * BWTEST) {
            f32x4 v[BWTEST];
#pragma unroll
            for (int u = 0; u < BWTEST; ++u) v[u] = (i + u * stride < n4) ? src[i + u * stride] : (f32x4){0.f, 0.f, 0.f, 0.f};
#pragma unroll
            for (int u = 0; u < BWTEST; ++u) if (i + u * stride < n4) dst[i + u * stride] = v[u];
        }
        GRID_BAR();
        tp_acc += __builtin_amdgcn_s_memrealtime() - tb0;
    }
#endif
#if defined(TMASK) && defined(EPITIME)
    tp_acc += F.MISC[24];
#endif
#ifdef TMASK
    if (F.bid == UBLK) { const unsigned long long t_end = __builtin_amdgcn_s_memrealtime() + (unsigned long long)(TAMP) * tp_acc; while (__builtin_amdgcn_s_memrealtime() < t_end) __builtin_amdgcn_s_sleep(32); }
#endif
#undef GRID_BAR
}

extern "C" void kernel_launch(void* const* d_in, const int* in_sizes, int n_in, void* d_out, int out_size, void* d_ws, size_t ws_size, hipStream_t stream) {
    static int ready = 0;
    if (ready == 0) {
        if (n_in != 39 || out_size != NBATCH * SEQ * D || ws_size < WS_END) { fprintf(stderr, "kernel_launch: unexpected problem (n_in %d, out %d, ws %zu); nothing launched\n", n_in, out_size, ws_size); ready = -1; return; }
        if (hipFuncSetAttribute((const void*)fwd_kernel, hipFuncAttributeMaxDynamicSharedMemorySize, LDS_BYTES) != hipSuccess) { fprintf(stderr, "kernel_launch: hipFuncSetAttribute failed\n"); ready = -1; return; }
        int per_cu = 0;
        if (hipOccupancyMaxActiveBlocksPerMultiprocessor(&per_cu, (const void*)fwd_kernel, NTHREADS, LDS_BYTES) != hipSuccess || per_cu < 1) fprintf(stderr, "kernel_launch: occupancy query reports %d workgroups per CU\n", per_cu);
        (void)hipGetLastError();
        ready = 1;
    }
    if (ready < 0) return;
    (void)in_sizes;
    if (hipMemsetAsync((char*)d_ws + WS_CTL, 0, CTL_ZERO_BYTES, stream) != hipSuccess) return;
    Params p{};
    for (int i = 0; i < 39; ++i) p.in[i] = (const float*)d_in[i];
    p.out = (float*)d_out; p.ws = (unsigned char*)d_ws;
    hipLaunchKernelGGL(fwd_kernel, dim3(GRID), dim3(NTHREADS), LDS_BYTES, stream, p);
}
```
